# Optimizing an MI355X kernel written in HIP

```python
import jax, jax.numpy as jnp
from jax import lax
import numpy as np

D_MODEL = 1024
BATCH = 16
SEQ = 256
DEPTH = 2
DEC_BATCH = 8
DEC_SEQ = 2048
PAST_LEN = 256

GRID_W = 64
N_CONV_LAYERS = (DEPTH + 1) // 2
N_ATTN_LAYERS = DEPTH // 2
SC_WIDTH = D_MODEL // 2
SC_KERNEL = 3
CF_WIDTH = D_MODEL // 2
CF_KERNEL = 31
GQA_HEADS = 8
GQA_KV_HEADS = 2
GQA_HEAD_DIM = 64
MLA_HEADS = 8
MLA_Q_LORA = 384
MLA_KV_LORA = 256
MLA_NOPE = 64
MLA_ROPE = 32
MLA_V = 64
FFN_HIDDEN = ((8 * D_MODEL // 3 + 255) // 256) * 256
ROPE_THETA = 10000.0
NORM_EPS = 1e-6
Q_BLOCK = 128
N_MOD = 6
CONV_IN = 3 * SC_WIDTH + 2 * CF_WIDTH
CONV_MIX = SC_WIDTH + CF_WIDTH
GQA_Q = GQA_HEADS * GQA_HEAD_DIM
GQA_KV = GQA_KV_HEADS * GQA_HEAD_DIM
ATTN_IN = GQA_Q + 2 * GQA_KV + MLA_Q_LORA + MLA_KV_LORA + MLA_ROPE
ATTN_MIX = GQA_Q + MLA_HEADS * MLA_V

kernel_name = "hybrid_diffusion_prefix_step"


def _rmsnorm(x, g):
    xf = x.astype(jnp.float32)
    y = xf * lax.rsqrt(jnp.mean(xf * xf, axis=-1, keepdims=True) + NORM_EPS)
    return (y * g.astype(jnp.float32)).astype(x.dtype)


def _layernorm(x, g, b):
    xf = x.astype(jnp.float32)
    mu = jnp.mean(xf, axis=-1, keepdims=True)
    var = jnp.mean(jnp.square(xf - mu), axis=-1, keepdims=True)
    y = (xf - mu) * lax.rsqrt(var + NORM_EPS)
    return (y * g.astype(jnp.float32) + b.astype(jnp.float32)).astype(x.dtype)


def _adaln(cvec, w, b):
    m = jax.nn.silu(cvec) @ w + b
    return m.reshape(cvec.shape[0], N_MOD, D_MODEL)


def _modulate(h, shift, scale):
    return h * (1.0 + scale[:, None, :]) + shift[:, None, :]


def _rope_1d(x, pos):
    d = x.shape[-1]
    inv = ROPE_THETA ** (-jnp.arange(0, d, 2, dtype=jnp.float32) / d)
    ang = pos[:, None] * inv[None, :]
    cos = jnp.cos(ang)[:, None, :]
    sin = jnp.sin(ang)[:, None, :]
    xf = x.astype(jnp.float32)
    x1, x2 = xf[..., : d // 2], xf[..., d // 2:]
    return jnp.concatenate([x1 * cos - x2 * sin, x2 * cos + x1 * sin], axis=-1).astype(x.dtype)


def _rope_2d(x, pos):
    row, col = pos
    half = x.shape[-1] // 2
    return jnp.concatenate([_rope_1d(x[..., :half], row), _rope_1d(x[..., half:], col)], axis=-1)


def _depthwise_conv(x, w):
    width = w.shape[0]
    pad = (width - 1) // 2
    return lax.conv_general_dilated(x, w[:, None, :].astype(x.dtype), window_strides=(1,),
                                    padding=[(pad, width - 1 - pad)],
                                    dimension_numbers=("NWC", "WIO", "NWC"),
                                    feature_group_count=x.shape[-1])


def _conv_mixers(h, w_in, sc_w, cf_b_in, cf_dw_w, cf_dw_b, cf_ln_g, cf_ln_b, w_out, b_out):
    u = h @ w_in
    gate_b = u[..., :SC_WIDTH]
    gate_c = u[..., SC_WIDTH:2 * SC_WIDTH]
    xa = u[..., 2 * SC_WIDTH:3 * SC_WIDTH]
    ub = u[..., 3 * SC_WIDTH:] + cf_b_in
    ya = gate_b * _depthwise_conv(gate_c * xa, sc_w)
    z = ub[..., :CF_WIDTH] * jax.nn.sigmoid(ub[..., CF_WIDTH:])
    z = _depthwise_conv(z, cf_dw_w) + cf_dw_b
    z = jax.nn.silu(_layernorm(z, cf_ln_g, cf_ln_b))
    return jnp.concatenate([ya, z], axis=-1) @ w_out + b_out


def _attn_project(h, w_in, q_norm, k_norm, q_a_norm, w_q_b, kv_a_norm, pos):
    bsz, length, _ = h.shape
    u = h @ w_in
    o1, o2, o3 = GQA_Q, GQA_Q + GQA_KV, GQA_Q + 2 * GQA_KV
    o4 = o3 + MLA_Q_LORA
    q = _rmsnorm(u[..., :o1].reshape(bsz, length, GQA_HEADS, GQA_HEAD_DIM), q_norm)
    k = _rmsnorm(u[..., o1:o2].reshape(bsz, length, GQA_KV_HEADS, GQA_HEAD_DIM), k_norm)
    v = u[..., o2:o3].reshape(bsz, length, GQA_KV_HEADS, GQA_HEAD_DIM)
    mq = (_rmsnorm(u[..., o3:o4], q_a_norm) @ w_q_b).reshape(bsz, length, MLA_HEADS, MLA_NOPE + MLA_ROPE)
    kva = u[..., o4:]
    ckv = _rmsnorm(kva[..., :MLA_KV_LORA], kv_a_norm)
    kr = kva[..., MLA_KV_LORA:]
    if pos is not None:
        q = _rope_2d(q, pos)
        k = _rope_2d(k, pos)
        mq = jnp.concatenate([mq[..., :MLA_NOPE], _rope_2d(mq[..., MLA_NOPE:], pos)], axis=-1)
        kr = _rope_2d(kr[:, :, None, :], pos)[:, :, 0, :]
    return q, k, v, mq, ckv, kr


def _mla_expand(ckv, kr, w_kv_b):
    bsz, t, _ = ckv.shape
    kv = (ckv @ w_kv_b).reshape(bsz, t, MLA_HEADS, MLA_NOPE + MLA_V)
    k_rope = jnp.broadcast_to(kr[:, :, None, :], (bsz, t, MLA_HEADS, MLA_ROPE))
    k = jnp.concatenate([kv[..., :MLA_NOPE], k_rope], axis=-1)
    return k, kv[..., MLA_NOPE:]


def _attend(q, k, v, scale):
    bsz, s, hk, g, dk = q.shape
    nb = s // Q_BLOCK
    qb = q.reshape(bsz, nb, Q_BLOCK, hk, g, dk).transpose(1, 0, 2, 3, 4, 5)

    def one_block(qblk):
        sc = jnp.einsum("bqhgd,bthd->bhgqt", qblk, k, preferred_element_type=jnp.float32) * scale
        p = jax.nn.softmax(sc, axis=-1).astype(v.dtype)
        return jnp.einsum("bhgqt,bthd->bqhgd", p, v)

    o = lax.map(one_block, qb)
    return o.transpose(1, 0, 2, 3, 4, 5).reshape(bsz, s, hk * g * v.shape[-1])


def _attn_merge(qc, kc, vc, qm, km, vm, w_out):
    bsz, s = qc.shape[0], qc.shape[1]
    qc5 = qc.reshape(bsz, s, GQA_KV_HEADS, GQA_HEADS // GQA_KV_HEADS, GQA_HEAD_DIM)
    oc = _attend(qc5, kc, vc, GQA_HEAD_DIM ** -0.5)
    om = _attend(qm[:, :, :, None, :], km, vm, (MLA_NOPE + MLA_ROPE) ** -0.5)
    return jnp.concatenate([oc, om], axis=-1) @ w_out


def _swiglu(h, wg, wu, wd):
    return (jax.nn.silu(h @ wg) * (h @ wu)) @ wd


def setup_inputs(seed: int = 0) -> dict:
    key = jax.random.key(seed)
    ks = iter(jax.random.split(key, 40))
    f32 = jnp.float32

    def nrm(shape, scale=1.0):
        return jax.random.normal(next(ks), shape, f32) * scale

    def gain(shape):
        return 1.0 + nrm(shape, 0.05)

    na, nc = N_ATTN_LAYERS, N_CONV_LAYERS
    return {
        "x_prompt": nrm((BATCH, SEQ, D_MODEL)),
        "x_sample": nrm((DEC_BATCH, DEC_SEQ, D_MODEL)),
        "cache_gqa_k": nrm((DEC_BATCH, na, PAST_LEN, GQA_KV_HEADS, GQA_HEAD_DIM)),
        "cache_gqa_v": nrm((DEC_BATCH, na, PAST_LEN, GQA_KV_HEADS, GQA_HEAD_DIM)),
        "cache_mla_ckv": nrm((DEC_BATCH, na, PAST_LEN, MLA_KV_LORA)),
        "cache_mla_krope": nrm((DEC_BATCH, na, PAST_LEN, MLA_ROPE)),
        "c": nrm((DEC_BATCH, D_MODEL)),
        "c_ctx": nrm((D_MODEL,)),
        "ada_w": nrm((DEPTH, D_MODEL, N_MOD * D_MODEL), 0.5 * D_MODEL ** -0.5),
        "ada_b": nrm((DEPTH, N_MOD * D_MODEL), 0.02),
        "norm_pre": gain((DEPTH, 2, D_MODEL)),
        "norm_post": gain((DEPTH, 2, D_MODEL)),
        "conv_w_in": nrm((nc, D_MODEL, CONV_IN), D_MODEL ** -0.5),
        "conv_sc_w": nrm((nc, SC_KERNEL, SC_WIDTH), SC_KERNEL ** -0.5),
        "conv_cf_b_in": nrm((nc, 2 * CF_WIDTH), 0.02),
        "conv_cf_dw_w": nrm((nc, CF_KERNEL, CF_WIDTH), CF_KERNEL ** -0.5),
        "conv_cf_dw_b": nrm((nc, CF_WIDTH), 0.02),
        "conv_cf_ln_g": gain((nc, CF_WIDTH)),
        "conv_cf_ln_b": nrm((nc, CF_WIDTH), 0.02),
        "conv_w_out": nrm((nc, CONV_MIX, D_MODEL), CONV_MIX ** -0.5),
        "conv_b_out": nrm((nc, D_MODEL), 0.02),
        "attn_w_in": nrm((na, D_MODEL, ATTN_IN), D_MODEL ** -0.5),
        "attn_q_norm": gain((na, GQA_HEAD_DIM)),
        "attn_k_norm": gain((na, GQA_HEAD_DIM)),
        "attn_q_a_norm": gain((na, MLA_Q_LORA)),
        "attn_w_q_b": nrm((na, MLA_Q_LORA, MLA_HEADS * (MLA_NOPE + MLA_ROPE)), MLA_Q_LORA ** -0.5),
        "attn_kv_a_norm": gain((na, MLA_KV_LORA)),
        "attn_w_kv_b": nrm((na, MLA_KV_LORA, MLA_HEADS * (MLA_NOPE + MLA_V)), MLA_KV_LORA ** -0.5),
        "attn_w_out": nrm((na, ATTN_MIX, D_MODEL), ATTN_MIX ** -0.5),
        "ffn_w_gate": nrm((DEPTH, D_MODEL, FFN_HIDDEN), D_MODEL ** -0.5),
        "ffn_w_up": nrm((DEPTH, D_MODEL, FFN_HIDDEN), D_MODEL ** -0.5),
        "ffn_w_down": nrm((DEPTH, FFN_HIDDEN, D_MODEL), FFN_HIDDEN ** -0.5),
    }


def reference(x_prompt, x_sample, cache_gqa_k, cache_gqa_v, cache_mla_ckv, cache_mla_krope, c, c_ctx,
              ada_w, ada_b, norm_pre, norm_post,
              conv_w_in, conv_sc_w, conv_cf_b_in, conv_cf_dw_w, conv_cf_dw_b, conv_cf_ln_g, conv_cf_ln_b,
              conv_w_out, conv_b_out,
              attn_w_in, attn_q_norm, attn_k_norm, attn_q_a_norm, attn_w_q_b, attn_kv_a_norm, attn_w_kv_b,
              attn_w_out, ffn_w_gate, ffn_w_up, ffn_w_down):
    length = x_sample.shape[1]
    rows = length // GRID_W
    lat_pos = (jnp.repeat(jnp.arange(rows, dtype=jnp.float32), GRID_W),
               jnp.tile(jnp.arange(GRID_W, dtype=jnp.float32), rows))
    xp, xs = x_prompt, x_sample
    new_k, new_v, new_ckv, new_kr = [], [], [], []
    for l in range(DEPTH):
        mp = _adaln(c_ctx[None, :].astype(xp.dtype), ada_w[l], ada_b[l])
        ms = _adaln(c, ada_w[l], ada_b[l])
        hp = _modulate(_rmsnorm(xp, norm_pre[l, 0]), mp[:, 0], mp[:, 1])
        hs = _modulate(_rmsnorm(xs, norm_pre[l, 0]), ms[:, 0], ms[:, 1])
        j = l // 2
        if l % 2 == 0:
            cargs = (conv_w_in[j], conv_sc_w[j], conv_cf_b_in[j], conv_cf_dw_w[j], conv_cf_dw_b[j],
                     conv_cf_ln_g[j], conv_cf_ln_b[j], conv_w_out[j], conv_b_out[j])
            op = _conv_mixers(hp, *cargs)
            os_ = _conv_mixers(hs, *cargs)
        else:
            pargs = (attn_w_in[j], attn_q_norm[j], attn_k_norm[j], attn_q_a_norm[j], attn_w_q_b[j],
                     attn_kv_a_norm[j])
            qc, kc, vc, qm, ckv, kr = _attn_project(hp, *pargs, None)
            new_k.append(kc)
            new_v.append(vc)
            new_ckv.append(ckv)
            new_kr.append(kr)
            km, vm = _mla_expand(ckv, kr, attn_w_kv_b[j])
            op = _attn_merge(qc, kc, vc, qm, km, vm, attn_w_out[j])
            qcs, kcs, vcs, qms, ckvs, krs = _attn_project(hs, *pargs, lat_pos)
            kc_all = jnp.concatenate([cache_gqa_k[:, j].astype(kcs.dtype), kcs], axis=1)
            vc_all = jnp.concatenate([cache_gqa_v[:, j].astype(vcs.dtype), vcs], axis=1)
            ckv_all = jnp.concatenate([cache_mla_ckv[:, j].astype(ckvs.dtype), ckvs], axis=1)
            kr_all = jnp.concatenate([cache_mla_krope[:, j].astype(krs.dtype), krs], axis=1)
            kms, vms = _mla_expand(ckv_all, kr_all, attn_w_kv_b[j])
            os_ = _attn_merge(qcs, kc_all, vc_all, qms, kms, vms, attn_w_out[j])
        xp = xp + mp[:, 2][:, None, :] * _rmsnorm(op, norm_post[l, 0])
        xs = xs + ms[:, 2][:, None, :] * _rmsnorm(os_, norm_post[l, 0])
        fp = _modulate(_rmsnorm(xp, norm_pre[l, 1]), mp[:, 3], mp[:, 4])
        fs = _modulate(_rmsnorm(xs, norm_pre[l, 1]), ms[:, 3], ms[:, 4])
        xp = xp + mp[:, 5][:, None, :] * _rmsnorm(_swiglu(fp, ffn_w_gate[l], ffn_w_up[l], ffn_w_down[l]), norm_post[l, 1])
        xs = xs + ms[:, 5][:, None, :] * _rmsnorm(_swiglu(fs, ffn_w_gate[l], ffn_w_up[l], ffn_w_down[l]), norm_post[l, 1])
    return (xp, xs, jnp.stack(new_k, axis=1), jnp.stack(new_v, axis=1), jnp.stack(new_ckv, axis=1), jnp.stack(new_kr, axis=1))
```

```cpp
#include <hip/hip_runtime.h>
#include <hip/hip_cooperative_groups.h>
#include <cstdio>
#include <cstdint>
namespace cg = cooperative_groups;
namespace pg8 {
#define PG8_LAS __attribute__((address_space(3)))
typedef unsigned short bf16_t;
typedef short bf16x8 __attribute__((ext_vector_type(8)));
typedef float f32x4 __attribute__((ext_vector_type(4)));
typedef unsigned u32x4 __attribute__((ext_vector_type(4)));
constexpr int BM = 256, BK = 64, HALF = 128, HTB = HALF * BK * 2  , STAGE_BYTES = 8 * HTB, NXCD = 8, WGM = 8;

__host__ __device__ __forceinline__ int lds_byte(int r, int c) { const int st = (r >> 4) * 2 + (c >> 5), rr = r & 15, cc = c & 31, ob = rr * 64 + cc * 2; return st * 1024 + (ob ^ (((ob >> 9) & 1) << 5)); }
__host__ __device__ __forceinline__ void stage_rc(int b, int& R, int& C) { const int st = b / 1024, sb = b % 1024, swz = sb ^ (((sb >> 9) & 1) << 5); R = (st >> 1) * 16 + swz / 64; C = (st & 1) * 32 + (swz % 64) / 2; }
__host__ __device__ __forceinline__ int perm32(int rho) { const int n = rho >> 4, i = rho & 15; return 8 * (i >> 2) + 4 * n + (i & 3); }

struct Unit { int pm, pn; };
struct Gemm { const bf16_t* A; const bf16_t* Bt; int M, N, K; };

struct StaticOrder {
    int nM, nN, nwg, G, c;
    __host__ __device__ void init(int M, int N, int G_, int c_) { nM = M / BM; nN = N / BM; nwg = nM * nN; G = G_; c = c_; }
    __host__ __device__ bool next(int i, Unit& u) const {
        const long L = (long)i * G + c; if (L >= nwg) return false;
        int wgid = (int)L; { const int q = nwg / NXCD, r = nwg % NXCD, xcd = wgid % NXCD, off = wgid / NXCD; wgid = (xcd < r ? xcd * (q + 1) : r * (q + 1) + (xcd - r) * q) + off; }
        const int nig = WGM * nN, gid = wgid / nig, fm = gid * WGM, gsz = (nM - fm) < WGM ? (nM - fm) : WGM;
        u.pm = fm + ((wgid % nig) % gsz); u.pn = (wgid % nig) / gsz; return true;
    }
    __device__ __forceinline__ void a_ready(const Unit&) const {}
    __device__ __forceinline__ void done(const Unit&) const {}
};

__device__ __forceinline__ unsigned cvt_pk_bf16(float lo, float hi) { unsigned r; asm volatile("v_cvt_pk_bf16_f32 %0, %1, %2" : "=v"(r) : "v"(lo), "v"(hi)); return r; }
template <class Epi, class Sched, bool ALIGN_EPI = false, bool SP2 = false>
__device__ __forceinline__ void gemm_phase(PG8_LAS unsigned char* lds, const Gemm g, const Sched& S, const Epi& E) {
    const int tid = threadIdx.x, wid = __builtin_amdgcn_readfirstlane(tid >> 6), lane = tid & 63, wr = wid >> 2, wc = wid & 3, fr = lane & 15, fq = lane >> 4;
    const int K = g.K, nt = K / BK;
    unsigned voffA[2], voffB[2];
#pragma unroll
    for (int i = 0; i < 2; ++i) { int R, C; stage_rc(tid * 16 + i * 8192, R, C); const int Rb = Epi::PERM ? ((R & ~31) + perm32(R & 31)) : R;
        voffA[i] = (unsigned)(R * K + C) * 2u; voffB[i] = (unsigned)(Rb * K + C) * 2u; }
    const size_t kstep = (size_t)(BK * 2);
    const size_t hstep = (size_t)HALF * K * 2;
    const size_t tstep = 2 * hstep;
    const unsigned ldsw = (unsigned)wid * 1024u;
    const int aoff = lds_byte(wr * 64 + fr, fq * 8), boff = lds_byte(wc * 32 + fr, fq * 8);
#define PG8_SA(b, h) (((b) * 2 + (h)) * HTB)
#define PG8_SB(b, h) ((4 + (b) * 2 + (h)) * HTB)
#define PG8_STAGE(bufoff, gbase, voff) do { _Pragma("unroll") for (int _i = 0; _i < 2; ++_i) \
        __builtin_amdgcn_global_load_lds((const unsigned*)((const char*)(gbase) + (voff)[_i]), (PG8_LAS unsigned*)(lds + (bufoff) + ldsw + _i * 8192), 16, 0, 0); } while (0)
#define PG8_LDA(dst, b, h) do { _Pragma("unroll") for (int m = 0; m < 4; ++m) _Pragma("unroll") for (int k = 0; k < 2; ++k) dst[m][k] = *(const PG8_LAS bf16x8*)(lds + PG8_SA(b, h) + aoff + m * 2048 + k * 1024); } while (0)
#define PG8_LDB(dst, b, h) do { _Pragma("unroll") for (int n = 0; n < 2; ++n) _Pragma("unroll") for (int k = 0; k < 2; ++k) dst[n][k] = *(const PG8_LAS bf16x8*)(lds + PG8_SB(b, h) + boff + n * 2048 + k * 1024); } while (0)
#define PG8_MMA(ai, bj, At, Bt) do { __builtin_amdgcn_s_setprio(1); _Pragma("unroll") for (int m = 0; m < 4; ++m) _Pragma("unroll") for (int n = 0; n < 2; ++n) _Pragma("unroll") for (int k = 0; k < 2; ++k) \
        acc[ai][bj][m][n] = __builtin_amdgcn_mfma_f32_16x16x32_bf16(Bt[n][k], At[m][k], acc[ai][bj][m][n], 0, 0, 0); __builtin_amdgcn_s_setprio(0); } while (0)
#define PG8_WAIT_V(n) asm volatile("s_waitcnt vmcnt(" #n ")" ::: "memory")
#define PG8_WAIT_L(n) asm volatile("s_waitcnt lgkmcnt(" #n ")" ::: "memory")
#define PG8_BAR __builtin_amdgcn_s_barrier()
#define PG8_SCHED __builtin_amdgcn_sched_barrier(0)
    Unit cur, nxt; int ui = 0;
    if (!S.next(0, cur)) return;
    f32x4 acc[2][2][4][2];
#pragma unroll
    for (int a = 0; a < 2; ++a)
#pragma unroll
        for (int b = 0; b < 2; ++b)
#pragma unroll
            for (int m = 0; m < 4; ++m)
#pragma unroll
                for (int n = 0; n < 2; ++n) acc[a][b][m][n] = (f32x4){0.f, 0.f, 0.f, 0.f};
    bf16x8 At[4][2], B0[2][2], B1[2][2];
    const char* cA = (const char*)g.A + (size_t)cur.pm * tstep; const char* cB = (const char*)g.Bt + (size_t)cur.pn * tstep;
    S.a_ready(cur);
    if constexpr (SP2) {
        PG8_STAGE(PG8_SB(0, 0), cB, voffB); PG8_STAGE(PG8_SB(0, 1), cB + hstep, voffB); PG8_STAGE(PG8_SA(0, 0), cA, voffA); PG8_STAGE(PG8_SA(0, 1), cA + hstep, voffA);
        if (wr == 1) PG8_BAR;
        PG8_WAIT_V(2); PG8_BAR;
        PG8_STAGE(PG8_SB(1, 0), cB + kstep, voffB); PG8_STAGE(PG8_SA(1, 0), cA + kstep, voffA); PG8_STAGE(PG8_SB(1, 1), cB + hstep + kstep, voffB);
        PG8_WAIT_V(6); PG8_BAR;
    } else {
        PG8_STAGE(PG8_SB(0, 0), cB, voffB); PG8_STAGE(PG8_SA(0, 0), cA, voffA); PG8_STAGE(PG8_SB(0, 1), cB + hstep, voffB); PG8_STAGE(PG8_SA(0, 1), cA + hstep, voffA);
        if (wr == 1) PG8_BAR;
        PG8_WAIT_V(4); PG8_BAR;
        PG8_STAGE(PG8_SB(1, 0), cB + kstep, voffB); PG8_STAGE(PG8_SA(1, 0), cA + kstep, voffA); PG8_STAGE(PG8_SB(1, 1), cB + hstep + kstep, voffB);
        PG8_WAIT_V(6); PG8_BAR;
    }
    for (;;) {
        const bool has_next = S.next(ui + 1, nxt);
        const char* nA = has_next ? (const char*)g.A + (size_t)nxt.pm * tstep : cA; const char* nB = has_next ? (const char*)g.Bt + (size_t)nxt.pn * tstep : cB;
        for (int t = 0; t < nt; t += 2) {
            const bool last = (t == nt - 2);
            const char* a1 = cA + (size_t)(t + 1) * kstep;
            const char* a2 = last ? nA : cA + (size_t)(t + 2) * kstep; const char* b2 = last ? nB : cB + (size_t)(t + 2) * kstep;
            const char* a3 = a2 + kstep; const char* b3 = b2 + kstep;
            if (last && has_next) S.a_ready(nxt);
            if constexpr (SP2) {
            PG8_LDB(B0, 0, 0); PG8_LDB(B1, 0, 1); PG8_SCHED; PG8_LDA(At, 0, 0); PG8_STAGE(PG8_SA(1, 1), a1 + hstep, voffA);
            PG8_WAIT_V(8); PG8_WAIT_L(0); PG8_BAR; PG8_MMA(0, 0, At, B0); PG8_MMA(0, 1, At, B1); PG8_BAR; PG8_SCHED;
            PG8_LDA(At, 0, 1); PG8_STAGE(PG8_SB(0, 0), b2, voffB); PG8_STAGE(PG8_SB(0, 1), b2 + hstep, voffB); PG8_STAGE(PG8_SA(0, 0), a2, voffA);
            PG8_WAIT_V(8); PG8_WAIT_L(0); PG8_BAR; PG8_MMA(1, 0, At, B0); PG8_MMA(1, 1, At, B1); PG8_BAR; PG8_SCHED;
            PG8_LDB(B0, 1, 0); PG8_LDB(B1, 1, 1); PG8_SCHED; PG8_LDA(At, 1, 0); PG8_STAGE(PG8_SA(0, 1), a2 + hstep, voffA);
            PG8_WAIT_V(8); PG8_WAIT_L(0); PG8_BAR; PG8_MMA(0, 0, At, B0); PG8_MMA(0, 1, At, B1); PG8_BAR; PG8_SCHED;
            PG8_LDA(At, 1, 1); PG8_STAGE(PG8_SB(1, 0), b3, voffB); PG8_STAGE(PG8_SB(1, 1), b3 + hstep, voffB); PG8_STAGE(PG8_SA(1, 0), a3, voffA);
            PG8_WAIT_V(8); PG8_WAIT_L(0); PG8_BAR; PG8_MMA(1, 0, At, B0); PG8_MMA(1, 1, At, B1); PG8_BAR; PG8_SCHED;
            } else {
            PG8_LDB(B0, 0, 0); PG8_SCHED; PG8_LDA(At, 0, 0); PG8_STAGE(PG8_SA(1, 1), a1 + hstep, voffA);
            PG8_WAIT_L(8); PG8_BAR; PG8_WAIT_L(0); PG8_MMA(0, 0, At, B0); PG8_BAR; PG8_SCHED;
            PG8_LDB(B1, 0, 1); PG8_STAGE(PG8_SB(0, 0), b2, voffB);
            PG8_BAR; PG8_WAIT_L(0); PG8_MMA(0, 1, At, B1); PG8_BAR;
            PG8_LDA(At, 0, 1); PG8_STAGE(PG8_SA(0, 0), a2, voffA);
            PG8_BAR; PG8_WAIT_L(0); PG8_MMA(1, 0, At, B0); PG8_BAR; PG8_SCHED;
            PG8_STAGE(PG8_SB(0, 1), b2 + hstep, voffB);
            PG8_WAIT_V(6); PG8_BAR; PG8_MMA(1, 1, At, B1); PG8_BAR;
            PG8_LDB(B0, 1, 0); PG8_SCHED; PG8_LDA(At, 1, 0); PG8_STAGE(PG8_SA(0, 1), a2 + hstep, voffA);
            PG8_WAIT_L(8); PG8_BAR; PG8_WAIT_L(0); PG8_MMA(0, 0, At, B0); PG8_BAR; PG8_SCHED;
            PG8_LDB(B1, 1, 1); PG8_STAGE(PG8_SB(1, 0), b3, voffB);
            PG8_BAR; PG8_WAIT_L(0); PG8_MMA(0, 1, At, B1); PG8_BAR;
            PG8_LDA(At, 1, 1); PG8_STAGE(PG8_SA(1, 0), a3, voffA);
            PG8_BAR; PG8_WAIT_L(0); PG8_MMA(1, 0, At, B0); PG8_BAR; PG8_SCHED;
            PG8_STAGE(PG8_SB(1, 1), b3 + hstep, voffB);
            PG8_WAIT_V(6); PG8_BAR; PG8_MMA(1, 1, At, B1); PG8_BAR;
            }
        }
        if constexpr (ALIGN_EPI) { if (wr == 0) PG8_BAR; }
        if constexpr (!Epi::AFTER_DRAIN) { E(acc, cur, wr, wc, fr, fq); S.done(cur); }
        if (!has_next) break;
#pragma unroll
        for (int a = 0; a < 2; ++a)
#pragma unroll
            for (int b = 0; b < 2; ++b)
#pragma unroll
                for (int m = 0; m < 4; ++m)
#pragma unroll
                    for (int n = 0; n < 2; ++n) acc[a][b][m][n] = (f32x4){0.f, 0.f, 0.f, 0.f};
        cur = nxt; cA = nA; cB = nB; ++ui;
        if constexpr (ALIGN_EPI) { if (wr == 1) PG8_BAR; }
    }
    PG8_WAIT_V(0);
    if constexpr (!ALIGN_EPI) { if (wr == 0) PG8_BAR; }
    PG8_BAR;
    if constexpr (Epi::AFTER_DRAIN) { E.fused(acc, cur, wr, wc, fr, fq, lds, wid, lane); S.done(cur); }
#undef PG8_SA
#undef PG8_SB
#undef PG8_STAGE
#undef PG8_LDA
#undef PG8_LDB
#undef PG8_MMA
#undef PG8_WAIT_V
#undef PG8_WAIT_L
#undef PG8_BAR
#undef PG8_SCHED
}
}

#define LAS __attribute__((address_space(3)))
typedef unsigned short bf16;
typedef float f32x4 __attribute__((ext_vector_type(4)));
typedef float f32x2 __attribute__((ext_vector_type(2)));
typedef float f32x16 __attribute__((ext_vector_type(16)));
typedef short bf16x8 __attribute__((ext_vector_type(8)));
typedef unsigned u32x4 __attribute__((ext_vector_type(4)));
typedef unsigned u32x2 __attribute__((ext_vector_type(2)));

constexpr int DM = 1024, TP = 4096, TS = 16384, T = TP + TS, SEQS = 2048, NBS = 8, PAST = 256;
constexpr int KSEQ = PAST + SEQS;
constexpr int TK = TP + NBS * KSEQ;
constexpr int FFN = 2816, CIN = 2560, AIN = 1440, AINP = 1536, QL = 384, KVL = 256, MQD = 768;
constexpr float EPS = 1e-6f;
constexpr int NWAVES = 8, NTHR = 512;
constexpr int LDS_BYTES = 147456;

constexpr size_t MiB = (size_t)1 << 20;
constexpr size_t al256(size_t x) { return (x + 255) & ~(size_t)255; }
constexpr size_t WS_CTL = 0;
constexpr size_t WS_MOD = 1 * MiB;
constexpr size_t WS_TABG = WS_MOD + al256((size_t)2 * 9 * 6144 * 4);
constexpr size_t WS_TABM = WS_TABG + al256(64 * 16 * 8);
constexpr size_t WS_BCIN = WS_TABM + al256(64 * 8 * 8);
constexpr size_t WS_WCIN = 2 * MiB;
constexpr size_t WS_WCOUT = WS_WCIN + (size_t)2560 * 1024 * 2;
constexpr size_t WS_WGU0 = WS_WCOUT + (size_t)1024 * 1024 * 2;
constexpr size_t WS_WD0 = WS_WGU0 + (size_t)5632 * 1024 * 2;
constexpr size_t WS_WGU1 = WS_WD0 + (size_t)1024 * 2816 * 2;
constexpr size_t WS_WD1 = WS_WGU1 + (size_t)5632 * 1024 * 2;
constexpr size_t WS_WAIN = WS_WD1 + (size_t)1024 * 2816 * 2;
constexpr size_t WS_WQB = WS_WAIN + (size_t)1536 * 1024 * 2;
constexpr size_t WS_WKN = WS_WQB + (size_t)768 * 384 * 2;
constexpr size_t WS_WVT = WS_WKN + (size_t)512 * 256 * 2;
constexpr size_t WS_WAOUT = WS_WVT + (size_t)512 * 256 * 2;
constexpr size_t WS_WEND = WS_WAOUT + (size_t)1024 * 1024 * 2;
constexpr size_t WS_A = 50 * MiB;
constexpr size_t WS_B = 90 * MiB;
constexpr size_t WS_C = 130 * MiB;
constexpr size_t WS_END = 240 * MiB;
static_assert(WS_BCIN + 2560 * 4 <= WS_WCIN && WS_WEND <= WS_A, "ws map");
constexpr size_t A_QA = 0;
constexpr size_t A_CKV = A_QA + (size_t)T * QL * 2;
constexpr size_t A_KR = A_CKV + (size_t)TK * KVL * 2;
constexpr size_t A_KC = A_KR + (size_t)TK * 32 * 2;
constexpr size_t A_VTC = A_KC + (size_t)TK * 128 * 2;
static_assert(A_VTC + (size_t)128 * TK * 2 <= 40 * MiB, "region A");
constexpr size_t C_U1 = 0;
constexpr size_t C_QC = (size_t)T * AINP * 2;
constexpr size_t C_VTM = C_QC + (size_t)T * 512 * 2;
constexpr size_t C_MQ = 0;
constexpr size_t C_KN = (size_t)T * MQD * 2;
static_assert(C_KN + (size_t)TK * 512 * 2 <= C_QC && C_VTM + (size_t)512 * TK * 2 <= 110 * MiB, "region C");
constexpr size_t OUT_Y = 0, OUT_K = (size_t)T * DM, OUT_V = OUT_K + (size_t)TP * 128, OUT_CKV = OUT_V + (size_t)TP * 128, OUT_KR = OUT_CKV + (size_t)TP * 256;

__device__ __forceinline__ unsigned pk2(float lo, float hi) { return pg8::cvt_pk_bf16(lo, hi); }
__device__ __forceinline__ bf16 f2bf(float x) { return (bf16)(pk2(x, 0.f) & 0xffffu); }
__device__ __forceinline__ float bf2f(bf16 b) { return __uint_as_float((unsigned)b << 16); }
__device__ __forceinline__ float bflo(unsigned w) { return __uint_as_float(w << 16); }
__device__ __forceinline__ float bfhi(unsigned w) { return __uint_as_float(w & 0xffff0000u); }
__device__ __forceinline__ float wave_sum(float v) {
#pragma unroll
    for (int o = 1; o < 64; o <<= 1) v += __shfl_xor(v, o);
    return v;
}
__device__ __forceinline__ float fsigmoid(float x) { return __builtin_amdgcn_rcpf(1.f + __builtin_amdgcn_exp2f(-1.4426950408889634f * x)); }
__device__ __forceinline__ float fsilu(float x) { return x * fsigmoid(x); }
__device__ __forceinline__ const float* xrow_in(const float* xp, const float* xs, int r) { return r < TP ? xp + (size_t)r * DM : xs + (size_t)(r - TP) * DM; }
__device__ __forceinline__ int cond_of(int r) { return r < TP ? 0 : 1 + ((r - TP) >> 11); }
__device__ __forceinline__ void unpack8(u32x4 w, float (&v)[8]) {
    v[0] = bflo(w.x); v[1] = bfhi(w.x); v[2] = bflo(w.y); v[3] = bfhi(w.y); v[4] = bflo(w.z); v[5] = bfhi(w.z); v[6] = bflo(w.w); v[7] = bfhi(w.w);
}
__device__ __forceinline__ u32x4 pack8(const float (&v)[8]) { u32x4 w; w.x = pk2(v[0], v[1]); w.y = pk2(v[2], v[3]); w.z = pk2(v[4], v[5]); w.w = pk2(v[6], v[7]); return w; }

struct EpiStore {
    static constexpr bool PERM = true, AFTER_DRAIN = false;
    bf16* O; int ldc; const float* bias;
    __device__ __forceinline__ void operator()(const f32x4 (&acc)[2][2][4][2], const pg8::Unit& u, int wr, int wc, int fr, int fq) const {
        const int row0 = u.pm * 256 + wr * 64 + fr, col0 = u.pn * 256 + wc * 32 + 8 * fq;
        f32x4 bv[2][2];
#pragma unroll
        for (int bj = 0; bj < 2; ++bj)
#pragma unroll
            for (int n = 0; n < 2; ++n) bv[bj][n] = bias ? *(const f32x4*)(bias + col0 + bj * 128 + 4 * n) : (f32x4){0.f, 0.f, 0.f, 0.f};
#pragma unroll
        for (int ai = 0; ai < 2; ++ai)
#pragma unroll
            for (int m = 0; m < 4; ++m) { bf16* rowp = O + (size_t)(row0 + ai * 128 + m * 16) * ldc + col0;
#pragma unroll
                for (int bj = 0; bj < 2; ++bj) { const f32x4 v0 = acc[ai][bj][m][0] + bv[bj][0], v1 = acc[ai][bj][m][1] + bv[bj][1];
                    u32x4 w; w.x = pk2(v0[0], v0[1]); w.y = pk2(v0[2], v0[3]); w.z = pk2(v1[0], v1[1]); w.w = pk2(v1[2], v1[3]);
                    *(u32x4*)(rowp + bj * 128) = w; } }
    }
};
struct EpiSwiGLU {
    static constexpr bool PERM = true, AFTER_DRAIN = false;
    bf16* O;
    __device__ __forceinline__ void operator()(const f32x4 (&acc)[2][2][4][2], const pg8::Unit& u, int wr, int wc, int fr, int fq) const {
        const int row0 = u.pm * 256 + wr * 64 + fr, col0 = u.pn * 128 + wc * 32 + 8 * fq;
#pragma unroll
        for (int ai = 0; ai < 2; ++ai)
#pragma unroll
            for (int m = 0; m < 4; ++m) { bf16* rowp = O + (size_t)(row0 + ai * 128 + m * 16) * FFN + col0;
                const f32x4 g0 = acc[ai][0][m][0], g1 = acc[ai][0][m][1], u0 = acc[ai][1][m][0], u1 = acc[ai][1][m][1];
                u32x4 w; w.x = pk2(fsilu(g0[0]) * u0[0], fsilu(g0[1]) * u0[1]); w.y = pk2(fsilu(g0[2]) * u0[2], fsilu(g0[3]) * u0[3]);
                w.z = pk2(fsilu(g1[0]) * u1[0], fsilu(g1[1]) * u1[1]); w.w = pk2(fsilu(g1[2]) * u1[2], fsilu(g1[3]) * u1[3]);
                *(u32x4*)rowp = w; }
    }
};
__device__ __forceinline__ void tr_item(const float* src, int ldw, bf16* WT, int K, int k0, int drow0, LAS float* scr, int lane) {
#pragma unroll 8
    for (int i = 0; i < 32; ++i) { const int kk = 2 * i + (lane >> 5); scr[kk * 33 + (lane & 31)] = src ? src[(size_t)(k0 + kk) * ldw] : 0.f; }
    asm volatile("s_waitcnt lgkmcnt(0)" ::: "memory");
    const int c = lane & 7;
#pragma unroll
    for (int j = 0; j < 4; ++j) { const int n = (lane >> 3) + 8 * j; const LAS float* s = scr + (8 * c) * 33 + n;
        u32x4 o; o.x = pk2(s[0 * 33], s[1 * 33]); o.y = pk2(s[2 * 33], s[3 * 33]); o.z = pk2(s[4 * 33], s[5 * 33]); o.w = pk2(s[6 * 33], s[7 * 33]);
        *(u32x4*)(WT + (size_t)(drow0 + n) * K + k0 + 8 * c) = o; }
    asm volatile("s_waitcnt lgkmcnt(0)" ::: "memory");
}

__device__ __forceinline__ void p0_weights(const float* const* in, unsigned char* ws, LAS float* scr, int gw, int ngw, int lane) {
    constexpr int I_CIN = 16 * 80, I_COUT = 16 * 32, I_GU = 16 * 176, I_D = 44 * 32, I_AIN = 16 * 48, I_QB = 6 * 24, I_KN = 4 * 16, I_AOUT = 16 * 32;
    constexpr int NITEMS = I_CIN + I_COUT + 2 * I_GU + 2 * I_D + I_AIN + I_QB + 2 * I_KN + I_AOUT;
    const int ln = lane & 31;
    for (int it = gw; it < NITEMS; it += ngw) {
        int r = it;
        if (r < I_CIN) { const int nblk = 80, kb = r / nblk, nb = r % nblk, n = 32 * nb + ln;
            tr_item(in[12] + n, CIN, (bf16*)(ws + WS_WCIN), 1024, 64 * kb, 32 * nb, scr, lane); continue; } r -= I_CIN;
        if (r < I_COUT) { const int nblk = 32, kb = r / nblk, nb = r % nblk, n = 32 * nb + ln;
            tr_item(in[19] + n, 1024, (bf16*)(ws + WS_WCOUT), 1024, 64 * kb, 32 * nb, scr, lane); continue; } r -= I_COUT;
        if (r < 2 * (I_GU + I_D)) { const int l = r >= (I_GU + I_D) ? 1 : 0; r -= l * (I_GU + I_D);
            if (r < I_GU) { const int nblk = 176, kb = r / nblk, nb = r % nblk, n = 32 * nb + ln, t = n >> 8, w = n & 255;
                const float* src = (w < 128 ? in[29] : in[30]) + (size_t)l * 1024 * FFN + 128 * t + (w & 127);
                tr_item(src, FFN, (bf16*)(ws + (l ? WS_WGU1 : WS_WGU0)), 1024, 64 * kb, 32 * nb, scr, lane); }
            else { r -= I_GU; const int nblk = 32, kb = r / nblk, nb = r % nblk, n = 32 * nb + ln;
                tr_item(in[31] + (size_t)l * FFN * 1024 + n, 1024, (bf16*)(ws + (l ? WS_WD1 : WS_WD0)), FFN, 64 * kb, 32 * nb, scr, lane); }
            continue; } r -= 2 * (I_GU + I_D);
        if (r < I_AIN) { const int nblk = 48, kb = r / nblk, nb = r % nblk, n = 32 * nb + ln;
            tr_item(n < AIN ? in[21] + n : nullptr, AIN, (bf16*)(ws + WS_WAIN), 1024, 64 * kb, 32 * nb, scr, lane); continue; } r -= I_AIN;
        if (r < I_QB) { const int nblk = 24, kb = r / nblk, nb = r % nblk, n = 32 * nb + ln, hh = n / 96, w = n % 96;
            int sc = n; if (w >= 64) { const int e = w - 64, blk = e >> 4, loc = e & 15; sc = hh * 96 + 64 + 16 * blk + 8 * (loc & 1) + (loc >> 1); }
            tr_item(in[25] + sc, MQD, (bf16*)(ws + WS_WQB), QL, 64 * kb, 32 * nb, scr, lane); continue; } r -= I_QB;
        if (r < I_KN) { const int nblk = 16, kb = r / nblk, nb = r % nblk, n = 32 * nb + ln;
            tr_item(in[27] + (n >> 6) * 128 + (n & 63), 1024, (bf16*)(ws + WS_WKN), KVL, 64 * kb, 32 * nb, scr, lane); continue; } r -= I_KN;
        if (r < I_KN) { const int nblk = 16, kb = r / nblk, nb = r % nblk, n = 32 * nb + ln;
            tr_item(in[27] + (n >> 6) * 128 + 64 + (n & 63), 1024, (bf16*)(ws + WS_WVT), KVL, 64 * kb, 32 * nb, scr, lane); continue; } r -= I_KN;
        { const int nblk = 32, kb = r / nblk, nb = r % nblk, n = 32 * nb + ln;
            tr_item(in[28] + n, 1024, (bf16*)(ws + WS_WAOUT), 1024, 64 * kb, 32 * nb, scr, lane); }
    }
}

__device__ __forceinline__ void p0_adaln(const float* const* in, unsigned char* ws, LAS unsigned char* lds, int tid, int wave, int lane, int G) {
    if ((int)blockIdx.x >= 192) return;
    LAS float* sS = (LAS float*)lds;
    LAS float* red = (LAS float*)(lds + 9 * 1024 * 4);
    float* MOD = (float*)(ws + WS_MOD);
    for (int i = tid; i < 9 * 1024; i += NTHR) { const int cnd = i >> 10, k = i & 1023; const float x = cnd == 0 ? in[7][k] : in[6][(cnd - 1) * 1024 + k]; sS[i] = fsilu(x); }
    __syncthreads();
    for (int it = blockIdx.x; it < 192; it += G) {
        const int l = it / 96, n0 = 64 * (it % 96);
        const float* wp = in[8] + (size_t)l * 1024 * 6144 + n0 + lane;
        float acc[9];
#pragma unroll
        for (int c = 0; c < 9; ++c) acc[c] = 0.f;
        const int kb = 128 * wave;
#pragma unroll 4
        for (int k = kb; k < kb + 128; k += 4) {
            const float w0 = wp[(size_t)(k + 0) * 6144], w1 = wp[(size_t)(k + 1) * 6144], w2 = wp[(size_t)(k + 2) * 6144], w3 = wp[(size_t)(k + 3) * 6144];
#pragma unroll
            for (int c = 0; c < 9; ++c) { const f32x4 s = *(const LAS f32x4*)(sS + c * 1024 + k); acc[c] += s.x * w0 + s.y * w1 + s.z * w2 + s.w * w3; }
        }
#pragma unroll
        for (int c = 0; c < 9; ++c) red[(wave * 9 + c) * 64 + lane] = acc[c];
        __syncthreads();
        for (int idx = tid; idx < 576; idx += NTHR) { const int c = idx >> 6, ln = idx & 63; float s = in[9][l * 6144 + n0 + ln];
#pragma unroll
            for (int w = 0; w < 8; ++w) s += red[(w * 9 + c) * 64 + ln];
            MOD[(size_t)(l * 9 + c) * 6144 + n0 + ln] = s; }
        __syncthreads();
    }
}
__device__ __forceinline__ void p0_tables(const float* const* in, unsigned char* ws, int tid) {
    f32x2* tabg = (f32x2*)(ws + WS_TABG); f32x2* tabm = (f32x2*)(ws + WS_TABM); float* bcin = (float*)(ws + WS_BCIN);
    for (int i = tid; i < 64 * 16; i += NTHR) { const int pos = i >> 4, f = i & 15; const float inv = exp2f(-(float)f * (13.287712379549449f / 16.f)), a = (float)pos * inv; tabg[i] = (f32x2){__cosf(a), __sinf(a)}; }
    for (int i = tid; i < 64 * 8; i += NTHR) { const int pos = i >> 3, f = i & 7; const float inv = exp2f(-(float)f * (13.287712379549449f / 8.f)), a = (float)pos * inv; tabm[i] = (f32x2){__cosf(a), __sinf(a)}; }
    for (int i = tid; i < CIN; i += NTHR) bcin[i] = i < 1536 ? 0.f : in[14][i - 1536];
}

__device__ __forceinline__ void phase_norm_in(const float* xp, const float* xs, const float* gpre, const float* modl, int sidx, bf16* H, int gw, int ngw, int lane) {
    for (int r = gw; r < T; r += ngw) {
        const f32x4* x4 = (const f32x4*)xrow_in(xp, xs, r) + lane;
        f32x4 v[4]; float ss = 0.f;
#pragma unroll
        for (int j = 0; j < 4; ++j) { v[j] = x4[64 * j]; ss += (v[j].x * v[j].x + v[j].y * v[j].y) + (v[j].z * v[j].z + v[j].w * v[j].w); }
        const float rstd = rsqrtf(wave_sum(ss) * (1.f / DM) + EPS);
        const float* mb = modl + (size_t)cond_of(r) * 6144;
        const f32x4* g4 = (const f32x4*)gpre + lane; const f32x4* sh4 = (const f32x4*)(mb + sidx * DM) + lane; const f32x4* sc4 = (const f32x4*)(mb + (sidx + 1) * DM) + lane;
        u32x2* h2 = (u32x2*)(H + (size_t)r * DM) + lane;
#pragma unroll
        for (int j = 0; j < 4; ++j) { const f32x4 g = g4[64 * j], sh = sh4[64 * j], sc = sc4[64 * j]; const f32x4 o = v[j] * rstd * g * (1.f + sc) + sh;
            h2[64 * j] = (u32x2){pk2(o.x, o.y), pk2(o.z, o.w)}; }
    }
}
template <bool NEXT>
__device__ __forceinline__ void phase_post(const bf16* O, const float* xp, const float* xs, float* Y, const float* gpost, const float* modl, int gidx,
                                           const float* gpre_n, const float* modn, int sidx_n, bf16* H, int gw, int ngw, int lane) {
    for (int r = gw; r < T; r += ngw) {
        const u32x2* o2 = (const u32x2*)(O + (size_t)r * DM) + lane; const f32x4* x4 = (const f32x4*)xrow_in(xp, xs, r) + lane;
        f32x4 o[4], x[4]; float ss = 0.f;
#pragma unroll
        for (int j = 0; j < 4; ++j) { const u32x2 w = o2[64 * j]; o[j] = (f32x4){bflo(w.x), bfhi(w.x), bflo(w.y), bfhi(w.y)}; x[j] = x4[64 * j];
            ss += (o[j].x * o[j].x + o[j].y * o[j].y) + (o[j].z * o[j].z + o[j].w * o[j].w); }
        const float ro = rsqrtf(wave_sum(ss) * (1.f / DM) + EPS);
        const int cnd = cond_of(r);
        const f32x4* gp4 = (const f32x4*)gpost + lane; const f32x4* gt4 = (const f32x4*)(modl + (size_t)cnd * 6144 + gidx * DM) + lane;
        f32x4* y4 = (f32x4*)(Y + (size_t)r * DM) + lane; float s2 = 0.f;
#pragma unroll
        for (int j = 0; j < 4; ++j) { const f32x4 gp = gp4[64 * j], gt = gt4[64 * j]; x[j] = x[j] + gt * (o[j] * ro * gp); y4[64 * j] = x[j];
            s2 += (x[j].x * x[j].x + x[j].y * x[j].y) + (x[j].z * x[j].z + x[j].w * x[j].w); }
        if (NEXT) {
            const float rx = rsqrtf(wave_sum(s2) * (1.f / DM) + EPS);
            const float* mb = modn + (size_t)cnd * 6144;
            const f32x4* g4 = (const f32x4*)gpre_n + lane; const f32x4* sh4 = (const f32x4*)(mb + sidx_n * DM) + lane; const f32x4* sc4 = (const f32x4*)(mb + (sidx_n + 1) * DM) + lane;
            u32x2* h2 = (u32x2*)(H + (size_t)r * DM) + lane;
#pragma unroll
            for (int j = 0; j < 4; ++j) { const f32x4 g = g4[64 * j], sh = sh4[64 * j], sc = sc4[64 * j]; const f32x4 h = x[j] * rx * g * (1.f + sc) + sh;
                h2[64 * j] = (u32x2){pk2(h.x, h.y), pk2(h.z, h.w)}; }
        }
    }
}

__device__ __forceinline__ void phase_conv(const bf16* U, bf16* MIX, const float* sc_w, const float* dw_w, const float* dw_b, const float* ln_g, const float* ln_b,
                                           LAS unsigned char* lds, int tid, int wave, int lane, int G) {
    LAS float* zs = (LAS float*)lds;
    LAS float* stat = (LAS float*)(lds + 63 * 512 * 4);
    const int c = tid;
    float w[31];
#pragma unroll
    for (int j = 0; j < 31; ++j) w[j] = dw_w[j * 512 + c];
    const float bdw = dw_b[c], lg = ln_g[c], lb = ln_b[c], s0w = sc_w[c], s1w = sc_w[512 + c], s2w = sc_w[1024 + c];
    for (int ch = blockIdx.x; ch < T / 32; ch += G) {
        const int r0 = 32 * ch;
        const int sq0 = r0 < TP ? (r0 & ~255) : TP + ((r0 - TP) & ~2047), sq1 = sq0 + (r0 < TP ? 256 : 2048);
        {   const bf16* up = U + (size_t)(r0 - 15) * CIN + c;
#pragma unroll 8
            for (int j = 0; j < 62; ++j) { const int rr = r0 - 15 + j; const bool ok = rr >= sq0 && rr < sq1;
                const float a = bf2f(up[(size_t)j * CIN + 1536]), g = bf2f(up[(size_t)j * CIN + 2048]); zs[j * 512 + c] = ok ? a * fsigmoid(g) : 0.f; }
            zs[62 * 512 + c] = 0.f; }
        {   float win[31];
#pragma unroll
            for (int j = 0; j < 31; ++j) win[j] = zs[j * 512 + c];
#pragma unroll 1
            for (int t = 0; t < 32; ++t) { float a = bdw;
#pragma unroll
                for (int j = 0; j < 31; ++j) a += w[j] * win[j];
                const float nxt = zs[(t + 31) * 512 + c];
                zs[t * 512 + c] = a;
#pragma unroll
                for (int j = 0; j < 30; ++j) win[j] = win[j + 1];
                win[30] = nxt; } }
        __syncthreads();
#pragma unroll
        for (int q = 0; q < 4; ++q) { const int t = 4 * wave + q; float a = 0.f, b = 0.f;
#pragma unroll
            for (int k = 0; k < 8; ++k) { const float x = zs[t * 512 + lane + 64 * k]; a += x; b += x * x; }
            a = wave_sum(a); b = wave_sum(b);
            const float mean = a * (1.f / 512.f), var = fmaxf(b * (1.f / 512.f) - mean * mean, 0.f);
            if (lane == 0) { stat[2 * t] = mean; stat[2 * t + 1] = rsqrtf(var + EPS); } }
        __syncthreads();
        {   bf16* mp = MIX + (size_t)r0 * DM + 512 + c;
#pragma unroll 4
            for (int t = 0; t < 32; ++t) { const f32x2 ms = *(const LAS f32x2*)(stat + 2 * t); const float y = (zs[t * 512 + c] - ms.x) * ms.y * lg + lb;
                mp[(size_t)t * DM] = f2bf(fsilu(y)); } }
        {   const bf16* up = U + (size_t)(r0 - 1) * CIN + c;
#pragma unroll 8
            for (int j = 0; j < 34; ++j) { const int rr = r0 - 1 + j; const bool ok = rr >= sq0 && rr < sq1;
                const float gc = bf2f(up[(size_t)j * CIN + 512]), xa = bf2f(up[(size_t)j * CIN + 1024]); zs[j * 512 + c] = ok ? gc * xa : 0.f; }
            const bf16* gp = U + (size_t)r0 * CIN + c; bf16* mp = MIX + (size_t)r0 * DM + c;
#pragma unroll 8
            for (int t = 0; t < 32; ++t) { const float gb = bf2f(gp[(size_t)t * CIN]);
                mp[(size_t)t * DM] = f2bf(gb * (s0w * zs[t * 512 + c] + s1w * zs[(t + 1) * 512 + c] + s2w * zs[(t + 2) * 512 + c])); } }
        __syncthreads();
    }
}

__device__ __forceinline__ void rope_head64(float (&v)[8], int lane, int prow, int pcol, const f32x2* tabg) {
    const int pos = (lane & 4) ? pcol : prow, i0 = 8 * (lane & 1); const bool second = (lane & 2) != 0;
#pragma unroll
    for (int j = 0; j < 8; ++j) { const float pv = __shfl_xor(v[j], 2); const f32x2 cs = tabg[pos * 16 + i0 + j];
        v[j] = second ? v[j] * cs.x + pv * cs.y : v[j] * cs.x - pv * cs.y; }
}
__device__ __forceinline__ void phase_attn_rows(const bf16* U1, const float* qn, const float* kn, const float* qan, const float* kvan, const f32x2* tabg, const f32x2* tabm,
                                                bf16* QC, bf16* KC, bf16* VtC, bf16* QA, bf16* CKV, bf16* KR, float* o_k, float* o_v, float* o_ckv, float* o_kr,
                                                const float* c_k, const float* c_v, const float* c_ckv, const float* c_kr, int gw, int ngw, int lane) {
    for (int r = gw; r < T; r += ngw) {
        const bool smp = r >= TP; const int ts = (r - TP) & 2047, prow = ts >> 6, pcol = ts & 63;
        const int krow = smp ? TP + ((r - TP) >> 11) * KSEQ + PAST + ts : r;
        const bf16* u = U1 + (size_t)r * AINP;
        {
            float v[8]; unpack8(*(const u32x4*)(u + 8 * lane), v);
            float ss = 0.f;
#pragma unroll
            for (int j = 0; j < 8; ++j) ss += v[j] * v[j];
            ss += __shfl_xor(ss, 1); ss += __shfl_xor(ss, 2); ss += __shfl_xor(ss, 4);
            const float rstd = rsqrtf(ss * (1.f / 64.f) + EPS); const int d0 = 8 * (lane & 7);
#pragma unroll
            for (int j = 0; j < 8; ++j) v[j] = v[j] * rstd * qn[d0 + j];
            float vr[8];
#pragma unroll
            for (int j = 0; j < 8; ++j) vr[j] = v[j];
            rope_head64(vr, lane, prow, pcol, tabg);
#pragma unroll
            for (int j = 0; j < 8; ++j) v[j] = smp ? vr[j] : v[j];
            *(u32x4*)(QC + (size_t)r * 512 + 8 * lane) = pack8(v);
        }
        {
            const int l2 = lane & 31; float v[8], raw[8]; unpack8(*(const u32x4*)(u + 512 + 8 * l2), v);
            float ss = 0.f;
#pragma unroll
            for (int j = 0; j < 8; ++j) { raw[j] = v[j]; ss += v[j] * v[j]; }
            ss += __shfl_xor(ss, 1); ss += __shfl_xor(ss, 2); ss += __shfl_xor(ss, 4);
            const float rstd = rsqrtf(ss * (1.f / 64.f) + EPS); const int d0 = 8 * (lane & 7);
#pragma unroll
            for (int j = 0; j < 8; ++j) v[j] = v[j] * rstd * kn[d0 + j];
            if (lane < 16 && !smp) { float* ok = o_k + (size_t)r * 128 + 8 * lane; *(f32x4*)ok = (f32x4){v[0], v[1], v[2], v[3]}; *(f32x4*)(ok + 4) = (f32x4){v[4], v[5], v[6], v[7]}; }
            float vr[8];
#pragma unroll
            for (int j = 0; j < 8; ++j) vr[j] = v[j];
            rope_head64(vr, lane, prow, pcol, tabg);
#pragma unroll
            for (int j = 0; j < 8; ++j) v[j] = smp ? vr[j] : v[j];
            if (lane < 16) *(u32x4*)(KC + (size_t)krow * 128 + 8 * lane) = pack8(v);
            else if (lane < 32) { const int cv = 8 * (lane - 16);
#pragma unroll
                for (int j = 0; j < 8; ++j) VtC[(size_t)(cv + j) * TK + krow] = f2bf(raw[j]);
                if (!smp) { float* ov = o_v + (size_t)r * 128 + cv; *(f32x4*)ov = (f32x4){raw[0], raw[1], raw[2], raw[3]}; *(f32x4*)(ov + 4) = (f32x4){raw[4], raw[5], raw[6], raw[7]}; } }
        }
        {
            const int l3 = lane < 48 ? lane : 0; float v[8]; unpack8(*(const u32x4*)(u + 768 + 8 * l3), v);
            float ss = 0.f;
#pragma unroll
            for (int j = 0; j < 8; ++j) ss += v[j] * v[j];
            ss = wave_sum(lane < 48 ? ss : 0.f);
            const float rstd = rsqrtf(ss * (1.f / 384.f) + EPS);
#pragma unroll
            for (int j = 0; j < 8; ++j) v[j] = v[j] * rstd * qan[8 * l3 + j];
            if (lane < 48) *(u32x4*)(QA + (size_t)r * QL + 8 * lane) = pack8(v);
        }
        {
            const int l2 = lane & 31; float v[8]; unpack8(*(const u32x4*)(u + 1152 + 8 * l2), v);
            float ss = 0.f;
#pragma unroll
            for (int j = 0; j < 8; ++j) ss += v[j] * v[j];
            ss = wave_sum(lane < 32 ? ss : 0.f);
            const float rstd = rsqrtf(ss * (1.f / 256.f) + EPS);
#pragma unroll
            for (int j = 0; j < 8; ++j) v[j] = v[j] * rstd * kvan[8 * l2 + j];
            if (lane < 32) { *(u32x4*)(CKV + (size_t)krow * KVL + 8 * lane) = pack8(v);
                if (!smp) { float* oc = o_ckv + (size_t)r * 256 + 8 * lane; *(f32x4*)oc = (f32x4){v[0], v[1], v[2], v[3]}; *(f32x4*)(oc + 4) = (f32x4){v[4], v[5], v[6], v[7]}; } }
        }
        {
            const int l4 = lane & 3; float v[8]; unpack8(*(const u32x4*)(u + 1408 + 8 * l4), v);
            const int blk = l4 >> 1, pos = blk ? pcol : prow; const bool second = (l4 & 1) != 0;
            if (lane < 4 && !smp) { float* okr = o_kr + (size_t)r * 32 + 8 * lane; *(f32x4*)okr = (f32x4){v[0], v[1], v[2], v[3]}; *(f32x4*)(okr + 4) = (f32x4){v[4], v[5], v[6], v[7]}; }
#pragma unroll
            for (int j = 0; j < 8; ++j) { const float pv = __shfl_xor(v[j], 1); const f32x2 cs = tabm[pos * 8 + j];
                const float rv = second ? v[j] * cs.x + pv * cs.y : v[j] * cs.x - pv * cs.y; v[j] = smp ? rv : v[j]; }
            if (lane < 4) {
#pragma unroll
                for (int j = 0; j < 8; ++j) KR[(size_t)krow * 32 + 16 * blk + 2 * j + (second ? 1 : 0)] = f2bf(v[j]); }
        }
    }
    for (int cr = gw; cr < NBS * PAST; cr += ngw) {
        const int krow = TP + (cr >> 8) * KSEQ + (cr & 255);
        if (lane < 32) { const f32x4 k4 = *(const f32x4*)(c_k + (size_t)cr * 128 + 4 * lane); *(u32x2*)(KC + (size_t)krow * 128 + 4 * lane) = (u32x2){pk2(k4.x, k4.y), pk2(k4.z, k4.w)};
            const f32x4 v4 = *(const f32x4*)(c_v + (size_t)cr * 128 + 4 * lane);
            VtC[(size_t)(4 * lane + 0) * TK + krow] = f2bf(v4.x); VtC[(size_t)(4 * lane + 1) * TK + krow] = f2bf(v4.y);
            VtC[(size_t)(4 * lane + 2) * TK + krow] = f2bf(v4.z); VtC[(size_t)(4 * lane + 3) * TK + krow] = f2bf(v4.w);
            const int e = lane, blk = e >> 4, loc = e & 15; KR[(size_t)krow * 32 + 16 * blk + 2 * (loc & 7) + (loc >> 3)] = f2bf(c_kr[(size_t)cr * 32 + e]); }
        { const f32x4 c4 = *(const f32x4*)(c_ckv + (size_t)cr * 256 + 4 * lane); *(u32x2*)(CKV + (size_t)krow * KVL + 4 * lane) = (u32x2){pk2(c4.x, c4.y), pk2(c4.z, c4.w)}; }
    }
}

#define MFMA32(a, b, c) __builtin_amdgcn_mfma_f32_32x32x16_bf16((a), (b), (c), 0, 0, 0)
template <bool MLA>
__device__ __forceinline__ void attn_unit(LAS unsigned char* lds, const bf16* Q, int ldq, const bf16* K, int ldk, const bf16* KRp, const bf16* Vt, int nkeys, bf16* O, float c,
                                          const f32x2* tabm, int qpos0, int tid, int wave, int lane) {
    constexpr int NQ = MLA ? 6 : 4;
    constexpr int KB_SZ = 64 * 144, KR_OFF = 2 * KB_SZ, KR_SZ = 64 * 80, VT_OFF = KR_OFF + 2 * KR_SZ, VT_SZ = 64 * 136;
    const int r = lane & 31, h = lane >> 5;
    bf16x8 qf[NQ];
    { const bf16* qrow = Q + (size_t)(32 * wave + r) * ldq + 8 * h;
#pragma unroll
      for (int ks = 0; ks < NQ; ++ks) qf[ks] = *(const bf16x8*)(qrow + 16 * ks); }
    if (MLA && qpos0 >= 0) {
        const int ts = qpos0 + 32 * wave + r, prow = ts >> 6, pcol = ts & 63;
#pragma unroll
        for (int blk = 0; blk < 2; ++blk) { const u32x4 w = __builtin_bit_cast(u32x4, qf[NQ - 2 + blk]); float v[8]; unpack8(w, v); const int pos = blk ? pcol : prow;
#pragma unroll
            for (int jj = 0; jj < 4; ++jj) { const f32x2 cs = tabm[pos * 8 + 4 * h + jj]; const float x1 = v[2 * jj], x2 = v[2 * jj + 1]; v[2 * jj] = x1 * cs.x - x2 * cs.y; v[2 * jj + 1] = x2 * cs.x + x1 * cs.y; }
            qf[NQ - 2 + blk] = __builtin_bit_cast(bf16x8, pack8(v)); }
    }
    f32x16 o0, o1;
#pragma unroll
    for (int i = 0; i < 16; ++i) { o0[i] = 0.f; o1[i] = 0.f; }
    float m = -1e30f, l = 0.f;
    const int skey = tid >> 3, sch = tid & 7;
    const bf16* kg = K + (size_t)skey * ldk + 8 * sch;
    const bf16* vg = Vt + (size_t)skey * TK + 8 * sch;
    const bf16* rg = KRp + (size_t)(tid >> 2) * 32 + 8 * (tid & 3);
    const int kw = skey * 144 + sch * 16, vw = skey * 136 + sch * 16, rw = (tid >> 2) * 80 + (tid & 3) * 16;
    const int nt = nkeys >> 6;
    u32x4 kreg = *(const u32x4*)kg, vreg = *(const u32x4*)vg, rreg = (u32x4){0u, 0u, 0u, 0u};
    if (MLA && tid < 256) rreg = *(const u32x4*)rg;
    *(LAS u32x4*)(lds + kw) = kreg;
    *(LAS u32x2*)(lds + VT_OFF + vw) = (u32x2){vreg.x, vreg.y}; *(LAS u32x2*)(lds + VT_OFF + vw + 8) = (u32x2){vreg.z, vreg.w};
    if (MLA && tid < 256) *(LAS u32x4*)(lds + KR_OFF + rw) = rreg;
    __syncthreads();
    for (int j = 0; j < nt; ++j) {
        const int cur = j & 1; const bool more = j + 1 < nt;
        if (more) { kreg = *(const u32x4*)(kg + (size_t)(j + 1) * 64 * ldk); vreg = *(const u32x4*)(vg + (j + 1) * 64);
            if (MLA && tid < 256) rreg = *(const u32x4*)(rg + (size_t)(j + 1) * 64 * 32); }
        const LAS unsigned char* kb = lds + cur * KB_SZ; const LAS unsigned char* rb = lds + KR_OFF + cur * KR_SZ; const LAS unsigned char* vb = lds + VT_OFF + cur * VT_SZ;
        f32x16 p0, p1;
#pragma unroll
        for (int i = 0; i < 16; ++i) { p0[i] = 0.f; p1[i] = 0.f; }
#pragma unroll
        for (int ks = 0; ks < 4; ++ks) { const bf16x8 a0 = *(const LAS bf16x8*)(kb + r * 144 + ks * 32 + h * 16), a1 = *(const LAS bf16x8*)(kb + (32 + r) * 144 + ks * 32 + h * 16);
            p0 = MFMA32(a0, qf[ks], p0); p1 = MFMA32(a1, qf[ks], p1); }
        if (MLA) {
#pragma unroll
            for (int ks = 0; ks < 2; ++ks) { const bf16x8 a0 = *(const LAS bf16x8*)(rb + r * 80 + ks * 32 + h * 16), a1 = *(const LAS bf16x8*)(rb + (32 + r) * 80 + ks * 32 + h * 16);
                p0 = MFMA32(a0, qf[NQ - 2 + ks], p0); p1 = MFMA32(a1, qf[NQ - 2 + ks], p1); } }
        __builtin_amdgcn_sched_barrier(0);
        float mx = p0[0];
#pragma unroll
        for (int i = 1; i < 16; ++i) mx = fmaxf(mx, p0[i]);
#pragma unroll
        for (int i = 0; i < 16; ++i) mx = fmaxf(mx, p1[i]);
        mx = fmaxf(mx, __shfl_xor(mx, 32));
        const float mn = fmaxf(m, mx), alpha = __builtin_amdgcn_exp2f((m - mn) * c), mc = -mn * c; m = mn;
        float ps = 0.f;
#pragma unroll
        for (int i = 0; i < 16; ++i) { p0[i] = __builtin_amdgcn_exp2f(fmaf(p0[i], c, mc)); ps += p0[i]; }
#pragma unroll
        for (int i = 0; i < 16; ++i) { p1[i] = __builtin_amdgcn_exp2f(fmaf(p1[i], c, mc)); ps += p1[i]; }
        l = l * alpha + ps;
#pragma unroll
        for (int i = 0; i < 16; ++i) { o0[i] *= alpha; o1[i] *= alpha; }
        __builtin_amdgcn_sched_barrier(0);
        bf16x8 pb[2][2];
#pragma unroll
        for (int s = 0; s < 2; ++s) {
            u32x4 w0; w0.x = pk2(p0[8 * s + 0], p0[8 * s + 1]); w0.y = pk2(p0[8 * s + 2], p0[8 * s + 3]); w0.z = pk2(p0[8 * s + 4], p0[8 * s + 5]); w0.w = pk2(p0[8 * s + 6], p0[8 * s + 7]);
            u32x4 w1; w1.x = pk2(p1[8 * s + 0], p1[8 * s + 1]); w1.y = pk2(p1[8 * s + 2], p1[8 * s + 3]); w1.z = pk2(p1[8 * s + 4], p1[8 * s + 5]); w1.w = pk2(p1[8 * s + 6], p1[8 * s + 7]);
            pb[0][s] = __builtin_bit_cast(bf16x8, w0); pb[1][s] = __builtin_bit_cast(bf16x8, w1); }
#pragma unroll
        for (int t = 0; t < 2; ++t)
#pragma unroll
            for (int s = 0; s < 2; ++s) { const int ko = (32 * t + 16 * s + 4 * h) * 2;
                { const u32x2 lo = *(const LAS u32x2*)(vb + r * 136 + ko), hi = *(const LAS u32x2*)(vb + r * 136 + ko + 16);
                  o0 = MFMA32(__builtin_bit_cast(bf16x8, ((u32x4){lo.x, lo.y, hi.x, hi.y})), pb[t][s], o0); }
                { const u32x2 lo = *(const LAS u32x2*)(vb + (32 + r) * 136 + ko), hi = *(const LAS u32x2*)(vb + (32 + r) * 136 + ko + 16);
                  o1 = MFMA32(__builtin_bit_cast(bf16x8, ((u32x4){lo.x, lo.y, hi.x, hi.y})), pb[t][s], o1); }
                __builtin_amdgcn_sched_barrier(0); }
        if (more) { const int nx = cur ^ 1;
            *(LAS u32x4*)(lds + nx * KB_SZ + kw) = kreg;
            *(LAS u32x2*)(lds + VT_OFF + nx * VT_SZ + vw) = (u32x2){vreg.x, vreg.y}; *(LAS u32x2*)(lds + VT_OFF + nx * VT_SZ + vw + 8) = (u32x2){vreg.z, vreg.w};
            if (MLA && tid < 256) *(LAS u32x4*)(lds + KR_OFF + nx * KR_SZ + rw) = rreg; }
        __syncthreads();
    }
    l += __shfl_xor(l, 32);
    const float inv = 1.f / l;
    bf16* orow = O + (size_t)(32 * wave + r) * DM;
#pragma unroll
    for (int g = 0; g < 4; ++g) {
        *(u32x2*)(orow + 8 * g + 4 * h) = (u32x2){pk2(o0[4 * g] * inv, o0[4 * g + 1] * inv), pk2(o0[4 * g + 2] * inv, o0[4 * g + 3] * inv)};
        *(u32x2*)(orow + 32 + 8 * g + 4 * h) = (u32x2){pk2(o1[4 * g] * inv, o1[4 * g + 1] * inv), pk2(o1[4 * g + 2] * inv, o1[4 * g + 3] * inv)}; }
}
__device__ __forceinline__ void phase_attention(unsigned char* ws, LAS unsigned char* lds, const f32x2* tabm, int tid, int wave, int lane, int G) {
    const bf16* QC = (const bf16*)(ws + WS_C + C_QC); const bf16* MQ = (const bf16*)(ws + WS_C + C_MQ); const bf16* KN = (const bf16*)(ws + WS_C + C_KN);
    const bf16* VTM = (const bf16*)(ws + WS_C + C_VTM); const bf16* KC = (const bf16*)(ws + WS_A + A_KC); const bf16* VTC = (const bf16*)(ws + WS_A + A_VTC);
    const bf16* KR = (const bf16*)(ws + WS_A + A_KR); bf16* ATT = (bf16*)(ws + WS_B);
    constexpr float C_G = 0.125f * 1.4426950408889634f, C_M = 0.10206207261596577f * 1.4426950408889634f;
    for (int i = blockIdx.x; i < 1280; i += G) {
        bool mla; int row0, key0, nkeys, hh, qpos0;
        if (i < 1024) { mla = i < 512; const int ii = i & 511, b = ii >> 6, qb = ii & 7; hh = (ii >> 3) & 7; row0 = TP + b * SEQS + qb * 256; key0 = TP + b * KSEQ; nkeys = KSEQ; qpos0 = qb * 256; }
        else { mla = i < 1152; const int ii = (i - 1024) & 127, b = ii >> 3; hh = ii & 7; row0 = b * 256; key0 = row0; nkeys = 256; qpos0 = -1; }
        if (mla) attn_unit<true>(lds, MQ + (size_t)row0 * MQD + hh * 96, MQD, KN + (size_t)key0 * 512 + hh * 64, 512, KR + (size_t)key0 * 32, VTM + (size_t)(hh * 64) * TK + key0, nkeys,
                                 ATT + (size_t)row0 * DM + 512 + hh * 64, C_M, tabm, qpos0, tid, wave, lane);
        else attn_unit<false>(lds, QC + (size_t)row0 * 512 + hh * 64, 512, KC + (size_t)key0 * 128 + (hh >> 2) * 64, 128, KR, VTC + (size_t)((hh >> 2) * 64) * TK + key0, nkeys,
                              ATT + (size_t)row0 * DM + hh * 64, C_G, tabm, -1, tid, wave, lane);
    }
}

struct Args { const float* in[32]; float* out; unsigned char* ws; int ph_lo, ph_hi; };
constexpr int NPHASE = 18;

template <class Epi>
__device__ __forceinline__ void run_gemm(LAS unsigned char* lds, const bf16* A, const bf16* Bt, int M, int N, int K, int G, int cid, const Epi& E) {
    pg8::Gemm g{A, Bt, M, N, K}; pg8::StaticOrder S; S.init(M, N, G, cid);
    pg8::gemm_phase<Epi, pg8::StaticOrder, true, true>(lds, g, S, E);
}

__global__ void __launch_bounds__(NTHR, 2) fwd_kernel(Args args) {
    extern __shared__ __attribute__((aligned(16))) unsigned char lds_raw[];
    LAS unsigned char* lds = (LAS unsigned char*)lds_raw;
    cg::grid_group grid = cg::this_grid();
    const int tid = threadIdx.x, lane = tid & 63, wave = __builtin_amdgcn_readfirstlane(tid >> 6);
    const int G = gridDim.x, bid = blockIdx.x, gw = bid * NWAVES + wave, ngw = G * NWAVES;
    unsigned char* ws = args.ws; const float* const* in = args.in; float* out = args.out;
    const int lo = args.ph_lo, hi = args.ph_hi;
#ifndef PH_MASK
#define PH_MASK 0x3ffff
#endif
#define IN(k) (((PH_MASK >> (k)) & 1) && lo <= (k) && (k) < hi)
#define SEAM(k) do { if (IN(k) && IN((k) + 1)) grid.sync(); } while (0)
    bf16* H = (bf16*)(ws + WS_A); bf16* OB = (bf16*)(ws + WS_A); bf16* MIX = (bf16*)(ws + WS_B); bf16* ATT = (bf16*)(ws + WS_B);
    bf16* U = (bf16*)(ws + WS_C); bf16* ACT = (bf16*)(ws + WS_C);
    const float* MOD0 = (const float*)(ws + WS_MOD); const float* MOD1 = MOD0 + 9 * 6144;
    const f32x2* tabg = (const f32x2*)(ws + WS_TABG); const f32x2* tabm = (const f32x2*)(ws + WS_TABM);
    float* Y = out + OUT_Y;

    if (IN(0)) {
        p0_adaln(in, ws, lds, tid, wave, lane, G);
        if (bid == G - 1) p0_tables(in, ws, tid);
        p0_weights(in, ws, (LAS float*)(lds + 57344 + wave * 8448), gw, ngw, lane);
    }
    SEAM(0);
    if (IN(1)) phase_norm_in(in[0], in[1], in[10] + 0 * DM, MOD0, 0, H, gw, ngw, lane);
    SEAM(1);
    if (IN(2)) run_gemm(lds, H, (const bf16*)(ws + WS_WCIN), T, CIN, 1024, G, bid, EpiStore{U, CIN, (const float*)(ws + WS_BCIN)});
    SEAM(2);
    if (IN(3)) phase_conv(U, MIX, in[13], in[15], in[16], in[17], in[18], lds, tid, wave, lane, G);
    SEAM(3);
    if (IN(4)) run_gemm(lds, MIX, (const bf16*)(ws + WS_WCOUT), T, 1024, 1024, G, bid, EpiStore{OB, DM, in[20]});
    SEAM(4);
    if (IN(5)) phase_post<true>(OB, in[0], in[1], Y, in[11] + 0 * DM, MOD0, 2, in[10] + 1 * DM, MOD0, 3, H, gw, ngw, lane);
    SEAM(5);
    if (IN(6)) run_gemm(lds, H, (const bf16*)(ws + WS_WGU0), T, 2 * FFN, 1024, G, bid, EpiSwiGLU{ACT});
    SEAM(6);
    if (IN(7)) run_gemm(lds, ACT, (const bf16*)(ws + WS_WD0), T, 1024, FFN, G, bid, EpiStore{OB, DM, nullptr});
    SEAM(7);
    if (IN(8)) phase_post<true>(OB, Y, Y + (size_t)TP * DM, Y, in[11] + 1 * DM, MOD0, 5, in[10] + 2 * DM, MOD1, 0, H, gw, ngw, lane);
    SEAM(8);
    if (IN(9)) run_gemm(lds, H, (const bf16*)(ws + WS_WAIN), T, AINP, 1024, G, bid, EpiStore{(bf16*)(ws + WS_C + C_U1), AINP, nullptr});
    SEAM(9);
    if (IN(10)) phase_attn_rows((const bf16*)(ws + WS_C + C_U1), in[22], in[23], in[24], in[26], tabg, tabm,
                                (bf16*)(ws + WS_C + C_QC), (bf16*)(ws + WS_A + A_KC), (bf16*)(ws + WS_A + A_VTC), (bf16*)(ws + WS_A + A_QA), (bf16*)(ws + WS_A + A_CKV), (bf16*)(ws + WS_A + A_KR),
                                out + OUT_K, out + OUT_V, out + OUT_CKV, out + OUT_KR, in[2], in[3], in[4], in[5], gw, ngw, lane);
    SEAM(10);
    if (IN(11)) {
        run_gemm(lds, (const bf16*)(ws + WS_A + A_QA), (const bf16*)(ws + WS_WQB), T, MQD, QL, G, bid, EpiStore{(bf16*)(ws + WS_C + C_MQ), MQD, nullptr});
        run_gemm(lds, (const bf16*)(ws + WS_A + A_CKV), (const bf16*)(ws + WS_WKN), TK, 512, KVL, G, (bid + 240) % G, EpiStore{(bf16*)(ws + WS_C + C_KN), 512, nullptr});
        run_gemm(lds, (const bf16*)(ws + WS_WVT), (const bf16*)(ws + WS_A + A_CKV), 512, TK, KVL, G, (bid + 160) % G, EpiStore{(bf16*)(ws + WS_C + C_VTM), TK, nullptr});
    }
    SEAM(11);
    if (IN(12)) phase_attention(ws, lds, tabm, tid, wave, lane, G);
    SEAM(12);
    if (IN(13)) run_gemm(lds, ATT, (const bf16*)(ws + WS_WAOUT), T, 1024, 1024, G, bid, EpiStore{OB, DM, nullptr});
    SEAM(13);
    if (IN(14)) phase_post<true>(OB, Y, Y + (size_t)TP * DM, Y, in[11] + 2 * DM, MOD1, 2, in[10] + 3 * DM, MOD1, 3, H, gw, ngw, lane);
    SEAM(14);
    if (IN(15)) run_gemm(lds, H, (const bf16*)(ws + WS_WGU1), T, 2 * FFN, 1024, G, bid, EpiSwiGLU{ACT});
    SEAM(15);
    if (IN(16)) run_gemm(lds, ACT, (const bf16*)(ws + WS_WD1), T, 1024, FFN, G, bid, EpiStore{OB, DM, nullptr});
    SEAM(16);
    if (IN(17)) phase_post<false>(OB, Y, Y + (size_t)TP * DM, Y, in[11] + 3 * DM, MOD1, 5, nullptr, nullptr, 0, nullptr, gw, ngw, lane);
#undef IN
#undef SEAM
}

#ifndef MK_ONE_LAUNCH
#define MK_ONE_LAUNCH 1
#endif
extern "C" void kernel_launch(void* const* d_in, const int* in_sizes, int n_in, void* d_out, int out_size, void* d_ws, size_t ws_size, hipStream_t stream) {
    static int grid = 0;
    if (grid == 0) {
        if (n_in != 32 || ws_size < WS_END) { fprintf(stderr, "kernel_launch: unexpected inputs (n_in %d, ws %zu)\n", n_in, ws_size); grid = -1; return; }
        int dev = 0, cus = 0, per_cu = 0;
        (void)hipGetDevice(&dev); (void)hipDeviceGetAttribute(&cus, hipDeviceAttributeMultiprocessorCount, dev);
        if (hipFuncSetAttribute((const void*)fwd_kernel, hipFuncAttributeMaxDynamicSharedMemorySize, LDS_BYTES) != hipSuccess) { fprintf(stderr, "kernel_launch: hipFuncSetAttribute failed\n"); grid = -1; return; }
        if (hipOccupancyMaxActiveBlocksPerMultiprocessor(&per_cu, (const void*)fwd_kernel, NTHR, LDS_BYTES) != hipSuccess || per_cu < 1) { fprintf(stderr, "kernel_launch: occupancy query says %d\n", per_cu); per_cu = 1; }
        (void)hipGetLastError();
        grid = cus;
    }
    if (grid < 0) return;
    Args a{};
    for (int i = 0; i < 32; ++i) a.in[i] = (const float*)d_in[i];
    a.out = (float*)d_out; a.ws = (unsigned char*)d_ws;
#if MK_ONE_LAUNCH
    a.ph_lo = 0; a.ph_hi = NPHASE;
    void* kargs[] = {&a};
    hipError_t e = hipLaunchCooperativeKernel((const void*)fwd_kernel, dim3(grid), dim3(NTHR), kargs, LDS_BYTES, stream);
    if (e != hipSuccess) fprintf(stderr, "kernel_launch: cooperative launch failed: %s (grid %d)\n", hipGetErrorString(e), grid);
#else
    for (int p = 0; p < NPHASE; ++p) { a.ph_lo = p; a.ph_hi = p + 1; hipLaunchKernelGGL(fwd_kernel, dim3(grid), dim3(NTHR), LDS_BYTES, stream, a); }
#endif
}
```

```cpp
#include <hip/hip_runtime.h>
#include <hip/hip_cooperative_groups.h>
#include <cstdio>
#include <cstdint>
namespace cg = cooperative_groups;
#ifndef MK_CG_SYNC
#define MK_CG_SYNC 0
#endif
namespace pg8 {
#define PG8_LAS __attribute__((address_space(3)))
typedef unsigned short bf16_t;
typedef short bf16x8 __attribute__((ext_vector_type(8)));
typedef float f32x4 __attribute__((ext_vector_type(4)));
typedef unsigned u32x4 __attribute__((ext_vector_type(4)));
constexpr int BM = 256, BK = 64, HALF = 128, HTB = HALF * BK * 2  , STAGE_BYTES = 8 * HTB, NXCD = 8, WGM = 8;

__host__ __device__ __forceinline__ int lds_byte(int r, int c) { const int st = (r >> 4) * 2 + (c >> 5), rr = r & 15, cc = c & 31, ob = rr * 64 + cc * 2; return st * 1024 + (ob ^ (((ob >> 9) & 1) << 5)); }
__host__ __device__ __forceinline__ void stage_rc(int b, int& R, int& C) { const int st = b / 1024, sb = b % 1024, swz = sb ^ (((sb >> 9) & 1) << 5); R = (st >> 1) * 16 + swz / 64; C = (st & 1) * 32 + (swz % 64) / 2; }
__host__ __device__ __forceinline__ int perm32(int rho) { const int n = rho >> 4, i = rho & 15; return 8 * (i >> 2) + 4 * n + (i & 3); }

struct Unit { int pm, pn; };
struct Gemm { const bf16_t* A; const bf16_t* Bt; int M, N, K; };

struct StaticOrder {
    int nM, nN, nwg, G, c;
    __host__ __device__ void init(int M, int N, int G_, int c_) { nM = M / BM; nN = N / BM; nwg = nM * nN; G = G_; c = c_; }
    __host__ __device__ bool next(int i, Unit& u) const {
        const long L = (long)i * G + c; if (L >= nwg) return false;
        int wgid = (int)L; { const int q = nwg / NXCD, r = nwg % NXCD, xcd = wgid % NXCD, off = wgid / NXCD; wgid = (xcd < r ? xcd * (q + 1) : r * (q + 1) + (xcd - r) * q) + off; }
        const int nig = WGM * nN, gid = wgid / nig, fm = gid * WGM, gsz = (nM - fm) < WGM ? (nM - fm) : WGM;
        u.pm = fm + ((wgid % nig) % gsz); u.pn = (wgid % nig) / gsz; return true;
    }
    __device__ __forceinline__ void a_ready(const Unit&) const {}
    __device__ __forceinline__ void done(const Unit&) const {}
};

__device__ __forceinline__ unsigned cvt_pk_bf16(float lo, float hi) { unsigned r; asm volatile("v_cvt_pk_bf16_f32 %0, %1, %2" : "=v"(r) : "v"(lo), "v"(hi)); return r; }
template <class Epi, class Sched, bool ALIGN_EPI = false, bool SP2 = false>
__device__ __forceinline__ void gemm_phase(PG8_LAS unsigned char* lds, const Gemm g, const Sched& S, const Epi& E) {
    const int tid = threadIdx.x, wid = __builtin_amdgcn_readfirstlane(tid >> 6), lane = tid & 63, wr = wid >> 2, wc = wid & 3, fr = lane & 15, fq = lane >> 4;
    const int K = g.K, nt = K / BK;
    unsigned voffA[2], voffB[2];
#pragma unroll
    for (int i = 0; i < 2; ++i) { int R, C; stage_rc(tid * 16 + i * 8192, R, C); const int Rb = Epi::PERM ? ((R & ~31) + perm32(R & 31)) : R;
        voffA[i] = (unsigned)(R * K + C) * 2u; voffB[i] = (unsigned)(Rb * K + C) * 2u; }
    const size_t kstep = (size_t)(BK * 2);
    const size_t hstep = (size_t)HALF * K * 2;
    const size_t tstep = 2 * hstep;
    const unsigned ldsw = (unsigned)wid * 1024u;
    const int aoff = lds_byte(wr * 64 + fr, fq * 8), boff = lds_byte(wc * 32 + fr, fq * 8);
#define PG8_SA(b, h) (((b) * 2 + (h)) * HTB)
#define PG8_SB(b, h) ((4 + (b) * 2 + (h)) * HTB)
#define PG8_STAGE(bufoff, gbase, voff) do { _Pragma("unroll") for (int _i = 0; _i < 2; ++_i) \
        __builtin_amdgcn_global_load_lds((const unsigned*)((const char*)(gbase) + (voff)[_i]), (PG8_LAS unsigned*)(lds + (bufoff) + ldsw + _i * 8192), 16, 0, 0); } while (0)
#define PG8_LDA(dst, b, h) do { _Pragma("unroll") for (int m = 0; m < 4; ++m) _Pragma("unroll") for (int k = 0; k < 2; ++k) dst[m][k] = *(const PG8_LAS bf16x8*)(lds + PG8_SA(b, h) + aoff + m * 2048 + k * 1024); } while (0)
#define PG8_LDB(dst, b, h) do { _Pragma("unroll") for (int n = 0; n < 2; ++n) _Pragma("unroll") for (int k = 0; k < 2; ++k) dst[n][k] = *(const PG8_LAS bf16x8*)(lds + PG8_SB(b, h) + boff + n * 2048 + k * 1024); } while (0)
#define PG8_MMA(ai, bj, At, Bt) do { __builtin_amdgcn_s_setprio(1); _Pragma("unroll") for (int m = 0; m < 4; ++m) _Pragma("unroll") for (int n = 0; n < 2; ++n) _Pragma("unroll") for (int k = 0; k < 2; ++k) \
        acc[ai][bj][m][n] = __builtin_amdgcn_mfma_f32_16x16x32_bf16(Bt[n][k], At[m][k], acc[ai][bj][m][n], 0, 0, 0); __builtin_amdgcn_s_setprio(0); } while (0)
#define PG8_WAIT_V(n) asm volatile("s_waitcnt vmcnt(" #n ")" ::: "memory")
#define PG8_WAIT_L(n) asm volatile("s_waitcnt lgkmcnt(" #n ")" ::: "memory")
#define PG8_BAR __builtin_amdgcn_s_barrier()
#define PG8_SCHED __builtin_amdgcn_sched_barrier(0)
    Unit cur, nxt; int ui = 0;
    if (!S.next(0, cur)) return;
    f32x4 acc[2][2][4][2];
#pragma unroll
    for (int a = 0; a < 2; ++a)
#pragma unroll
        for (int b = 0; b < 2; ++b)
#pragma unroll
            for (int m = 0; m < 4; ++m)
#pragma unroll
                for (int n = 0; n < 2; ++n) acc[a][b][m][n] = (f32x4){0.f, 0.f, 0.f, 0.f};
    bf16x8 At[4][2], B0[2][2], B1[2][2];
    const char* cA = (const char*)g.A + (size_t)cur.pm * tstep; const char* cB = (const char*)g.Bt + (size_t)cur.pn * tstep;
    S.a_ready(cur);
    if constexpr (SP2) {
        PG8_STAGE(PG8_SB(0, 0), cB, voffB); PG8_STAGE(PG8_SB(0, 1), cB + hstep, voffB); PG8_STAGE(PG8_SA(0, 0), cA, voffA); PG8_STAGE(PG8_SA(0, 1), cA + hstep, voffA);
        if (wr == 1) PG8_BAR;
        PG8_WAIT_V(2); PG8_BAR;
        PG8_STAGE(PG8_SB(1, 0), cB + kstep, voffB); PG8_STAGE(PG8_SA(1, 0), cA + kstep, voffA); PG8_STAGE(PG8_SB(1, 1), cB + hstep + kstep, voffB);
        PG8_WAIT_V(6); PG8_BAR;
    } else {
        PG8_STAGE(PG8_SB(0, 0), cB, voffB); PG8_STAGE(PG8_SA(0, 0), cA, voffA); PG8_STAGE(PG8_SB(0, 1), cB + hstep, voffB); PG8_STAGE(PG8_SA(0, 1), cA + hstep, voffA);
        if (wr == 1) PG8_BAR;
        PG8_WAIT_V(4); PG8_BAR;
        PG8_STAGE(PG8_SB(1, 0), cB + kstep, voffB); PG8_STAGE(PG8_SA(1, 0), cA + kstep, voffA); PG8_STAGE(PG8_SB(1, 1), cB + hstep + kstep, voffB);
        PG8_WAIT_V(6); PG8_BAR;
    }
    for (;;) {
        const bool has_next = S.next(ui + 1, nxt);
        const char* nA = has_next ? (const char*)g.A + (size_t)nxt.pm * tstep : cA; const char* nB = has_next ? (const char*)g.Bt + (size_t)nxt.pn * tstep : cB;
        for (int t = 0; t < nt; t += 2) {
            const bool last = (t == nt - 2);
            const char* a1 = cA + (size_t)(t + 1) * kstep;
            const char* a2 = last ? nA : cA + (size_t)(t + 2) * kstep; const char* b2 = last ? nB : cB + (size_t)(t + 2) * kstep;
            const char* a3 = a2 + kstep; const char* b3 = b2 + kstep;
            if (last && has_next) S.a_ready(nxt);
            if constexpr (SP2) {
            PG8_LDB(B0, 0, 0); PG8_LDB(B1, 0, 1); PG8_SCHED; PG8_LDA(At, 0, 0); PG8_STAGE(PG8_SA(1, 1), a1 + hstep, voffA);
            PG8_WAIT_V(8); PG8_WAIT_L(0); PG8_BAR; PG8_MMA(0, 0, At, B0); PG8_MMA(0, 1, At, B1); PG8_BAR; PG8_SCHED;
            PG8_LDA(At, 0, 1); PG8_STAGE(PG8_SB(0, 0), b2, voffB); PG8_STAGE(PG8_SB(0, 1), b2 + hstep, voffB); PG8_STAGE(PG8_SA(0, 0), a2, voffA);
            PG8_WAIT_V(8); PG8_WAIT_L(0); PG8_BAR; PG8_MMA(1, 0, At, B0); PG8_MMA(1, 1, At, B1); PG8_BAR; PG8_SCHED;
            PG8_LDB(B0, 1, 0); PG8_LDB(B1, 1, 1); PG8_SCHED; PG8_LDA(At, 1, 0); PG8_STAGE(PG8_SA(0, 1), a2 + hstep, voffA);
            PG8_WAIT_V(8); PG8_WAIT_L(0); PG8_BAR; PG8_MMA(0, 0, At, B0); PG8_MMA(0, 1, At, B1); PG8_BAR; PG8_SCHED;
            PG8_LDA(At, 1, 1); PG8_STAGE(PG8_SB(1, 0), b3, voffB); PG8_STAGE(PG8_SB(1, 1), b3 + hstep, voffB); PG8_STAGE(PG8_SA(1, 0), a3, voffA);
            PG8_WAIT_V(8); PG8_WAIT_L(0); PG8_BAR; PG8_MMA(1, 0, At, B0); PG8_MMA(1, 1, At, B1); PG8_BAR; PG8_SCHED;
            } else {
            PG8_LDB(B0, 0, 0); PG8_SCHED; PG8_LDA(At, 0, 0); PG8_STAGE(PG8_SA(1, 1), a1 + hstep, voffA);
            PG8_WAIT_L(8); PG8_BAR; PG8_WAIT_L(0); PG8_MMA(0, 0, At, B0); PG8_BAR; PG8_SCHED;
            PG8_LDB(B1, 0, 1); PG8_STAGE(PG8_SB(0, 0), b2, voffB);
            PG8_BAR; PG8_WAIT_L(0); PG8_MMA(0, 1, At, B1); PG8_BAR;
            PG8_LDA(At, 0, 1); PG8_STAGE(PG8_SA(0, 0), a2, voffA);
            PG8_BAR; PG8_WAIT_L(0); PG8_MMA(1, 0, At, B0); PG8_BAR; PG8_SCHED;
            PG8_STAGE(PG8_SB(0, 1), b2 + hstep, voffB);
            PG8_WAIT_V(6); PG8_BAR; PG8_MMA(1, 1, At, B1); PG8_BAR;
            PG8_LDB(B0, 1, 0); PG8_SCHED; PG8_LDA(At, 1, 0); PG8_STAGE(PG8_SA(0, 1), a2 + hstep, voffA);
            PG8_WAIT_L(8); PG8_BAR; PG8_WAIT_L(0); PG8_MMA(0, 0, At, B0); PG8_BAR; PG8_SCHED;
            PG8_LDB(B1, 1, 1); PG8_STAGE(PG8_SB(1, 0), b3, voffB);
            PG8_BAR; PG8_WAIT_L(0); PG8_MMA(0, 1, At, B1); PG8_BAR;
            PG8_LDA(At, 1, 1); PG8_STAGE(PG8_SA(1, 0), a3, voffA);
            PG8_BAR; PG8_WAIT_L(0); PG8_MMA(1, 0, At, B0); PG8_BAR; PG8_SCHED;
            PG8_STAGE(PG8_SB(1, 1), b3 + hstep, voffB);
            PG8_WAIT_V(6); PG8_BAR; PG8_MMA(1, 1, At, B1); PG8_BAR;
            }
        }
        if constexpr (ALIGN_EPI) { if (wr == 0) PG8_BAR; }
        if constexpr (!Epi::AFTER_DRAIN) { E(acc, cur, wr, wc, fr, fq); S.done(cur); }
        if (!has_next) break;
#pragma unroll
        for (int a = 0; a < 2; ++a)
#pragma unroll
            for (int b = 0; b < 2; ++b)
#pragma unroll
                for (int m = 0; m < 4; ++m)
#pragma unroll
                    for (int n = 0; n < 2; ++n) acc[a][b][m][n] = (f32x4){0.f, 0.f, 0.f, 0.f};
        cur = nxt; cA = nA; cB = nB; ++ui;
        if constexpr (ALIGN_EPI) { if (wr == 1) PG8_BAR; }
    }
    PG8_WAIT_V(0);
    if constexpr (!ALIGN_EPI) { if (wr == 0) PG8_BAR; }
    PG8_BAR;
    if constexpr (Epi::AFTER_DRAIN) { E.fused(acc, cur, wr, wc, fr, fq, lds, wid, lane); S.done(cur); }
#undef PG8_SA
#undef PG8_SB
#undef PG8_STAGE
#undef PG8_LDA
#undef PG8_LDB
#undef PG8_MMA
#undef PG8_WAIT_V
#undef PG8_WAIT_L
#undef PG8_BAR
#undef PG8_SCHED
}
}

#define LAS __attribute__((address_space(3)))
typedef unsigned short bf16;
typedef float f32x4 __attribute__((ext_vector_type(4)));
typedef float f32x2 __attribute__((ext_vector_type(2)));
typedef float f32x16 __attribute__((ext_vector_type(16)));
typedef short bf16x8 __attribute__((ext_vector_type(8)));
typedef unsigned u32x4 __attribute__((ext_vector_type(4)));
typedef unsigned u32x2 __attribute__((ext_vector_type(2)));

constexpr int DM = 1024, TP = 4096, TS = 16384, T = TP + TS, SEQS = 2048, NBS = 8, PAST = 256;
constexpr int KSEQ = PAST + SEQS;
constexpr int TK = TP + NBS * KSEQ;
constexpr int FFN = 2816, CIN = 2560, AIN = 1440, AINP = 1536, QL = 384, KVL = 256, MQD = 768;
constexpr float EPS = 1e-6f;
constexpr int NWAVES = 8, NTHR = 512;
constexpr int LDS_BYTES = 147456;

constexpr size_t MiB = (size_t)1 << 20;
constexpr size_t al256(size_t x) { return (x + 255) & ~(size_t)255; }
constexpr size_t WS_CTL = 0;
constexpr size_t WS_MOD = 1 * MiB;
constexpr size_t WS_TABG = WS_MOD + al256((size_t)2 * 9 * 6144 * 4);
constexpr size_t WS_TABM = WS_TABG + al256(64 * 16 * 8);
constexpr size_t WS_BCIN = WS_TABM + al256(64 * 8 * 8);
constexpr size_t WS_WCIN = 2 * MiB;
constexpr size_t WS_WCOUT = WS_WCIN + (size_t)2560 * 1024 * 2;
constexpr size_t WS_WGU0 = WS_WCOUT + (size_t)1024 * 1024 * 2;
constexpr size_t WS_WD0 = WS_WGU0 + (size_t)5632 * 1024 * 2;
constexpr size_t WS_WGU1 = WS_WD0 + (size_t)1024 * 2816 * 2;
constexpr size_t WS_WD1 = WS_WGU1 + (size_t)5632 * 1024 * 2;
constexpr size_t WS_WAIN = WS_WD1 + (size_t)1024 * 2816 * 2;
constexpr size_t WS_WQB = WS_WAIN + (size_t)1536 * 1024 * 2;
constexpr size_t WS_WKN = WS_WQB + (size_t)768 * 384 * 2;
constexpr size_t WS_WVT = WS_WKN + (size_t)512 * 256 * 2;
constexpr size_t WS_WAOUT = WS_WVT + (size_t)512 * 256 * 2;
constexpr size_t WS_WEND = WS_WAOUT + (size_t)1024 * 1024 * 2;
constexpr size_t WS_A = 50 * MiB;
constexpr size_t WS_B = 90 * MiB;
constexpr size_t WS_C = 130 * MiB;
constexpr size_t WS_END = 240 * MiB;
static_assert(WS_BCIN + 2560 * 4 <= WS_WCIN && WS_WEND <= WS_A, "ws map");
constexpr size_t A_QA = 0;
constexpr size_t A_CKV = A_QA + (size_t)T * QL * 2;
constexpr size_t A_KR = A_CKV + (size_t)TK * KVL * 2;
constexpr size_t A_KC = A_KR + (size_t)TK * 32 * 2;
constexpr size_t A_VTC = A_KC + (size_t)TK * 128 * 2;
static_assert(A_VTC + (size_t)128 * TK * 2 <= 40 * MiB, "region A");
constexpr size_t C_U1 = 0;
constexpr size_t C_QC = (size_t)T * AINP * 2;
constexpr size_t C_VTM = C_QC + (size_t)T * 512 * 2;
constexpr size_t C_MQ = 0;
constexpr size_t C_KN = (size_t)T * MQD * 2;
static_assert(C_KN + (size_t)TK * 512 * 2 <= C_QC && C_VTM + (size_t)512 * TK * 2 <= 110 * MiB, "region C");
constexpr size_t OUT_Y = 0, OUT_K = (size_t)T * DM, OUT_V = OUT_K + (size_t)TP * 128, OUT_CKV = OUT_V + (size_t)TP * 128, OUT_KR = OUT_CKV + (size_t)TP * 256;

__device__ __forceinline__ unsigned pk2(float lo, float hi) { return pg8::cvt_pk_bf16(lo, hi); }
__device__ __forceinline__ bf16 f2bf(float x) { return (bf16)(pk2(x, 0.f) & 0xffffu); }
__device__ __forceinline__ float bf2f(bf16 b) { return __uint_as_float((unsigned)b << 16); }
__device__ __forceinline__ float bflo(unsigned w) { return __uint_as_float(w << 16); }
__device__ __forceinline__ float bfhi(unsigned w) { return __uint_as_float(w & 0xffff0000u); }
__device__ __forceinline__ float wave_sum(float v) {
#pragma unroll
    for (int o = 1; o < 64; o <<= 1) v += __shfl_xor(v, o);
    return v;
}
__device__ __forceinline__ float fsigmoid(float x) { return __builtin_amdgcn_rcpf(1.f + __builtin_amdgcn_exp2f(-1.4426950408889634f * x)); }
__device__ __forceinline__ float fsilu(float x) { return x * fsigmoid(x); }
__device__ __forceinline__ const float* xrow_in(const float* xp, const float* xs, int r) { return r < TP ? xp + (size_t)r * DM : xs + (size_t)(r - TP) * DM; }
__device__ __forceinline__ int cond_of(int r) { return r < TP ? 0 : 1 + ((r - TP) >> 11); }
__device__ __forceinline__ void unpack8(u32x4 w, float (&v)[8]) {
    v[0] = bflo(w.x); v[1] = bfhi(w.x); v[2] = bflo(w.y); v[3] = bfhi(w.y); v[4] = bflo(w.z); v[5] = bfhi(w.z); v[6] = bflo(w.w); v[7] = bfhi(w.w);
}
__device__ __forceinline__ u32x4 pack8(const float (&v)[8]) { u32x4 w; w.x = pk2(v[0], v[1]); w.y = pk2(v[2], v[3]); w.z = pk2(v[4], v[5]); w.w = pk2(v[6], v[7]); return w; }

struct EpiStore {
    static constexpr bool PERM = true, AFTER_DRAIN = false;
    bf16* O; int ldc; const float* bias;
    __device__ __forceinline__ void operator()(const f32x4 (&acc)[2][2][4][2], const pg8::Unit& u, int wr, int wc, int fr, int fq) const {
        const int row0 = u.pm * 256 + wr * 64 + fr, col0 = u.pn * 256 + wc * 32 + 8 * fq;
        f32x4 bv[2][2];
#pragma unroll
        for (int bj = 0; bj < 2; ++bj)
#pragma unroll
            for (int n = 0; n < 2; ++n) bv[bj][n] = bias ? *(const f32x4*)(bias + col0 + bj * 128 + 4 * n) : (f32x4){0.f, 0.f, 0.f, 0.f};
#pragma unroll
        for (int ai = 0; ai < 2; ++ai)
#pragma unroll
            for (int m = 0; m < 4; ++m) { bf16* rowp = O + (size_t)(row0 + ai * 128 + m * 16) * ldc + col0;
#pragma unroll
                for (int bj = 0; bj < 2; ++bj) { const f32x4 v0 = acc[ai][bj][m][0] + bv[bj][0], v1 = acc[ai][bj][m][1] + bv[bj][1];
                    u32x4 w; w.x = pk2(v0[0], v0[1]); w.y = pk2(v0[2], v0[3]); w.z = pk2(v1[0], v1[1]); w.w = pk2(v1[2], v1[3]);
                    *(u32x4*)(rowp + bj * 128) = w; } }
    }
};
struct EpiSwiGLU {
    static constexpr bool PERM = true, AFTER_DRAIN = false;
    bf16* O;
    __device__ __forceinline__ void operator()(const f32x4 (&acc)[2][2][4][2], const pg8::Unit& u, int wr, int wc, int fr, int fq) const {
        const int row0 = u.pm * 256 + wr * 64 + fr, col0 = u.pn * 128 + wc * 32 + 8 * fq;
#pragma unroll
        for (int ai = 0; ai < 2; ++ai)
#pragma unroll
            for (int m = 0; m < 4; ++m) { bf16* rowp = O + (size_t)(row0 + ai * 128 + m * 16) * FFN + col0;
                const f32x4 g0 = acc[ai][0][m][0], g1 = acc[ai][0][m][1], u0 = acc[ai][1][m][0], u1 = acc[ai][1][m][1];
                u32x4 w; w.x = pk2(fsilu(g0[0]) * u0[0], fsilu(g0[1]) * u0[1]); w.y = pk2(fsilu(g0[2]) * u0[2], fsilu(g0[3]) * u0[3]);
                w.z = pk2(fsilu(g1[0]) * u1[0], fsilu(g1[1]) * u1[1]); w.w = pk2(fsilu(g1[2]) * u1[2], fsilu(g1[3]) * u1[3]);
                *(u32x4*)rowp = w; }
    }
};
__device__ __forceinline__ void tr_item(const float* src, int ldw, bf16* WT, int K, int k0, int drow0, LAS float* scr, int lane) {
#pragma unroll 8
    for (int i = 0; i < 32; ++i) { const int kk = 2 * i + (lane >> 5); scr[kk * 33 + (lane & 31)] = src ? src[(size_t)(k0 + kk) * ldw] : 0.f; }
    asm volatile("s_waitcnt lgkmcnt(0)" ::: "memory");
    const int c = lane & 7;
#pragma unroll
    for (int j = 0; j < 4; ++j) { const int n = (lane >> 3) + 8 * j; const LAS float* s = scr + (8 * c) * 33 + n;
        u32x4 o; o.x = pk2(s[0 * 33], s[1 * 33]); o.y = pk2(s[2 * 33], s[3 * 33]); o.z = pk2(s[4 * 33], s[5 * 33]); o.w = pk2(s[6 * 33], s[7 * 33]);
        *(u32x4*)(WT + (size_t)(drow0 + n) * K + k0 + 8 * c) = o; }
    asm volatile("s_waitcnt lgkmcnt(0)" ::: "memory");
}

__device__ __forceinline__ void p0_weights(const float* const* in, unsigned char* ws, LAS float* scr, int gw, int ngw, int lane) {
    constexpr int I_CIN = 16 * 80, I_COUT = 16 * 32, I_GU = 16 * 176, I_D = 44 * 32, I_AIN = 16 * 48, I_QB = 6 * 24, I_KN = 4 * 16, I_AOUT = 16 * 32;
    constexpr int NITEMS = I_CIN + I_COUT + 2 * I_GU + 2 * I_D + I_AIN + I_QB + 2 * I_KN + I_AOUT;
    const int ln = lane & 31;
    for (int it = gw; it < NITEMS; it += ngw) {
        int r = it;
        if (r < I_CIN) { const int nblk = 80, kb = r / nblk, nb = r % nblk, n = 32 * nb + ln;
            tr_item(in[12] + n, CIN, (bf16*)(ws + WS_WCIN), 1024, 64 * kb, 32 * nb, scr, lane); continue; } r -= I_CIN;
        if (r < I_COUT) { const int nblk = 32, kb = r / nblk, nb = r % nblk, n = 32 * nb + ln;
            tr_item(in[19] + n, 1024, (bf16*)(ws + WS_WCOUT), 1024, 64 * kb, 32 * nb, scr, lane); continue; } r -= I_COUT;
        if (r < 2 * (I_GU + I_D)) { const int l = r >= (I_GU + I_D) ? 1 : 0; r -= l * (I_GU + I_D);
            if (r < I_GU) { const int nblk = 176, kb = r / nblk, nb = r % nblk, n = 32 * nb + ln, t = n >> 8, w = n & 255;
                const float* src = (w < 128 ? in[29] : in[30]) + (size_t)l * 1024 * FFN + 128 * t + (w & 127);
                tr_item(src, FFN, (bf16*)(ws + (l ? WS_WGU1 : WS_WGU0)), 1024, 64 * kb, 32 * nb, scr, lane); }
            else { r -= I_GU; const int nblk = 32, kb = r / nblk, nb = r % nblk, n = 32 * nb + ln;
                tr_item(in[31] + (size_t)l * FFN * 1024 + n, 1024, (bf16*)(ws + (l ? WS_WD1 : WS_WD0)), FFN, 64 * kb, 32 * nb, scr, lane); }
            continue; } r -= 2 * (I_GU + I_D);
        if (r < I_AIN) { const int nblk = 48, kb = r / nblk, nb = r % nblk, n = 32 * nb + ln;
            tr_item(n < AIN ? in[21] + n : nullptr, AIN, (bf16*)(ws + WS_WAIN), 1024, 64 * kb, 32 * nb, scr, lane); continue; } r -= I_AIN;
        if (r < I_QB) { const int nblk = 24, kb = r / nblk, nb = r % nblk, n = 32 * nb + ln, hh = n / 96, w = n % 96;
            int sc = n; if (w >= 64) { const int e = w - 64, blk = e >> 4, loc = e & 15; sc = hh * 96 + 64 + 16 * blk + 8 * (loc & 1) + (loc >> 1); }
            tr_item(in[25] + sc, MQD, (bf16*)(ws + WS_WQB), QL, 64 * kb, 32 * nb, scr, lane); continue; } r -= I_QB;
        if (r < I_KN) { const int nblk = 16, kb = r / nblk, nb = r % nblk, n = 32 * nb + ln;
            tr_item(in[27] + (n >> 6) * 128 + (n & 63), 1024, (bf16*)(ws + WS_WKN), KVL, 64 * kb, 32 * nb, scr, lane); continue; } r -= I_KN;
        if (r < I_KN) { const int nblk = 16, kb = r / nblk, nb = r % nblk, n = 32 * nb + ln;
            tr_item(in[27] + (n >> 6) * 128 + 64 + (n & 63), 1024, (bf16*)(ws + WS_WVT), KVL, 64 * kb, 32 * nb, scr, lane); continue; } r -= I_KN;
        { const int nblk = 32, kb = r / nblk, nb = r % nblk, n = 32 * nb + ln;
            tr_item(in[28] + n, 1024, (bf16*)(ws + WS_WAOUT), 1024, 64 * kb, 32 * nb, scr, lane); }
    }
}

__device__ __forceinline__ void p0_adaln(const float* const* in, unsigned char* ws, LAS unsigned char* lds, int tid, int wave, int lane, int G) {
    if ((int)blockIdx.x >= 192) return;
    LAS float* sS = (LAS float*)lds;
    LAS float* red = (LAS float*)(lds + 9 * 1024 * 4);
    float* MOD = (float*)(ws + WS_MOD);
    for (int i = tid; i < 9 * 1024; i += NTHR) { const int cnd = i >> 10, k = i & 1023; const float x = cnd == 0 ? in[7][k] : in[6][(cnd - 1) * 1024 + k]; sS[i] = fsilu(x); }
    __syncthreads();
    for (int it = blockIdx.x; it < 192; it += G) {
        const int l = it / 96, n0 = 64 * (it % 96);
        const float* wp = in[8] + (size_t)l * 1024 * 6144 + n0 + lane;
        float acc[9];
#pragma unroll
        for (int c = 0; c < 9; ++c) acc[c] = 0.f;
        const int kb = 128 * wave;
#pragma unroll 4
        for (int k = kb; k < kb + 128; k += 4) {
            const float w0 = wp[(size_t)(k + 0) * 6144], w1 = wp[(size_t)(k + 1) * 6144], w2 = wp[(size_t)(k + 2) * 6144], w3 = wp[(size_t)(k + 3) * 6144];
#pragma unroll
            for (int c = 0; c < 9; ++c) { const f32x4 s = *(const LAS f32x4*)(sS + c * 1024 + k); acc[c] += s.x * w0 + s.y * w1 + s.z * w2 + s.w * w3; }
        }
#pragma unroll
        for (int c = 0; c < 9; ++c) red[(wave * 9 + c) * 64 + lane] = acc[c];
        __syncthreads();
        for (int idx = tid; idx < 576; idx += NTHR) { const int c = idx >> 6, ln = idx & 63; float s = in[9][l * 6144 + n0 + ln];
#pragma unroll
            for (int w = 0; w < 8; ++w) s += red[(w * 9 + c) * 64 + ln];
            MOD[(size_t)(l * 9 + c) * 6144 + n0 + ln] = s; }
        __syncthreads();
    }
}
__device__ __forceinline__ void p0_tables(const float* const* in, unsigned char* ws, int tid) {
    f32x2* tabg = (f32x2*)(ws + WS_TABG); f32x2* tabm = (f32x2*)(ws + WS_TABM); float* bcin = (float*)(ws + WS_BCIN);
    for (int i = tid; i < 64 * 16; i += NTHR) { const int pos = i >> 4, f = i & 15; const float inv = exp2f(-(float)f * (13.287712379549449f / 16.f)), a = (float)pos * inv; tabg[i] = (f32x2){__cosf(a), __sinf(a)}; }
    for (int i = tid; i < 64 * 8; i += NTHR) { const int pos = i >> 3, f = i & 7; const float inv = exp2f(-(float)f * (13.287712379549449f / 8.f)), a = (float)pos * inv; tabm[i] = (f32x2){__cosf(a), __sinf(a)}; }
    for (int i = tid; i < CIN; i += NTHR) bcin[i] = i < 1536 ? 0.f : in[14][i - 1536];
}

__device__ __forceinline__ void phase_norm_in(const float* xp, const float* xs, const float* gpre, const float* modl, int sidx, bf16* H, int gw, int ngw, int lane) {
    for (int r = gw; r < T; r += ngw) {
        const f32x4* x4 = (const f32x4*)xrow_in(xp, xs, r) + lane;
        f32x4 v[4]; float ss = 0.f;
#pragma unroll
        for (int j = 0; j < 4; ++j) { v[j] = x4[64 * j]; ss += (v[j].x * v[j].x + v[j].y * v[j].y) + (v[j].z * v[j].z + v[j].w * v[j].w); }
        const float rstd = rsqrtf(wave_sum(ss) * (1.f / DM) + EPS);
        const float* mb = modl + (size_t)cond_of(r) * 6144;
        const f32x4* g4 = (const f32x4*)gpre + lane; const f32x4* sh4 = (const f32x4*)(mb + sidx * DM) + lane; const f32x4* sc4 = (const f32x4*)(mb + (sidx + 1) * DM) + lane;
        u32x2* h2 = (u32x2*)(H + (size_t)r * DM) + lane;
#pragma unroll
        for (int j = 0; j < 4; ++j) { const f32x4 g = g4[64 * j], sh = sh4[64 * j], sc = sc4[64 * j]; const f32x4 o = v[j] * rstd * g * (1.f + sc) + sh;
            h2[64 * j] = (u32x2){pk2(o.x, o.y), pk2(o.z, o.w)}; }
    }
}
template <bool NEXT>
__device__ __forceinline__ void phase_post(const bf16* O, const float* xp, const float* xs, float* Y, const float* gpost, const float* modl, int gidx,
                                           const float* gpre_n, const float* modn, int sidx_n, bf16* H, int gw, int ngw, int lane) {
    for (int r = gw; r < T; r += ngw) {
        const u32x2* o2 = (const u32x2*)(O + (size_t)r * DM) + lane; const f32x4* x4 = (const f32x4*)xrow_in(xp, xs, r) + lane;
        f32x4 o[4], x[4]; float ss = 0.f;
#pragma unroll
        for (int j = 0; j < 4; ++j) { const u32x2 w = o2[64 * j]; o[j] = (f32x4){bflo(w.x), bfhi(w.x), bflo(w.y), bfhi(w.y)}; x[j] = x4[64 * j];
            ss += (o[j].x * o[j].x + o[j].y * o[j].y) + (o[j].z * o[j].z + o[j].w * o[j].w); }
        const float ro = rsqrtf(wave_sum(ss) * (1.f / DM) + EPS);
        const int cnd = cond_of(r);
        const f32x4* gp4 = (const f32x4*)gpost + lane; const f32x4* gt4 = (const f32x4*)(modl + (size_t)cnd * 6144 + gidx * DM) + lane;
        f32x4* y4 = (f32x4*)(Y + (size_t)r * DM) + lane; float s2 = 0.f;
#pragma unroll
        for (int j = 0; j < 4; ++j) { const f32x4 gp = gp4[64 * j], gt = gt4[64 * j]; x[j] = x[j] + gt * (o[j] * ro * gp); y4[64 * j] = x[j];
            s2 += (x[j].x * x[j].x + x[j].y * x[j].y) + (x[j].z * x[j].z + x[j].w * x[j].w); }
        if (NEXT) {
            const float rx = rsqrtf(wave_sum(s2) * (1.f / DM) + EPS);
            const float* mb = modn + (size_t)cnd * 6144;
            const f32x4* g4 = (const f32x4*)gpre_n + lane; const f32x4* sh4 = (const f32x4*)(mb + sidx_n * DM) + lane; const f32x4* sc4 = (const f32x4*)(mb + (sidx_n + 1) * DM) + lane;
            u32x2* h2 = (u32x2*)(H + (size_t)r * DM) + lane;
#pragma unroll
            for (int j = 0; j < 4; ++j) { const f32x4 g = g4[64 * j], sh = sh4[64 * j], sc = sc4[64 * j]; const f32x4 h = x[j] * rx * g * (1.f + sc) + sh;
                h2[64 * j] = (u32x2){pk2(h.x, h.y), pk2(h.z, h.w)}; }
        }
    }
}

__device__ __forceinline__ void phase_conv(const bf16* U, bf16* MIX, const float* sc_w, const float* dw_w, const float* dw_b, const float* ln_g, const float* ln_b,
                                           LAS unsigned char* lds, int tid, int wave, int lane, int G) {
    LAS float* zs = (LAS float*)lds;
    LAS float* stat = (LAS float*)(lds + 63 * 512 * 4);
    const int c = tid;
    float w[31];
#pragma unroll
    for (int j = 0; j < 31; ++j) w[j] = dw_w[j * 512 + c];
    const float bdw = dw_b[c], lg = ln_g[c], lb = ln_b[c], s0w = sc_w[c], s1w = sc_w[512 + c], s2w = sc_w[1024 + c];
    for (int ch = blockIdx.x; ch < T / 32; ch += G) {
        const int r0 = 32 * ch;
        const int sq0 = r0 < TP ? (r0 & ~255) : TP + ((r0 - TP) & ~2047), sq1 = sq0 + (r0 < TP ? 256 : 2048);
        {   const bf16* up = U + (size_t)(r0 - 15) * CIN + c;
#pragma unroll 8
            for (int j = 0; j < 62; ++j) { const int rr = r0 - 15 + j; const bool ok = rr >= sq0 && rr < sq1;
                const float a = bf2f(up[(size_t)j * CIN + 1536]), g = bf2f(up[(size_t)j * CIN + 2048]); zs[j * 512 + c] = ok ? a * fsigmoid(g) : 0.f; }
            zs[62 * 512 + c] = 0.f; }
        {   float win[31];
#pragma unroll
            for (int j = 0; j < 31; ++j) win[j] = zs[j * 512 + c];
#pragma unroll 1
            for (int t = 0; t < 32; ++t) { float a = bdw;
#pragma unroll
                for (int j = 0; j < 31; ++j) a += w[j] * win[j];
                const float nxt = zs[(t + 31) * 512 + c];
                zs[t * 512 + c] = a;
#pragma unroll
                for (int j = 0; j < 30; ++j) win[j] = win[j + 1];
                win[30] = nxt; } }
        __syncthreads();
#pragma unroll
        for (int q = 0; q < 4; ++q) { const int t = 4 * wave + q; float a = 0.f, b = 0.f;
#pragma unroll
            for (int k = 0; k < 8; ++k) { const float x = zs[t * 512 + lane + 64 * k]; a += x; b += x * x; }
            a = wave_sum(a); b = wave_sum(b);
            const float mean = a * (1.f / 512.f), var = fmaxf(b * (1.f / 512.f) - mean * mean, 0.f);
            if (lane == 0) { stat[2 * t] = mean; stat[2 * t + 1] = rsqrtf(var + EPS); } }
        __syncthreads();
        {   bf16* mp = MIX + (size_t)r0 * DM + 512 + c;
#pragma unroll 4
            for (int t = 0; t < 32; ++t) { const f32x2 ms = *(const LAS f32x2*)(stat + 2 * t); const float y = (zs[t * 512 + c] - ms.x) * ms.y * lg + lb;
                mp[(size_t)t * DM] = f2bf(fsilu(y)); } }
        {   const bf16* up = U + (size_t)(r0 - 1) * CIN + c;
#pragma unroll 8
            for (int j = 0; j < 34; ++j) { const int rr = r0 - 1 + j; const bool ok = rr >= sq0 && rr < sq1;
                const float gc = bf2f(up[(size_t)j * CIN + 512]), xa = bf2f(up[(size_t)j * CIN + 1024]); zs[j * 512 + c] = ok ? gc * xa : 0.f; }
            const bf16* gp = U + (size_t)r0 * CIN + c; bf16* mp = MIX + (size_t)r0 * DM + c;
#pragma unroll 8
            for (int t = 0; t < 32; ++t) { const float gb = bf2f(gp[(size_t)t * CIN]);
                mp[(size_t)t * DM] = f2bf(gb * (s0w * zs[t * 512 + c] + s1w * zs[(t + 1) * 512 + c] + s2w * zs[(t + 2) * 512 + c])); } }
        __syncthreads();
    }
}

__device__ __forceinline__ void rope_head64(float (&v)[8], int lane, int prow, int pcol, const f32x2* tabg) {
    const int pos = (lane & 4) ? pcol : prow, i0 = 8 * (lane & 1); const bool second = (lane & 2) != 0;
#pragma unroll
    for (int j = 0; j < 8; ++j) { const float pv = __shfl_xor(v[j], 2); const f32x2 cs = tabg[pos * 16 + i0 + j];
        v[j] = second ? v[j] * cs.x + pv * cs.y : v[j] * cs.x - pv * cs.y; }
}
__device__ __forceinline__ void phase_attn_rows(const bf16* U1, const float* qn, const float* kn, const float* qan, const float* kvan, const f32x2* tabg, const f32x2* tabm,
                                                bf16* QC, bf16* KC, bf16* VtC, bf16* QA, bf16* CKV, bf16* KR, float* o_k, float* o_v, float* o_ckv, float* o_kr,
                                                const float* c_k, const float* c_v, const float* c_ckv, const float* c_kr, int gw, int ngw, int lane) {
    for (int r = gw; r < T; r += ngw) {
        const bool smp = r >= TP; const int ts = (r - TP) & 2047, prow = ts >> 6, pcol = ts & 63;
        const int krow = smp ? TP + ((r - TP) >> 11) * KSEQ + PAST + ts : r;
        const bf16* u = U1 + (size_t)r * AINP;
        {
            float v[8]; unpack8(*(const u32x4*)(u + 8 * lane), v);
            float ss = 0.f;
#pragma unroll
            for (int j = 0; j < 8; ++j) ss += v[j] * v[j];
            ss += __shfl_xor(ss, 1); ss += __shfl_xor(ss, 2); ss += __shfl_xor(ss, 4);
            const float rstd = rsqrtf(ss * (1.f / 64.f) + EPS); const int d0 = 8 * (lane & 7);
#pragma unroll
            for (int j = 0; j < 8; ++j) v[j] = v[j] * rstd * qn[d0 + j];
            float vr[8];
#pragma unroll
            for (int j = 0; j < 8; ++j) vr[j] = v[j];
            rope_head64(vr, lane, prow, pcol, tabg);
#pragma unroll
            for (int j = 0; j < 8; ++j) v[j] = smp ? vr[j] : v[j];
            *(u32x4*)(QC + (size_t)r * 512 + 8 * lane) = pack8(v);
        }
        {
            const int l2 = lane & 31; float v[8], raw[8]; unpack8(*(const u32x4*)(u + 512 + 8 * l2), v);
            float ss = 0.f;
#pragma unroll
            for (int j = 0; j < 8; ++j) { raw[j] = v[j]; ss += v[j] * v[j]; }
            ss += __shfl_xor(ss, 1); ss += __shfl_xor(ss, 2); ss += __shfl_xor(ss, 4);
            const float rstd = rsqrtf(ss * (1.f / 64.f) + EPS); const int d0 = 8 * (lane & 7);
#pragma unroll
            for (int j = 0; j < 8; ++j) v[j] = v[j] * rstd * kn[d0 + j];
            if (lane < 16 && !smp) { float* ok = o_k + (size_t)r * 128 + 8 * lane; *(f32x4*)ok = (f32x4){v[0], v[1], v[2], v[3]}; *(f32x4*)(ok + 4) = (f32x4){v[4], v[5], v[6], v[7]}; }
            float vr[8];
#pragma unroll
            for (int j = 0; j < 8; ++j) vr[j] = v[j];
            rope_head64(vr, lane, prow, pcol, tabg);
#pragma unroll
            for (int j = 0; j < 8; ++j) v[j] = smp ? vr[j] : v[j];
            if (lane < 16) *(u32x4*)(KC + (size_t)krow * 128 + 8 * lane) = pack8(v);
            else if (lane < 32) { const int cv = 8 * (lane - 16);
#pragma unroll
                for (int j = 0; j < 8; ++j) VtC[(size_t)(cv + j) * TK + krow] = f2bf(raw[j]);
                if (!smp) { float* ov = o_v + (size_t)r * 128 + cv; *(f32x4*)ov = (f32x4){raw[0], raw[1], raw[2], raw[3]}; *(f32x4*)(ov + 4) = (f32x4){raw[4], raw[5], raw[6], raw[7]}; } }
        }
        {
            const int l3 = lane < 48 ? lane : 0; float v[8]; unpack8(*(const u32x4*)(u + 768 + 8 * l3), v);
            float ss = 0.f;
#pragma unroll
            for (int j = 0; j < 8; ++j) ss += v[j] * v[j];
            ss = wave_sum(lane < 48 ? ss : 0.f);
            const float rstd = rsqrtf(ss * (1.f / 384.f) + EPS);
#pragma unroll
            for (int j = 0; j < 8; ++j) v[j] = v[j] * rstd * qan[8 * l3 + j];
            if (lane < 48) *(u32x4*)(QA + (size_t)r * QL + 8 * lane) = pack8(v);
        }
        {
            const int l2 = lane & 31; float v[8]; unpack8(*(const u32x4*)(u + 1152 + 8 * l2), v);
            float ss = 0.f;
#pragma unroll
            for (int j = 0; j < 8; ++j) ss += v[j] * v[j];
            ss = wave_sum(lane < 32 ? ss : 0.f);
            const float rstd = rsqrtf(ss * (1.f / 256.f) + EPS);
#pragma unroll
            for (int j = 0; j < 8; ++j) v[j] = v[j] * rstd * kvan[8 * l2 + j];
            if (lane < 32) { *(u32x4*)(CKV + (size_t)krow * KVL + 8 * lane) = pack8(v);
                if (!smp) { float* oc = o_ckv + (size_t)r * 256 + 8 * lane; *(f32x4*)oc = (f32x4){v[0], v[1], v[2], v[3]}; *(f32x4*)(oc + 4) = (f32x4){v[4], v[5], v[6], v[7]}; } }
        }
        {
            const int l4 = lane & 3; float v[8]; unpack8(*(const u32x4*)(u + 1408 + 8 * l4), v);
            const int blk = l4 >> 1, pos = blk ? pcol : prow; const bool second = (l4 & 1) != 0;
            if (lane < 4 && !smp) { float* okr = o_kr + (size_t)r * 32 + 8 * lane; *(f32x4*)okr = (f32x4){v[0], v[1], v[2], v[3]}; *(f32x4*)(okr + 4) = (f32x4){v[4], v[5], v[6], v[7]}; }
#pragma unroll
            for (int j = 0; j < 8; ++j) { const float pv = __shfl_xor(v[j], 1); const f32x2 cs = tabm[pos * 8 + j];
                const float rv = second ? v[j] * cs.x + pv * cs.y : v[j] * cs.x - pv * cs.y; v[j] = smp ? rv : v[j]; }
            if (lane < 4) {
#pragma unroll
                for (int j = 0; j < 8; ++j) KR[(size_t)krow * 32 + 16 * blk + 2 * j + (second ? 1 : 0)] = f2bf(v[j]); }
        }
    }
    for (int cr = gw; cr < NBS * PAST; cr += ngw) {
        const int krow = TP + (cr >> 8) * KSEQ + (cr & 255);
        if (lane < 32) { const f32x4 k4 = *(const f32x4*)(c_k + (size_t)cr * 128 + 4 * lane); *(u32x2*)(KC + (size_t)krow * 128 + 4 * lane) = (u32x2){pk2(k4.x, k4.y), pk2(k4.z, k4.w)};
            const f32x4 v4 = *(const f32x4*)(c_v + (size_t)cr * 128 + 4 * lane);
            VtC[(size_t)(4 * lane + 0) * TK + krow] = f2bf(v4.x); VtC[(size_t)(4 * lane + 1) * TK + krow] = f2bf(v4.y);
            VtC[(size_t)(4 * lane + 2) * TK + krow] = f2bf(v4.z); VtC[(size_t)(4 * lane + 3) * TK + krow] = f2bf(v4.w);
            const int e = lane, blk = e >> 4, loc = e & 15; KR[(size_t)krow * 32 + 16 * blk + 2 * (loc & 7) + (loc >> 3)] = f2bf(c_kr[(size_t)cr * 32 + e]); }
        { const f32x4 c4 = *(const f32x4*)(c_ckv + (size_t)cr * 256 + 4 * lane); *(u32x2*)(CKV + (size_t)krow * KVL + 4 * lane) = (u32x2){pk2(c4.x, c4.y), pk2(c4.z, c4.w)}; }
    }
}

#define MFMA32(a, b, c) __builtin_amdgcn_mfma_f32_32x32x16_bf16((a), (b), (c), 0, 0, 0)
template <bool MLA>
__device__ __forceinline__ void attn_unit(LAS unsigned char* lds, const bf16* Q, int ldq, const bf16* K, int ldk, const bf16* KRp, const bf16* Vt, int nkeys, bf16* O, float c,
                                          const f32x2* tabm, int qpos0, int tid, int wave, int lane) {
    constexpr int NQ = MLA ? 6 : 4;
    constexpr int KB_SZ = 64 * 144, KR_OFF = 2 * KB_SZ, KR_SZ = 64 * 80, VT_OFF = KR_OFF + 2 * KR_SZ, VT_SZ = 64 * 136;
    const int r = lane & 31, h = lane >> 5;
    bf16x8 qf[NQ];
    { const bf16* qrow = Q + (size_t)(32 * wave + r) * ldq + 8 * h;
#pragma unroll
      for (int ks = 0; ks < NQ; ++ks) qf[ks] = *(const bf16x8*)(qrow + 16 * ks); }
    if (MLA && qpos0 >= 0) {
        const int ts = qpos0 + 32 * wave + r, prow = ts >> 6, pcol = ts & 63;
#pragma unroll
        for (int blk = 0; blk < 2; ++blk) { const u32x4 w = __builtin_bit_cast(u32x4, qf[NQ - 2 + blk]); float v[8]; unpack8(w, v); const int pos = blk ? pcol : prow;
#pragma unroll
            for (int jj = 0; jj < 4; ++jj) { const f32x2 cs = tabm[pos * 8 + 4 * h + jj]; const float x1 = v[2 * jj], x2 = v[2 * jj + 1]; v[2 * jj] = x1 * cs.x - x2 * cs.y; v[2 * jj + 1] = x2 * cs.x + x1 * cs.y; }
            qf[NQ - 2 + blk] = __builtin_bit_cast(bf16x8, pack8(v)); }
    }
    f32x16 o0, o1;
#pragma unroll
    for (int i = 0; i < 16; ++i) { o0[i] = 0.f; o1[i] = 0.f; }
    float m = -1e30f, l = 0.f;
    const int skey = tid >> 3, sch = tid & 7;
    const bf16* kg = K + (size_t)skey * ldk + 8 * sch;
    const bf16* vg = Vt + (size_t)skey * TK + 8 * sch;
    const bf16* rg = KRp + (size_t)(tid >> 2) * 32 + 8 * (tid & 3);
    const int kw = skey * 144 + sch * 16, vw = skey * 136 + sch * 16, rw = (tid >> 2) * 80 + (tid & 3) * 16;
    const int nt = nkeys >> 6;
    u32x4 kreg = *(const u32x4*)kg, vreg = *(const u32x4*)vg, rreg = (u32x4){0u, 0u, 0u, 0u};
    if (MLA && tid < 256) rreg = *(const u32x4*)rg;
    *(LAS u32x4*)(lds + kw) = kreg;
    *(LAS u32x2*)(lds + VT_OFF + vw) = (u32x2){vreg.x, vreg.y}; *(LAS u32x2*)(lds + VT_OFF + vw + 8) = (u32x2){vreg.z, vreg.w};
    if (MLA && tid < 256) *(LAS u32x4*)(lds + KR_OFF + rw) = rreg;
    __syncthreads();
    for (int j = 0; j < nt; ++j) {
        const int cur = j & 1; const bool more = j + 1 < nt;
        if (more) { kreg = *(const u32x4*)(kg + (size_t)(j + 1) * 64 * ldk); vreg = *(const u32x4*)(vg + (j + 1) * 64);
            if (MLA && tid < 256) rreg = *(const u32x4*)(rg + (size_t)(j + 1) * 64 * 32); }
        const LAS unsigned char* kb = lds + cur * KB_SZ; const LAS unsigned char* rb = lds + KR_OFF + cur * KR_SZ; const LAS unsigned char* vb = lds + VT_OFF + cur * VT_SZ;
        f32x16 p0, p1;
#pragma unroll
        for (int i = 0; i < 16; ++i) { p0[i] = 0.f; p1[i] = 0.f; }
#pragma unroll
        for (int ks = 0; ks < 4; ++ks) { const bf16x8 a0 = *(const LAS bf16x8*)(kb + r * 144 + ks * 32 + h * 16), a1 = *(const LAS bf16x8*)(kb + (32 + r) * 144 + ks * 32 + h * 16);
            p0 = MFMA32(a0, qf[ks], p0); p1 = MFMA32(a1, qf[ks], p1); }
        if (MLA) {
#pragma unroll
            for (int ks = 0; ks < 2; ++ks) { const bf16x8 a0 = *(const LAS bf16x8*)(rb + r * 80 + ks * 32 + h * 16), a1 = *(const LAS bf16x8*)(rb + (32 + r) * 80 + ks * 32 + h * 16);
                p0 = MFMA32(a0, qf[NQ - 2 + ks], p0); p1 = MFMA32(a1, qf[NQ - 2 + ks], p1); } }
        __builtin_amdgcn_sched_barrier(0);
        float mx = p0[0];
#pragma unroll
        for (int i = 1; i < 16; ++i) mx = fmaxf(mx, p0[i]);
#pragma unroll
        for (int i = 0; i < 16; ++i) mx = fmaxf(mx, p1[i]);
        mx = fmaxf(mx, __shfl_xor(mx, 32));
        const float mn = fmaxf(m, mx), alpha = __builtin_amdgcn_exp2f((m - mn) * c), mc = -mn * c; m = mn;
        float ps = 0.f;
#pragma unroll
        for (int i = 0; i < 16; ++i) { p0[i] = __builtin_amdgcn_exp2f(fmaf(p0[i], c, mc)); ps += p0[i]; }
#pragma unroll
        for (int i = 0; i < 16; ++i) { p1[i] = __builtin_amdgcn_exp2f(fmaf(p1[i], c, mc)); ps += p1[i]; }
        l = l * alpha + ps;
#pragma unroll
        for (int i = 0; i < 16; ++i) { o0[i] *= alpha; o1[i] *= alpha; }
        __builtin_amdgcn_sched_barrier(0);
        bf16x8 pb[2][2];
#pragma unroll
        for (int s = 0; s < 2; ++s) {
            u32x4 w0; w0.x = pk2(p0[8 * s + 0], p0[8 * s + 1]); w0.y = pk2(p0[8 * s + 2], p0[8 * s + 3]); w0.z = pk2(p0[8 * s + 4], p0[8 * s + 5]); w0.w = pk2(p0[8 * s + 6], p0[8 * s + 7]);
            u32x4 w1; w1.x = pk2(p1[8 * s + 0], p1[8 * s + 1]); w1.y = pk2(p1[8 * s + 2], p1[8 * s + 3]); w1.z = pk2(p1[8 * s + 4], p1[8 * s + 5]); w1.w = pk2(p1[8 * s + 6], p1[8 * s + 7]);
            pb[0][s] = __builtin_bit_cast(bf16x8, w0); pb[1][s] = __builtin_bit_cast(bf16x8, w1); }
#pragma unroll
        for (int t = 0; t < 2; ++t)
#pragma unroll
            for (int s = 0; s < 2; ++s) { const int ko = (32 * t + 16 * s + 4 * h) * 2;
                { const u32x2 lo = *(const LAS u32x2*)(vb + r * 136 + ko), hi = *(const LAS u32x2*)(vb + r * 136 + ko + 16);
                  o0 = MFMA32(__builtin_bit_cast(bf16x8, ((u32x4){lo.x, lo.y, hi.x, hi.y})), pb[t][s], o0); }
                { const u32x2 lo = *(const LAS u32x2*)(vb + (32 + r) * 136 + ko), hi = *(const LAS u32x2*)(vb + (32 + r) * 136 + ko + 16);
                  o1 = MFMA32(__builtin_bit_cast(bf16x8, ((u32x4){lo.x, lo.y, hi.x, hi.y})), pb[t][s], o1); }
                __builtin_amdgcn_sched_barrier(0); }
        if (more) { const int nx = cur ^ 1;
            *(LAS u32x4*)(lds + nx * KB_SZ + kw) = kreg;
            *(LAS u32x2*)(lds + VT_OFF + nx * VT_SZ + vw) = (u32x2){vreg.x, vreg.y}; *(LAS u32x2*)(lds + VT_OFF + nx * VT_SZ + vw + 8) = (u32x2){vreg.z, vreg.w};
            if (MLA && tid < 256) *(LAS u32x4*)(lds + KR_OFF + nx * KR_SZ + rw) = rreg; }
        __syncthreads();
    }
    l += __shfl_xor(l, 32);
    const float inv = 1.f / l;
    bf16* orow = O + (size_t)(32 * wave + r) * DM;
#pragma unroll
    for (int g = 0; g < 4; ++g) {
        *(u32x2*)(orow + 8 * g + 4 * h) = (u32x2){pk2(o0[4 * g] * inv, o0[4 * g + 1] * inv), pk2(o0[4 * g + 2] * inv, o0[4 * g + 3] * inv)};
        *(u32x2*)(orow + 32 + 8 * g + 4 * h) = (u32x2){pk2(o1[4 * g] * inv, o1[4 * g + 1] * inv), pk2(o1[4 * g + 2] * inv, o1[4 * g + 3] * inv)}; }
}
__device__ __forceinline__ void phase_attention(unsigned char* ws, LAS unsigned char* lds, const f32x2* tabm, int tid, int wave, int lane, int G) {
    const bf16* QC = (const bf16*)(ws + WS_C + C_QC); const bf16* MQ = (const bf16*)(ws + WS_C + C_MQ); const bf16* KN = (const bf16*)(ws + WS_C + C_KN);
    const bf16* VTM = (const bf16*)(ws + WS_C + C_VTM); const bf16* KC = (const bf16*)(ws + WS_A + A_KC); const bf16* VTC = (const bf16*)(ws + WS_A + A_VTC);
    const bf16* KR = (const bf16*)(ws + WS_A + A_KR); bf16* ATT = (bf16*)(ws + WS_B);
    constexpr float C_G = 0.125f * 1.4426950408889634f, C_M = 0.10206207261596577f * 1.4426950408889634f;
    for (int i = blockIdx.x; i < 1280; i += G) {
        bool mla; int row0, key0, nkeys, hh, qpos0;
        if (i < 1024) { mla = i < 512; const int ii = i & 511, b = ii >> 6, qb = ii & 7; hh = (ii >> 3) & 7; row0 = TP + b * SEQS + qb * 256; key0 = TP + b * KSEQ; nkeys = KSEQ; qpos0 = qb * 256; }
        else { mla = i < 1152; const int ii = (i - 1024) & 127, b = ii >> 3; hh = ii & 7; row0 = b * 256; key0 = row0; nkeys = 256; qpos0 = -1; }
        if (mla) attn_unit<true>(lds, MQ + (size_t)row0 * MQD + hh * 96, MQD, KN + (size_t)key0 * 512 + hh * 64, 512, KR + (size_t)key0 * 32, VTM + (size_t)(hh * 64) * TK + key0, nkeys,
                                 ATT + (size_t)row0 * DM + 512 + hh * 64, C_M, tabm, qpos0, tid, wave, lane);
        else attn_unit<false>(lds, QC + (size_t)row0 * 512 + hh * 64, 512, KC + (size_t)key0 * 128 + (hh >> 2) * 64, 128, KR, VTC + (size_t)((hh >> 2) * 64) * TK + key0, nkeys,
                              ATT + (size_t)row0 * DM + hh * 64, C_G, tabm, -1, tid, wave, lane);
    }
}

#define XB_TMO      128
#define XB_XCNT(j)  (256  + 64 * (j))
#define XB_XSUB(j)  (1280 + 64 * (j))
#define XB_XGEN(j)  (2304 + 64 * (j))
#define XB_TOP      3328
#define XB_TOPGEN   3392
#define XCD_BAR_WORDS 3456
#define XB_SPIN_CAP (1u << 18)

__device__ __forceinline__ unsigned xb_ld(unsigned* p)              { return __hip_atomic_load(p, __ATOMIC_RELAXED, __HIP_MEMORY_SCOPE_AGENT); }
__device__ __forceinline__ unsigned xb_add(unsigned* p, unsigned v) { return __hip_atomic_fetch_add(p, v, __ATOMIC_RELAXED, __HIP_MEMORY_SCOPE_AGENT); }
__device__ __forceinline__ unsigned xb_xcc_id() { return (unsigned)__builtin_amdgcn_s_getreg((3 << 11) | 20) & 0xFu; }
#define XB_SPIN(cond, bar) do { unsigned _sp = 0; while (cond) { __builtin_amdgcn_s_sleep(1); \
    if ((++_sp & 255u) == 0u) { if (xb_ld(&(bar)[XB_TMO])) break; if (_sp > XB_SPIN_CAP) { atomicAdd(&(bar)[XB_TMO], 1u); break; } } } } while (0)

struct XcdBarrier {
    unsigned* bar; unsigned x;
    volatile LAS unsigned* st;
};

__device__ __forceinline__ XcdBarrier xcd_barrier_post(unsigned* bar, volatile LAS unsigned* st) {
    XcdBarrier b; b.bar = bar; b.x = xb_xcc_id(); b.st = st;
    if (threadIdx.x == 0) (void)xb_add(&bar[XB_XCNT(b.x)], 1u);
    return b;
}
__device__ __forceinline__ void xcd_barrier_complete(unsigned* bar, unsigned x, unsigned& nloc, unsigned& nx) {
    const unsigned G = gridDim.x * gridDim.y * gridDim.z;
    unsigned sum, cnt, mine, sp = 0u;
    for (;;) {
        sum = 0u; cnt = 0u; mine = 0u;
#pragma unroll
        for (unsigned j = 0; j < 16; ++j) { const unsigned c = xb_ld(&bar[XB_XCNT(j)]); sum += c; cnt += (c > 0u) ? 1u : 0u; mine = (j == x) ? c : mine; }
        if (sum == G) break;
        __builtin_amdgcn_s_sleep(1);
        if ((++sp & 255u) == 0u) { if (xb_ld(&bar[XB_TMO])) break; if (sp > XB_SPIN_CAP) { atomicAdd(&bar[XB_TMO], 1u); break; } }
    }
    nloc = mine > 0u ? mine : 1u; nx = cnt > 0u ? cnt : 1u;
}

__device__ __forceinline__ void xcd_barrier(const XcdBarrier& b) {
    asm volatile("s_waitcnt vmcnt(0)" ::: "memory");
    __syncthreads();
    if (threadIdx.x == 0) {
        unsigned* bar = b.bar;
        __builtin_amdgcn_s_waitcnt(0);
        unsigned nloc = b.st[0], nx = b.st[1];
        if (nloc == 0u) { xcd_barrier_complete(bar, b.x, nloc, nx); b.st[0] = nloc; b.st[1] = nx; }
        const unsigned old = xb_add(&bar[XB_XSUB(b.x)], 1u);
        const unsigned gen = old / nloc;
        if (old + 1u == (gen + 1u) * nloc) {
            __builtin_amdgcn_fence(__ATOMIC_RELEASE, "agent");
            asm volatile("s_waitcnt vmcnt(0)" ::: "memory");
            const unsigned og = xb_add(&bar[XB_TOP], 1u);
            const unsigned tg = og / nx;
            if (og + 1u == (tg + 1u) * nx) xb_add(&bar[XB_TOPGEN], 1u);
            else XB_SPIN(xb_ld(&bar[XB_TOPGEN]) == tg, bar);
            __builtin_amdgcn_fence(__ATOMIC_ACQUIRE, "agent");
            xb_add(&bar[XB_XGEN(b.x)], 1u);
            asm volatile("s_waitcnt vmcnt(0)" ::: "memory");
        } else {
            XB_SPIN(xb_ld(&bar[XB_XGEN(b.x)]) == gen, bar);
            __builtin_amdgcn_fence(__ATOMIC_ACQUIRE, "agent");
            asm volatile("s_waitcnt vmcnt(0)" ::: "memory");
        }
    }
    __syncthreads();
}

struct Args { const float* in[32]; float* out; unsigned char* ws; int ph_lo, ph_hi; };
constexpr int NPHASE = 18;

template <class Epi>
__device__ __forceinline__ void run_gemm(LAS unsigned char* lds, const bf16* A, const bf16* Bt, int M, int N, int K, int G, int cid, const Epi& E) {
    pg8::Gemm g{A, Bt, M, N, K}; pg8::StaticOrder S; S.init(M, N, G, cid);
    pg8::gemm_phase<Epi, pg8::StaticOrder, true, true>(lds, g, S, E);
}

__global__ void __launch_bounds__(NTHR, 2) fwd_kernel(Args args) {
    extern __shared__ __attribute__((aligned(16))) unsigned char lds_raw[];
    LAS unsigned char* lds = (LAS unsigned char*)lds_raw;
#if MK_CG_SYNC
    cg::grid_group grid = cg::this_grid();
#endif
    const int tid = threadIdx.x, lane = tid & 63, wave = __builtin_amdgcn_readfirstlane(tid >> 6);
    const int G = gridDim.x, bid = blockIdx.x, gw = bid * NWAVES + wave, ngw = G * NWAVES;
    unsigned char* ws = args.ws; const float* const* in = args.in; float* out = args.out;
    const int lo = args.ph_lo, hi = args.ph_hi;
#ifndef PH_MASK
#define PH_MASK 0x3ffff
#endif
#define IN(k) (((PH_MASK >> (k)) & 1) && lo <= (k) && (k) < hi)
#if MK_CG_SYNC
#define SEAM(k) do { if (IN(k) && IN((k) + 1)) grid.sync(); } while (0)
#else
    if (tid < 2) ((volatile LAS unsigned*)(lds + 131072))[tid] = 0u;
    __syncthreads();
    const XcdBarrier bar = xcd_barrier_post((unsigned*)(args.ws + WS_CTL), (volatile LAS unsigned*)(lds + 131072));
#define SEAM(k) do { if (IN(k) && IN((k) + 1)) xcd_barrier(bar); } while (0)
#endif
    bf16* H = (bf16*)(ws + WS_A); bf16* OB = (bf16*)(ws + WS_A); bf16* MIX = (bf16*)(ws + WS_B); bf16* ATT = (bf16*)(ws + WS_B);
    bf16* U = (bf16*)(ws + WS_C); bf16* ACT = (bf16*)(ws + WS_C);
    const float* MOD0 = (const float*)(ws + WS_MOD); const float* MOD1 = MOD0 + 9 * 6144;
    const f32x2* tabg = (const f32x2*)(ws + WS_TABG); const f32x2* tabm = (const f32x2*)(ws + WS_TABM);
    float* Y = out + OUT_Y;

    if (IN(0)) {
        p0_adaln(in, ws, lds, tid, wave, lane, G);
        if (bid == G - 1) p0_tables(in, ws, tid);
        p0_weights(in, ws, (LAS float*)(lds + 57344 + wave * 8448), gw, ngw, lane);
    }
    SEAM(0);
    if (IN(1)) phase_norm_in(in[0], in[1], in[10] + 0 * DM, MOD0, 0, H, gw, ngw, lane);
    SEAM(1);
    if (IN(2)) run_gemm(lds, H, (const bf16*)(ws + WS_WCIN), T, CIN, 1024, G, bid, EpiStore{U, CIN, (const float*)(ws + WS_BCIN)});
    SEAM(2);
    if (IN(3)) phase_conv(U, MIX, in[13], in[15], in[16], in[17], in[18], lds, tid, wave, lane, G);
    SEAM(3);
    if (IN(4)) run_gemm(lds, MIX, (const bf16*)(ws + WS_WCOUT), T, 1024, 1024, G, bid, EpiStore{OB, DM, in[20]});
    SEAM(4);
    if (IN(5)) phase_post<true>(OB, in[0], in[1], Y, in[11] + 0 * DM, MOD0, 2, in[10] + 1 * DM, MOD0, 3, H, gw, ngw, lane);
    SEAM(5);
    if (IN(6)) run_gemm(lds, H, (const bf16*)(ws + WS_WGU0), T, 2 * FFN, 1024, G, bid, EpiSwiGLU{ACT});
    SEAM(6);
    if (IN(7)) run_gemm(lds, ACT, (const bf16*)(ws + WS_WD0), T, 1024, FFN, G, bid, EpiStore{OB, DM, nullptr});
    SEAM(7);
    if (IN(8)) phase_post<true>(OB, Y, Y + (size_t)TP * DM, Y, in[11] + 1 * DM, MOD0, 5, in[10] + 2 * DM, MOD1, 0, H, gw, ngw, lane);
    SEAM(8);
    if (IN(9)) run_gemm(lds, H, (const bf16*)(ws + WS_WAIN), T, AINP, 1024, G, bid, EpiStore{(bf16*)(ws + WS_C + C_U1), AINP, nullptr});
    SEAM(9);
    if (IN(10)) phase_attn_rows((const bf16*)(ws + WS_C + C_U1), in[22], in[23], in[24], in[26], tabg, tabm,
                                (bf16*)(ws + WS_C + C_QC), (bf16*)(ws + WS_A + A_KC), (bf16*)(ws + WS_A + A_VTC), (bf16*)(ws + WS_A + A_QA), (bf16*)(ws + WS_A + A_CKV), (bf16*)(ws + WS_A + A_KR),
                                out + OUT_K, out + OUT_V, out + OUT_CKV, out + OUT_KR, in[2], in[3], in[4], in[5], gw, ngw, lane);
    SEAM(10);
    if (IN(11)) {
        run_gemm(lds, (const bf16*)(ws + WS_A + A_QA), (const bf16*)(ws + WS_WQB), T, MQD, QL, G, bid, EpiStore{(bf16*)(ws + WS_C + C_MQ), MQD, nullptr});
        run_gemm(lds, (const bf16*)(ws + WS_A + A_CKV), (const bf16*)(ws + WS_WKN), TK, 512, KVL, G, (bid + 240) % G, EpiStore{(bf16*)(ws + WS_C + C_KN), 512, nullptr});
        run_gemm(lds, (const bf16*)(ws + WS_WVT), (const bf16*)(ws + WS_A + A_CKV), 512, TK, KVL, G, (bid + 160) % G, EpiStore{(bf16*)(ws + WS_C + C_VTM), TK, nullptr});
    }
    SEAM(11);
    if (IN(12)) phase_attention(ws, lds, tabm, tid, wave, lane, G);
    SEAM(12);
    if (IN(13)) run_gemm(lds, ATT, (const bf16*)(ws + WS_WAOUT), T, 1024, 1024, G, bid, EpiStore{OB, DM, nullptr});
    SEAM(13);
    if (IN(14)) phase_post<true>(OB, Y, Y + (size_t)TP * DM, Y, in[11] + 2 * DM, MOD1, 2, in[10] + 3 * DM, MOD1, 3, H, gw, ngw, lane);
    SEAM(14);
    if (IN(15)) run_gemm(lds, H, (const bf16*)(ws + WS_WGU1), T, 2 * FFN, 1024, G, bid, EpiSwiGLU{ACT});
    SEAM(15);
    if (IN(16)) run_gemm(lds, ACT, (const bf16*)(ws + WS_WD1), T, 1024, FFN, G, bid, EpiStore{OB, DM, nullptr});
    SEAM(16);
    if (IN(17)) phase_post<false>(OB, Y, Y + (size_t)TP * DM, Y, in[11] + 3 * DM, MOD1, 5, nullptr, nullptr, 0, nullptr, gw, ngw, lane);
#undef IN
#undef SEAM
}

#ifndef MK_ONE_LAUNCH
#define MK_ONE_LAUNCH 1
#endif
extern "C" void kernel_launch(void* const* d_in, const int* in_sizes, int n_in, void* d_out, int out_size, void* d_ws, size_t ws_size, hipStream_t stream) {
    static int grid = 0;
    if (grid == 0) {
        if (n_in != 32 || ws_size < WS_END) { fprintf(stderr, "kernel_launch: unexpected inputs (n_in %d, ws %zu)\n", n_in, ws_size); grid = -1; return; }
        int dev = 0, cus = 0, per_cu = 0;
        (void)hipGetDevice(&dev); (void)hipDeviceGetAttribute(&cus, hipDeviceAttributeMultiprocessorCount, dev);
        if (hipFuncSetAttribute((const void*)fwd_kernel, hipFuncAttributeMaxDynamicSharedMemorySize, LDS_BYTES) != hipSuccess) { fprintf(stderr, "kernel_launch: hipFuncSetAttribute failed\n"); grid = -1; return; }
        if (hipOccupancyMaxActiveBlocksPerMultiprocessor(&per_cu, (const void*)fwd_kernel, NTHR, LDS_BYTES) != hipSuccess || per_cu < 1) { fprintf(stderr, "kernel_launch: occupancy query says %d\n", per_cu); per_cu = 1; }
        (void)hipGetLastError();
        grid = cus;
    }
    if (grid < 0) return;
    Args a{};
    for (int i = 0; i < 32; ++i) a.in[i] = (const float*)d_in[i];
    a.out = (float*)d_out; a.ws = (unsigned char*)d_ws;
#if MK_ONE_LAUNCH && MK_CG_SYNC
    a.ph_lo = 0; a.ph_hi = NPHASE;
    void* kargs[] = {&a};
    hipError_t e = hipLaunchCooperativeKernel((const void*)fwd_kernel, dim3(grid), dim3(NTHR), kargs, LDS_BYTES, stream);
    if (e != hipSuccess) fprintf(stderr, "kernel_launch: cooperative launch failed: %s (grid %d)\n", hipGetErrorString(e), grid);
#elif MK_ONE_LAUNCH
    if (hipMemsetAsync((char*)d_ws + WS_CTL, 0, 16384, stream) != hipSuccess) { fprintf(stderr, "kernel_launch: memset failed\n"); return; }
    a.ph_lo = 0; a.ph_hi = NPHASE;
    hipLaunchKernelGGL(fwd_kernel, dim3(grid), dim3(NTHR), LDS_BYTES, stream, a);
#else
    for (int p = 0; p < NPHASE; ++p) { a.ph_lo = p; a.ph_hi = p + 1; hipLaunchKernelGGL(fwd_kernel, dim3(grid), dim3(NTHR), LDS_BYTES, stream, a); }
#endif
}
```

```cpp
#include <hip/hip_runtime.h>
#include <hip/hip_cooperative_groups.h>
#include <cstdio>
#include <cstdint>
namespace cg = cooperative_groups;
#ifndef MK_CG_SYNC
#define MK_CG_SYNC 0
#endif
namespace pg8 {
#define PG8_LAS __attribute__((address_space(3)))
typedef unsigned short bf16_t;
typedef short bf16x8 __attribute__((ext_vector_type(8)));
typedef float f32x4 __attribute__((ext_vector_type(4)));
typedef unsigned u32x4 __attribute__((ext_vector_type(4)));
constexpr int BM = 256, BK = 64, HALF = 128, HTB = HALF * BK * 2  , STAGE_BYTES = 8 * HTB, NXCD = 8, WGM = 8;

__host__ __device__ __forceinline__ int lds_byte(int r, int c) { const int st = (r >> 4) * 2 + (c >> 5), rr = r & 15, cc = c & 31, ob = rr * 64 + cc * 2; return st * 1024 + (ob ^ (((ob >> 9) & 1) << 5)); }
__host__ __device__ __forceinline__ void stage_rc(int b, int& R, int& C) { const int st = b / 1024, sb = b % 1024, swz = sb ^ (((sb >> 9) & 1) << 5); R = (st >> 1) * 16 + swz / 64; C = (st & 1) * 32 + (swz % 64) / 2; }
__host__ __device__ __forceinline__ int perm32(int rho) { const int n = rho >> 4, i = rho & 15; return 8 * (i >> 2) + 4 * n + (i & 3); }

struct Unit { int pm, pn; };
struct Gemm { const bf16_t* A; const bf16_t* Bt; int M, N, K; };

struct StaticOrder {
    int nM, nN, nwg, G, c;
    __host__ __device__ void init(int M, int N, int G_, int c_) { nM = M / BM; nN = N / BM; nwg = nM * nN; G = G_; c = c_; }
    __host__ __device__ bool next(int i, Unit& u) const {
        const long L = (long)i * G + c; if (L >= nwg) return false;
        int wgid = (int)L; { const int q = nwg / NXCD, r = nwg % NXCD, xcd = wgid % NXCD, off = wgid / NXCD; wgid = (xcd < r ? xcd * (q + 1) : r * (q + 1) + (xcd - r) * q) + off; }
        const int nig = WGM * nN, gid = wgid / nig, fm = gid * WGM, gsz = (nM - fm) < WGM ? (nM - fm) : WGM;
        u.pm = fm + ((wgid % nig) % gsz); u.pn = (wgid % nig) / gsz; return true;
    }
    __device__ __forceinline__ void a_ready(const Unit&) const {}
    __device__ __forceinline__ void done(const Unit&) const {}
};

__device__ __forceinline__ unsigned cvt_pk_bf16(float lo, float hi) { unsigned r; asm volatile("v_cvt_pk_bf16_f32 %0, %1, %2" : "=v"(r) : "v"(lo), "v"(hi)); return r; }
template <class Epi, class Sched, bool ALIGN_EPI = false, bool SP2 = false>
__device__ __forceinline__ void gemm_phase(PG8_LAS unsigned char* lds, const Gemm g, const Sched& S, const Epi& E) {
    const int tid = threadIdx.x, wid = __builtin_amdgcn_readfirstlane(tid >> 6), lane = tid & 63, wr = wid >> 2, wc = wid & 3, fr = lane & 15, fq = lane >> 4;
    const int K = g.K, nt = K / BK;
    unsigned voffA[2], voffB[2];
#pragma unroll
    for (int i = 0; i < 2; ++i) { int R, C; stage_rc(tid * 16 + i * 8192, R, C); const int Rb = Epi::PERM ? ((R & ~31) + perm32(R & 31)) : R;
        voffA[i] = (unsigned)(R * K + C) * 2u; voffB[i] = (unsigned)(Rb * K + C) * 2u; }
    const size_t kstep = (size_t)(BK * 2);
    const size_t hstep = (size_t)HALF * K * 2;
    const size_t tstep = 2 * hstep;
    const unsigned ldsw = (unsigned)wid * 1024u;
    const int aoff = lds_byte(wr * 64 + fr, fq * 8), boff = lds_byte(wc * 32 + fr, fq * 8);
#define PG8_SA(b, h) (((b) * 2 + (h)) * HTB)
#define PG8_SB(b, h) ((4 + (b) * 2 + (h)) * HTB)
#define PG8_STAGE(bufoff, gbase, voff) do { _Pragma("unroll") for (int _i = 0; _i < 2; ++_i) \
        __builtin_amdgcn_global_load_lds((const unsigned*)((const char*)(gbase) + (voff)[_i]), (PG8_LAS unsigned*)(lds + (bufoff) + ldsw + _i * 8192), 16, 0, 0); } while (0)
#define PG8_LDA(dst, b, h) do { _Pragma("unroll") for (int m = 0; m < 4; ++m) _Pragma("unroll") for (int k = 0; k < 2; ++k) dst[m][k] = *(const PG8_LAS bf16x8*)(lds + PG8_SA(b, h) + aoff + m * 2048 + k * 1024); } while (0)
#define PG8_LDB(dst, b, h) do { _Pragma("unroll") for (int n = 0; n < 2; ++n) _Pragma("unroll") for (int k = 0; k < 2; ++k) dst[n][k] = *(const PG8_LAS bf16x8*)(lds + PG8_SB(b, h) + boff + n * 2048 + k * 1024); } while (0)
#define PG8_MMA(ai, bj, At, Bt) do { __builtin_amdgcn_s_setprio(1); _Pragma("unroll") for (int m = 0; m < 4; ++m) _Pragma("unroll") for (int n = 0; n < 2; ++n) _Pragma("unroll") for (int k = 0; k < 2; ++k) \
        acc[ai][bj][m][n] = __builtin_amdgcn_mfma_f32_16x16x32_bf16(Bt[n][k], At[m][k], acc[ai][bj][m][n], 0, 0, 0); __builtin_amdgcn_s_setprio(0); } while (0)
#define PG8_WAIT_V(n) asm volatile("s_waitcnt vmcnt(" #n ")" ::: "memory")
#define PG8_WAIT_L(n) asm volatile("s_waitcnt lgkmcnt(" #n ")" ::: "memory")
#define PG8_BAR __builtin_amdgcn_s_barrier()
#define PG8_SCHED __builtin_amdgcn_sched_barrier(0)
    Unit cur, nxt; int ui = 0;
    if (!S.next(0, cur)) return;
    f32x4 acc[2][2][4][2];
#pragma unroll
    for (int a = 0; a < 2; ++a)
#pragma unroll
        for (int b = 0; b < 2; ++b)
#pragma unroll
            for (int m = 0; m < 4; ++m)
#pragma unroll
                for (int n = 0; n < 2; ++n) acc[a][b][m][n] = (f32x4){0.f, 0.f, 0.f, 0.f};
    bf16x8 At[4][2], B0[2][2], B1[2][2];
    const char* cA = (const char*)g.A + (size_t)cur.pm * tstep; const char* cB = (const char*)g.Bt + (size_t)cur.pn * tstep;
    S.a_ready(cur);
    if constexpr (SP2) {
        PG8_STAGE(PG8_SB(0, 0), cB, voffB); PG8_STAGE(PG8_SB(0, 1), cB + hstep, voffB); PG8_STAGE(PG8_SA(0, 0), cA, voffA); PG8_STAGE(PG8_SA(0, 1), cA + hstep, voffA);
        if (wr == 1) PG8_BAR;
        PG8_WAIT_V(2); PG8_BAR;
        PG8_STAGE(PG8_SB(1, 0), cB + kstep, voffB); PG8_STAGE(PG8_SA(1, 0), cA + kstep, voffA); PG8_STAGE(PG8_SB(1, 1), cB + hstep + kstep, voffB);
        PG8_WAIT_V(6); PG8_BAR;
    } else {
        PG8_STAGE(PG8_SB(0, 0), cB, voffB); PG8_STAGE(PG8_SA(0, 0), cA, voffA); PG8_STAGE(PG8_SB(0, 1), cB + hstep, voffB); PG8_STAGE(PG8_SA(0, 1), cA + hstep, voffA);
        if (wr == 1) PG8_BAR;
        PG8_WAIT_V(4); PG8_BAR;
        PG8_STAGE(PG8_SB(1, 0), cB + kstep, voffB); PG8_STAGE(PG8_SA(1, 0), cA + kstep, voffA); PG8_STAGE(PG8_SB(1, 1), cB + hstep + kstep, voffB);
        PG8_WAIT_V(6); PG8_BAR;
    }
    for (;;) {
        const bool has_next = S.next(ui + 1, nxt);
        const char* nA = has_next ? (const char*)g.A + (size_t)nxt.pm * tstep : cA; const char* nB = has_next ? (const char*)g.Bt + (size_t)nxt.pn * tstep : cB;
        for (int t = 0; t < nt; t += 2) {
            const bool last = (t == nt - 2);
            const char* a1 = cA + (size_t)(t + 1) * kstep;
            const char* a2 = last ? nA : cA + (size_t)(t + 2) * kstep; const char* b2 = last ? nB : cB + (size_t)(t + 2) * kstep;
            const char* a3 = a2 + kstep; const char* b3 = b2 + kstep;
            if (last && has_next) S.a_ready(nxt);
            if constexpr (SP2) {
            PG8_LDB(B0, 0, 0); PG8_LDB(B1, 0, 1); PG8_SCHED; PG8_LDA(At, 0, 0); PG8_STAGE(PG8_SA(1, 1), a1 + hstep, voffA);
            PG8_WAIT_V(8); PG8_WAIT_L(0); PG8_BAR; PG8_MMA(0, 0, At, B0); PG8_MMA(0, 1, At, B1); PG8_BAR; PG8_SCHED;
            PG8_LDA(At, 0, 1); PG8_STAGE(PG8_SB(0, 0), b2, voffB); PG8_STAGE(PG8_SB(0, 1), b2 + hstep, voffB); PG8_STAGE(PG8_SA(0, 0), a2, voffA);
            PG8_WAIT_V(8); PG8_WAIT_L(0); PG8_BAR; PG8_MMA(1, 0, At, B0); PG8_MMA(1, 1, At, B1); PG8_BAR; PG8_SCHED;
            PG8_LDB(B0, 1, 0); PG8_LDB(B1, 1, 1); PG8_SCHED; PG8_LDA(At, 1, 0); PG8_STAGE(PG8_SA(0, 1), a2 + hstep, voffA);
            PG8_WAIT_V(8); PG8_WAIT_L(0); PG8_BAR; PG8_MMA(0, 0, At, B0); PG8_MMA(0, 1, At, B1); PG8_BAR; PG8_SCHED;
            PG8_LDA(At, 1, 1); PG8_STAGE(PG8_SB(1, 0), b3, voffB); PG8_STAGE(PG8_SB(1, 1), b3 + hstep, voffB); PG8_STAGE(PG8_SA(1, 0), a3, voffA);
            PG8_WAIT_V(8); PG8_WAIT_L(0); PG8_BAR; PG8_MMA(1, 0, At, B0); PG8_MMA(1, 1, At, B1); PG8_BAR; PG8_SCHED;
            } else {
            PG8_LDB(B0, 0, 0); PG8_SCHED; PG8_LDA(At, 0, 0); PG8_STAGE(PG8_SA(1, 1), a1 + hstep, voffA);
            PG8_WAIT_L(8); PG8_BAR; PG8_WAIT_L(0); PG8_MMA(0, 0, At, B0); PG8_BAR; PG8_SCHED;
            PG8_LDB(B1, 0, 1); PG8_STAGE(PG8_SB(0, 0), b2, voffB);
            PG8_BAR; PG8_WAIT_L(0); PG8_MMA(0, 1, At, B1); PG8_BAR;
            PG8_LDA(At, 0, 1); PG8_STAGE(PG8_SA(0, 0), a2, voffA);
            PG8_BAR; PG8_WAIT_L(0); PG8_MMA(1, 0, At, B0); PG8_BAR; PG8_SCHED;
            PG8_STAGE(PG8_SB(0, 1), b2 + hstep, voffB);
            PG8_WAIT_V(6); PG8_BAR; PG8_MMA(1, 1, At, B1); PG8_BAR;
            PG8_LDB(B0, 1, 0); PG8_SCHED; PG8_LDA(At, 1, 0); PG8_STAGE(PG8_SA(0, 1), a2 + hstep, voffA);
            PG8_WAIT_L(8); PG8_BAR; PG8_WAIT_L(0); PG8_MMA(0, 0, At, B0); PG8_BAR; PG8_SCHED;
            PG8_LDB(B1, 1, 1); PG8_STAGE(PG8_SB(1, 0), b3, voffB);
            PG8_BAR; PG8_WAIT_L(0); PG8_MMA(0, 1, At, B1); PG8_BAR;
            PG8_LDA(At, 1, 1); PG8_STAGE(PG8_SA(1, 0), a3, voffA);
            PG8_BAR; PG8_WAIT_L(0); PG8_MMA(1, 0, At, B0); PG8_BAR; PG8_SCHED;
            PG8_STAGE(PG8_SB(1, 1), b3 + hstep, voffB);
            PG8_WAIT_V(6); PG8_BAR; PG8_MMA(1, 1, At, B1); PG8_BAR;
            }
        }
        if constexpr (ALIGN_EPI) { if (wr == 0) PG8_BAR; }
        if constexpr (!Epi::AFTER_DRAIN) { E(acc, cur, wr, wc, fr, fq); S.done(cur); }
        if (!has_next) break;
#pragma unroll
        for (int a = 0; a < 2; ++a)
#pragma unroll
            for (int b = 0; b < 2; ++b)
#pragma unroll
                for (int m = 0; m < 4; ++m)
#pragma unroll
                    for (int n = 0; n < 2; ++n) acc[a][b][m][n] = (f32x4){0.f, 0.f, 0.f, 0.f};
        cur = nxt; cA = nA; cB = nB; ++ui;
        if constexpr (ALIGN_EPI) { if (wr == 1) PG8_BAR; }
    }
    PG8_WAIT_V(0);
    if constexpr (!ALIGN_EPI) { if (wr == 0) PG8_BAR; }
    PG8_BAR;
    if constexpr (Epi::AFTER_DRAIN) { E.fused(acc, cur, wr, wc, fr, fq, lds, wid, lane); S.done(cur); }
#undef PG8_SA
#undef PG8_SB
#undef PG8_STAGE
#undef PG8_LDA
#undef PG8_LDB
#undef PG8_MMA
#undef PG8_WAIT_V
#undef PG8_WAIT_L
#undef PG8_BAR
#undef PG8_SCHED
}
}

#define LAS __attribute__((address_space(3)))
typedef unsigned short bf16;
typedef float f32x4 __attribute__((ext_vector_type(4)));
typedef float f32x2 __attribute__((ext_vector_type(2)));
typedef float f32x16 __attribute__((ext_vector_type(16)));
typedef short bf16x8 __attribute__((ext_vector_type(8)));
typedef unsigned u32x4 __attribute__((ext_vector_type(4)));
typedef unsigned u32x2 __attribute__((ext_vector_type(2)));

constexpr int DM = 1024, TP = 4096, TS = 16384, T = TP + TS, SEQS = 2048, NBS = 8, PAST = 256;
constexpr int KSEQ = PAST + SEQS;
constexpr int TK = TP + NBS * KSEQ;
constexpr int FFN = 2816, CIN = 2560, AIN = 1440, AINP = 1536, QL = 384, KVL = 256, MQD = 768;
constexpr float EPS = 1e-6f;
constexpr int NWAVES = 8, NTHR = 512;
constexpr int LDS_BYTES = 147456;

constexpr size_t MiB = (size_t)1 << 20;
constexpr size_t al256(size_t x) { return (x + 255) & ~(size_t)255; }
constexpr size_t WS_CTL = 0;
constexpr size_t WS_MOD = 1 * MiB;
constexpr size_t WS_TABG = WS_MOD + al256((size_t)2 * 9 * 6144 * 4);
constexpr size_t WS_TABM = WS_TABG + al256(64 * 16 * 8);
constexpr size_t WS_BCIN = WS_TABM + al256(64 * 8 * 8);
constexpr size_t WS_WCIN = 2 * MiB;
constexpr size_t WS_WCOUT = WS_WCIN + (size_t)2560 * 1024 * 2;
constexpr size_t WS_WGU0 = WS_WCOUT + (size_t)1024 * 1024 * 2;
constexpr size_t WS_WD0 = WS_WGU0 + (size_t)5632 * 1024 * 2;
constexpr size_t WS_WGU1 = WS_WD0 + (size_t)1024 * 2816 * 2;
constexpr size_t WS_WD1 = WS_WGU1 + (size_t)5632 * 1024 * 2;
constexpr size_t WS_WAIN = WS_WD1 + (size_t)1024 * 2816 * 2;
constexpr size_t WS_WQB = WS_WAIN + (size_t)1536 * 1024 * 2;
constexpr size_t WS_WKN = WS_WQB + (size_t)768 * 384 * 2;
constexpr size_t WS_WVT = WS_WKN + (size_t)512 * 256 * 2;
constexpr size_t WS_WAOUT = WS_WVT + (size_t)512 * 256 * 2;
constexpr size_t WS_WEND = WS_WAOUT + (size_t)1024 * 1024 * 2;
constexpr size_t WS_A = 50 * MiB;
constexpr size_t WS_B = 90 * MiB;
constexpr size_t WS_C = 130 * MiB;
constexpr size_t WS_END = 240 * MiB;
static_assert(WS_BCIN + 2560 * 4 <= WS_WCIN && WS_WEND <= WS_A, "ws map");
constexpr size_t A_QA = 0;
constexpr size_t A_CKV = A_QA + (size_t)T * QL * 2;
constexpr size_t A_KR = A_CKV + (size_t)TK * KVL * 2;
constexpr size_t A_KC = A_KR + (size_t)TK * 32 * 2;
constexpr size_t A_VTC = A_KC + (size_t)TK * 128 * 2;
static_assert(A_VTC + (size_t)128 * TK * 2 <= 40 * MiB, "region A");
constexpr size_t C_U1 = 0;
constexpr size_t C_QC = (size_t)T * AINP * 2;
constexpr size_t C_VTM = C_QC + (size_t)T * 512 * 2;
constexpr size_t C_MQ = 0;
constexpr size_t C_KN = (size_t)T * MQD * 2;
static_assert(C_KN + (size_t)TK * 512 * 2 <= C_QC && C_VTM + (size_t)512 * TK * 2 <= 110 * MiB, "region C");
constexpr size_t OUT_Y = 0, OUT_K = (size_t)T * DM, OUT_V = OUT_K + (size_t)TP * 128, OUT_CKV = OUT_V + (size_t)TP * 128, OUT_KR = OUT_CKV + (size_t)TP * 256;

__device__ __forceinline__ unsigned pk2(float lo, float hi) { return pg8::cvt_pk_bf16(lo, hi); }
__device__ __forceinline__ bf16 f2bf(float x) { return (bf16)(pk2(x, 0.f) & 0xffffu); }
__device__ __forceinline__ float bf2f(bf16 b) { return __uint_as_float((unsigned)b << 16); }
__device__ __forceinline__ float bflo(unsigned w) { return __uint_as_float(w << 16); }
__device__ __forceinline__ float bfhi(unsigned w) { return __uint_as_float(w & 0xffff0000u); }
__device__ __forceinline__ float wave_sum(float v) {
#pragma unroll
    for (int o = 1; o < 64; o <<= 1) v += __shfl_xor(v, o);
    return v;
}
__device__ __forceinline__ float fsigmoid(float x) { return __builtin_amdgcn_rcpf(1.f + __builtin_amdgcn_exp2f(-1.4426950408889634f * x)); }
__device__ __forceinline__ float fsilu(float x) { return x * fsigmoid(x); }
__device__ __forceinline__ const float* xrow_in(const float* xp, const float* xs, int r) { return r < TP ? xp + (size_t)r * DM : xs + (size_t)(r - TP) * DM; }
__device__ __forceinline__ int cond_of(int r) { return r < TP ? 0 : 1 + ((r - TP) >> 11); }
__device__ __forceinline__ void unpack8(u32x4 w, float (&v)[8]) {
    v[0] = bflo(w.x); v[1] = bfhi(w.x); v[2] = bflo(w.y); v[3] = bfhi(w.y); v[4] = bflo(w.z); v[5] = bfhi(w.z); v[6] = bflo(w.w); v[7] = bfhi(w.w);
}
__device__ __forceinline__ u32x4 pack8(const float (&v)[8]) { u32x4 w; w.x = pk2(v[0], v[1]); w.y = pk2(v[2], v[3]); w.z = pk2(v[4], v[5]); w.w = pk2(v[6], v[7]); return w; }

struct EpiStore {
    static constexpr bool PERM = true, AFTER_DRAIN = false;
    bf16* O; int ldc; const float* bias;
    __device__ __forceinline__ void operator()(const f32x4 (&acc)[2][2][4][2], const pg8::Unit& u, int wr, int wc, int fr, int fq) const {
        const int row0 = u.pm * 256 + wr * 64 + fr, col0 = u.pn * 256 + wc * 32 + 8 * fq;
        f32x4 bv[2][2];
#pragma unroll
        for (int bj = 0; bj < 2; ++bj)
#pragma unroll
            for (int n = 0; n < 2; ++n) bv[bj][n] = bias ? *(const f32x4*)(bias + col0 + bj * 128 + 4 * n) : (f32x4){0.f, 0.f, 0.f, 0.f};
#pragma unroll
        for (int ai = 0; ai < 2; ++ai)
#pragma unroll
            for (int m = 0; m < 4; ++m) { bf16* rowp = O + (size_t)(row0 + ai * 128 + m * 16) * ldc + col0;
#pragma unroll
                for (int bj = 0; bj < 2; ++bj) { const f32x4 v0 = acc[ai][bj][m][0] + bv[bj][0], v1 = acc[ai][bj][m][1] + bv[bj][1];
                    u32x4 w; w.x = pk2(v0[0], v0[1]); w.y = pk2(v0[2], v0[3]); w.z = pk2(v1[0], v1[1]); w.w = pk2(v1[2], v1[3]);
                    *(u32x4*)(rowp + bj * 128) = w; } }
    }
};
struct EpiSwiGLU {
    static constexpr bool PERM = true, AFTER_DRAIN = false;
    bf16* O;
    __device__ __forceinline__ void operator()(const f32x4 (&acc)[2][2][4][2], const pg8::Unit& u, int wr, int wc, int fr, int fq) const {
        const int row0 = u.pm * 256 + wr * 64 + fr, col0 = u.pn * 128 + wc * 32 + 8 * fq;
#pragma unroll
        for (int ai = 0; ai < 2; ++ai)
#pragma unroll
            for (int m = 0; m < 4; ++m) { bf16* rowp = O + (size_t)(row0 + ai * 128 + m * 16) * FFN + col0;
                const f32x4 g0 = acc[ai][0][m][0], g1 = acc[ai][0][m][1], u0 = acc[ai][1][m][0], u1 = acc[ai][1][m][1];
                u32x4 w; w.x = pk2(fsilu(g0[0]) * u0[0], fsilu(g0[1]) * u0[1]); w.y = pk2(fsilu(g0[2]) * u0[2], fsilu(g0[3]) * u0[3]);
                w.z = pk2(fsilu(g1[0]) * u1[0], fsilu(g1[1]) * u1[1]); w.w = pk2(fsilu(g1[2]) * u1[2], fsilu(g1[3]) * u1[3]);
                *(u32x4*)rowp = w; }
    }
};
__device__ __forceinline__ void tr_item(const float* src, int ldw, bf16* WT, int K, int k0, int drow0, LAS float* scr, int lane) {
#pragma unroll 8
    for (int i = 0; i < 32; ++i) { const int kk = 2 * i + (lane >> 5); scr[kk * 33 + (lane & 31)] = src ? src[(size_t)(k0 + kk) * ldw] : 0.f; }
    asm volatile("s_waitcnt lgkmcnt(0)" ::: "memory");
    const int c = lane & 7;
#pragma unroll
    for (int j = 0; j < 4; ++j) { const int n = (lane >> 3) + 8 * j; const LAS float* s = scr + (8 * c) * 33 + n;
        u32x4 o; o.x = pk2(s[0 * 33], s[1 * 33]); o.y = pk2(s[2 * 33], s[3 * 33]); o.z = pk2(s[4 * 33], s[5 * 33]); o.w = pk2(s[6 * 33], s[7 * 33]);
        *(u32x4*)(WT + (size_t)(drow0 + n) * K + k0 + 8 * c) = o; }
    asm volatile("s_waitcnt lgkmcnt(0)" ::: "memory");
}

__device__ __forceinline__ void p0_weights(const float* const* in, unsigned char* ws, LAS float* scr, int gw, int ngw, int lane) {
    constexpr int I_CIN = 16 * 80, I_COUT = 16 * 32, I_GU = 16 * 176, I_D = 44 * 32, I_AIN = 16 * 48, I_QB = 6 * 24, I_KN = 4 * 16, I_AOUT = 16 * 32;
    constexpr int NITEMS = I_CIN + I_COUT + 2 * I_GU + 2 * I_D + I_AIN + I_QB + 2 * I_KN + I_AOUT;
    const int ln = lane & 31;
    for (int it = gw; it < NITEMS; it += ngw) {
        int r = it;
        if (r < I_CIN) { const int nblk = 80, kb = r / nblk, nb = r % nblk, n = 32 * nb + ln;
            tr_item(in[12] + n, CIN, (bf16*)(ws + WS_WCIN), 1024, 64 * kb, 32 * nb, scr, lane); continue; } r -= I_CIN;
        if (r < I_COUT) { const int nblk = 32, kb = r / nblk, nb = r % nblk, n = 32 * nb + ln;
            tr_item(in[19] + n, 1024, (bf16*)(ws + WS_WCOUT), 1024, 64 * kb, 32 * nb, scr, lane); continue; } r -= I_COUT;
        if (r < 2 * (I_GU + I_D)) { const int l = r >= (I_GU + I_D) ? 1 : 0; r -= l * (I_GU + I_D);
            if (r < I_GU) { const int nblk = 176, kb = r / nblk, nb = r % nblk, n = 32 * nb + ln, t = n >> 8, w = n & 255;
                const float* src = (w < 128 ? in[29] : in[30]) + (size_t)l * 1024 * FFN + 128 * t + (w & 127);
                tr_item(src, FFN, (bf16*)(ws + (l ? WS_WGU1 : WS_WGU0)), 1024, 64 * kb, 32 * nb, scr, lane); }
            else { r -= I_GU; const int nblk = 32, kb = r / nblk, nb = r % nblk, n = 32 * nb + ln;
                tr_item(in[31] + (size_t)l * FFN * 1024 + n, 1024, (bf16*)(ws + (l ? WS_WD1 : WS_WD0)), FFN, 64 * kb, 32 * nb, scr, lane); }
            continue; } r -= 2 * (I_GU + I_D);
        if (r < I_AIN) { const int nblk = 48, kb = r / nblk, nb = r % nblk, n = 32 * nb + ln;
            tr_item(n < AIN ? in[21] + n : nullptr, AIN, (bf16*)(ws + WS_WAIN), 1024, 64 * kb, 32 * nb, scr, lane); continue; } r -= I_AIN;
        if (r < I_QB) { const int nblk = 24, kb = r / nblk, nb = r % nblk, n = 32 * nb + ln, hh = n / 96, w = n % 96;
            int sc = n; if (w >= 64) { const int e = w - 64, blk = e >> 4, loc = e & 15; sc = hh * 96 + 64 + 16 * blk + 8 * (loc & 1) + (loc >> 1); }
            tr_item(in[25] + sc, MQD, (bf16*)(ws + WS_WQB), QL, 64 * kb, 32 * nb, scr, lane); continue; } r -= I_QB;
        if (r < I_KN) { const int nblk = 16, kb = r / nblk, nb = r % nblk, n = 32 * nb + ln;
            tr_item(in[27] + (n >> 6) * 128 + (n & 63), 1024, (bf16*)(ws + WS_WKN), KVL, 64 * kb, 32 * nb, scr, lane); continue; } r -= I_KN;
        if (r < I_KN) { const int nblk = 16, kb = r / nblk, nb = r % nblk, n = 32 * nb + ln;
            tr_item(in[27] + (n >> 6) * 128 + 64 + (n & 63), 1024, (bf16*)(ws + WS_WVT), KVL, 64 * kb, 32 * nb, scr, lane); continue; } r -= I_KN;
        { const int nblk = 32, kb = r / nblk, nb = r % nblk, n = 32 * nb + ln;
            tr_item(in[28] + n, 1024, (bf16*)(ws + WS_WAOUT), 1024, 64 * kb, 32 * nb, scr, lane); }
    }
}

__device__ __forceinline__ void p0_adaln(const float* const* in, unsigned char* ws, LAS unsigned char* lds, int tid, int wave, int lane, int G) {
    if ((int)blockIdx.x >= 192) return;
    LAS float* sS = (LAS float*)lds;
    LAS float* red = (LAS float*)(lds + 9 * 1024 * 4);
    float* MOD = (float*)(ws + WS_MOD);
    for (int i = tid; i < 9 * 1024; i += NTHR) { const int cnd = i >> 10, k = i & 1023; const float x = cnd == 0 ? in[7][k] : in[6][(cnd - 1) * 1024 + k]; sS[i] = fsilu(x); }
    __syncthreads();
    for (int it = blockIdx.x; it < 192; it += G) {
        const int l = it / 96, n0 = 64 * (it % 96);
        const float* wp = in[8] + (size_t)l * 1024 * 6144 + n0 + lane;
        float acc[9];
#pragma unroll
        for (int c = 0; c < 9; ++c) acc[c] = 0.f;
        const int kb = 128 * wave;
#pragma unroll 4
        for (int k = kb; k < kb + 128; k += 4) {
            const float w0 = wp[(size_t)(k + 0) * 6144], w1 = wp[(size_t)(k + 1) * 6144], w2 = wp[(size_t)(k + 2) * 6144], w3 = wp[(size_t)(k + 3) * 6144];
#pragma unroll
            for (int c = 0; c < 9; ++c) { const f32x4 s = *(const LAS f32x4*)(sS + c * 1024 + k); acc[c] += s.x * w0 + s.y * w1 + s.z * w2 + s.w * w3; }
        }
#pragma unroll
        for (int c = 0; c < 9; ++c) red[(wave * 9 + c) * 64 + lane] = acc[c];
        __syncthreads();
        for (int idx = tid; idx < 576; idx += NTHR) { const int c = idx >> 6, ln = idx & 63; float s = in[9][l * 6144 + n0 + ln];
#pragma unroll
            for (int w = 0; w < 8; ++w) s += red[(w * 9 + c) * 64 + ln];
            MOD[(size_t)(l * 9 + c) * 6144 + n0 + ln] = s; }
        __syncthreads();
    }
}
__device__ __forceinline__ void p0_tables(const float* const* in, unsigned char* ws, int tid) {
    f32x2* tabg = (f32x2*)(ws + WS_TABG); f32x2* tabm = (f32x2*)(ws + WS_TABM); float* bcin = (float*)(ws + WS_BCIN);
    for (int i = tid; i < 64 * 16; i += NTHR) { const int pos = i >> 4, f = i & 15; const float inv = exp2f(-(float)f * (13.287712379549449f / 16.f)), a = (float)pos * inv; tabg[i] = (f32x2){__cosf(a), __sinf(a)}; }
    for (int i = tid; i < 64 * 8; i += NTHR) { const int pos = i >> 3, f = i & 7; const float inv = exp2f(-(float)f * (13.287712379549449f / 8.f)), a = (float)pos * inv; tabm[i] = (f32x2){__cosf(a), __sinf(a)}; }
    for (int i = tid; i < CIN; i += NTHR) bcin[i] = i < 1536 ? 0.f : in[14][i - 1536];
}

__device__ __forceinline__ void phase_norm_in(const float* xp, const float* xs, const float* gpre, const float* modl, int sidx, bf16* H, int gw, int ngw, int lane) {
    for (int r = gw; r < T; r += ngw) {
        const f32x4* x4 = (const f32x4*)xrow_in(xp, xs, r) + lane;
        f32x4 v[4]; float ss = 0.f;
#pragma unroll
        for (int j = 0; j < 4; ++j) { v[j] = x4[64 * j]; ss += (v[j].x * v[j].x + v[j].y * v[j].y) + (v[j].z * v[j].z + v[j].w * v[j].w); }
        const float rstd = rsqrtf(wave_sum(ss) * (1.f / DM) + EPS);
        const float* mb = modl + (size_t)cond_of(r) * 6144;
        const f32x4* g4 = (const f32x4*)gpre + lane; const f32x4* sh4 = (const f32x4*)(mb + sidx * DM) + lane; const f32x4* sc4 = (const f32x4*)(mb + (sidx + 1) * DM) + lane;
        u32x2* h2 = (u32x2*)(H + (size_t)r * DM) + lane;
#pragma unroll
        for (int j = 0; j < 4; ++j) { const f32x4 g = g4[64 * j], sh = sh4[64 * j], sc = sc4[64 * j]; const f32x4 o = v[j] * rstd * g * (1.f + sc) + sh;
            h2[64 * j] = (u32x2){pk2(o.x, o.y), pk2(o.z, o.w)}; }
    }
}
template <bool NEXT>
__device__ __forceinline__ void phase_post(const bf16* O, const float* xp, const float* xs, float* Y, const float* gpost, const float* modl, int gidx,
                                           const float* gpre_n, const float* modn, int sidx_n, bf16* H, int gw, int ngw, int lane) {
    for (int r = gw; r < T; r += ngw) {
        const u32x2* o2 = (const u32x2*)(O + (size_t)r * DM) + lane; const f32x4* x4 = (const f32x4*)xrow_in(xp, xs, r) + lane;
        f32x4 o[4], x[4]; float ss = 0.f;
#pragma unroll
        for (int j = 0; j < 4; ++j) { const u32x2 w = o2[64 * j]; o[j] = (f32x4){bflo(w.x), bfhi(w.x), bflo(w.y), bfhi(w.y)}; x[j] = x4[64 * j];
            ss += (o[j].x * o[j].x + o[j].y * o[j].y) + (o[j].z * o[j].z + o[j].w * o[j].w); }
        const float ro = rsqrtf(wave_sum(ss) * (1.f / DM) + EPS);
        const int cnd = cond_of(r);
        const f32x4* gp4 = (const f32x4*)gpost + lane; const f32x4* gt4 = (const f32x4*)(modl + (size_t)cnd * 6144 + gidx * DM) + lane;
        f32x4* y4 = (f32x4*)(Y + (size_t)r * DM) + lane; float s2 = 0.f;
#pragma unroll
        for (int j = 0; j < 4; ++j) { const f32x4 gp = gp4[64 * j], gt = gt4[64 * j]; x[j] = x[j] + gt * (o[j] * ro * gp); y4[64 * j] = x[j];
            s2 += (x[j].x * x[j].x + x[j].y * x[j].y) + (x[j].z * x[j].z + x[j].w * x[j].w); }
        if (NEXT) {
            const float rx = rsqrtf(wave_sum(s2) * (1.f / DM) + EPS);
            const float* mb = modn + (size_t)cnd * 6144;
            const f32x4* g4 = (const f32x4*)gpre_n + lane; const f32x4* sh4 = (const f32x4*)(mb + sidx_n * DM) + lane; const f32x4* sc4 = (const f32x4*)(mb + (sidx_n + 1) * DM) + lane;
            u32x2* h2 = (u32x2*)(H + (size_t)r * DM) + lane;
#pragma unroll
            for (int j = 0; j < 4; ++j) { const f32x4 g = g4[64 * j], sh = sh4[64 * j], sc = sc4[64 * j]; const f32x4 h = x[j] * rx * g * (1.f + sc) + sh;
                h2[64 * j] = (u32x2){pk2(h.x, h.y), pk2(h.z, h.w)}; }
        }
    }
}

__device__ __forceinline__ void phase_conv(const bf16* U, bf16* MIX, const float* sc_w, const float* dw_w, const float* dw_b, const float* ln_g, const float* ln_b,
                                           LAS unsigned char* lds, int tid, int wave, int lane, int G) {
    LAS bf16* zsb = (LAS bf16*)lds;
    LAS bf16* pbuf = (LAS bf16*)(lds + 62 * 1024);
    LAS bf16* zbuf = (LAS bf16*)(lds + 96 * 1024);
    LAS float* part = (LAS float*)(lds + 129 * 1024);
    LAS float* stat = part + 512;
    const int c = tid, srow = tid >> 6, ch8 = tid & 63;
    float w[31];
#pragma unroll
    for (int j = 0; j < 31; ++j) w[j] = dw_w[j * 512 + c];
    const float bdw = dw_b[c], lg = ln_g[c], lb = ln_b[c];
    float scw[3][8];
#pragma unroll
    for (int j = 0; j < 3; ++j)
#pragma unroll
        for (int k = 0; k < 8; ++k) scw[j][k] = sc_w[j * 512 + 8 * ch8 + k];
    for (int ch = blockIdx.x; ch < T / 32; ch += G) {
        const int r0 = 32 * ch;
        const int sq0 = r0 < TP ? (r0 & ~255) : TP + ((r0 - TP) & ~2047), sq1 = sq0 + (r0 < TP ? 256 : 2048);
        u32x4 bv[8], bg[8], ac[5], ax[5];
        {   const bf16* ub = U + (size_t)(r0 - 15 + srow) * CIN + 8 * ch8;
#pragma unroll
            for (int p = 0; p < 8; ++p) { const int row = srow + 8 * p; const bf16* up = ub + (size_t)(row < 62 ? 8 * p : 0) * CIN; bv[p] = *(const u32x4*)(up + 1536); bg[p] = *(const u32x4*)(up + 2048); }
            const bf16* ua = U + (size_t)(r0 - 1 + srow) * CIN + 8 * ch8;
#pragma unroll
            for (int p = 0; p < 5; ++p) { const int row = srow + 8 * p; const bf16* up = ua + (size_t)(row < 34 ? 8 * p : 0) * CIN; ac[p] = *(const u32x4*)(up + 512); ax[p] = *(const u32x4*)(up + 1024); } }
#pragma unroll
        for (int p = 0; p < 8; ++p) { const int row = srow + 8 * p, rr = r0 - 15 + row; const bool ok = rr >= sq0 && rr < sq1;
            float a[8], g[8]; unpack8(bv[p], a); unpack8(bg[p], g);
#pragma unroll
            for (int k = 0; k < 8; ++k) a[k] = ok ? a[k] * fsigmoid(g[k]) : 0.f;
            if (row < 62) *(LAS u32x4*)(zsb + row * 512 + 8 * ch8) = pack8(a); }
#pragma unroll
        for (int p = 0; p < 5; ++p) { const int row = srow + 8 * p, rr = r0 - 1 + row; const bool ok = rr >= sq0 && rr < sq1;
            float a[8], g[8]; unpack8(ac[p], a); unpack8(ax[p], g);
#pragma unroll
            for (int k = 0; k < 8; ++k) a[k] = ok ? a[k] * g[k] : 0.f;
            if (row < 34) *(LAS u32x4*)(pbuf + row * 512 + 8 * ch8) = pack8(a); }
        __syncthreads();
        u32x4 gb[4];
        {   const bf16* ug = U + (size_t)(r0 + srow) * CIN + 8 * ch8;
#pragma unroll
            for (int p = 0; p < 4; ++p) gb[p] = *(const u32x4*)(ug + (size_t)(8 * p) * CIN); }
        float z1[32];
        {   float z0[62];
#pragma unroll
            for (int j = 0; j < 62; ++j) z0[j] = bf2f(zsb[j * 512 + c]);
#pragma unroll
            for (int t = 0; t < 32; ++t) z1[t] = bdw;
#pragma unroll
            for (int j = 0; j < 31; ++j)
#pragma unroll
                for (int t = 0; t < 32; ++t) z1[t] += w[j] * z0[t + j]; }
        {   float v1[32], v2[32];
#pragma unroll
            for (int t = 0; t < 32; ++t) { v1[t] = z1[t]; v2[t] = z1[t] * z1[t]; }
#pragma unroll
            for (int st = 0; st < 5; ++st) { const int B = 32 >> st, n = 16 >> st; const bool hi = (lane & B) != 0;
#pragma unroll
                for (int i = 0; i < 16; ++i) if (i < n) {
                    const float s1 = hi ? v1[i] : v1[i + n], k1 = hi ? v1[i + n] : v1[i]; v1[i] = k1 + __shfl_xor(s1, B);
                    const float s2 = hi ? v2[i] : v2[i + n], k2 = hi ? v2[i + n] : v2[i]; v2[i] = k2 + __shfl_xor(s2, B); } }
            v1[0] += __shfl_xor(v1[0], 1); v2[0] += __shfl_xor(v2[0], 1);
            if ((lane & 1) == 0) { part[wave * 32 + (lane >> 1)] = v1[0]; part[256 + wave * 32 + (lane >> 1)] = v2[0]; } }
        __syncthreads();
        if (tid < 32) { float a = 0.f, b = 0.f;
#pragma unroll
            for (int q = 0; q < 8; ++q) { a += part[q * 32 + tid]; b += part[256 + q * 32 + tid]; }
            const float mean = a * (1.f / 512.f), var = fmaxf(b * (1.f / 512.f) - mean * mean, 0.f);
            stat[2 * tid] = mean; stat[2 * tid + 1] = rsqrtf(var + EPS); }
        __syncthreads();
#pragma unroll
        for (int t = 0; t < 32; ++t) { const f32x2 ms = *(const LAS f32x2*)(stat + 2 * t); const float y = (z1[t] - ms.x) * ms.y * lg + lb; zbuf[t * 512 + c] = f2bf(fsilu(y)); }
#pragma unroll
        for (int p = 0; p < 4; ++p) { const int t = srow + 8 * p;
            float g[8], p0[8], p1[8], p2[8]; unpack8(gb[p], g);
            unpack8(*(const LAS u32x4*)(pbuf + t * 512 + 8 * ch8), p0); unpack8(*(const LAS u32x4*)(pbuf + (t + 1) * 512 + 8 * ch8), p1); unpack8(*(const LAS u32x4*)(pbuf + (t + 2) * 512 + 8 * ch8), p2);
#pragma unroll
            for (int k = 0; k < 8; ++k) g[k] = g[k] * (scw[0][k] * p0[k] + scw[1][k] * p1[k] + scw[2][k] * p2[k]);
            *(u32x4*)(MIX + (size_t)(r0 + t) * DM + 8 * ch8) = pack8(g); }
        __syncthreads();
#pragma unroll
        for (int p = 0; p < 4; ++p) { const int t = srow + 8 * p; *(u32x4*)(MIX + (size_t)(r0 + t) * DM + 512 + 8 * ch8) = *(const LAS u32x4*)(zbuf + t * 512 + 8 * ch8); }
    }
}

__device__ __forceinline__ void rope_head64(float (&v)[8], int lane, int prow, int pcol, const f32x2* tabg) {
    const int pos = (lane & 4) ? pcol : prow, i0 = 8 * (lane & 1); const bool second = (lane & 2) != 0;
#pragma unroll
    for (int j = 0; j < 8; ++j) { const float pv = __shfl_xor(v[j], 2); const f32x2 cs = tabg[pos * 16 + i0 + j];
        v[j] = second ? v[j] * cs.x + pv * cs.y : v[j] * cs.x - pv * cs.y; }
}
__device__ __forceinline__ void phase_attn_rows(const bf16* U1, const float* qn, const float* kn, const float* qan, const float* kvan, const f32x2* tabg, const f32x2* tabm,
                                                bf16* QC, bf16* KC, bf16* VtC, bf16* QA, bf16* CKV, bf16* KR, float* o_k, float* o_v, float* o_ckv, float* o_kr,
                                                const float* c_k, const float* c_v, const float* c_ckv, const float* c_kr, int gw, int ngw, int lane) {
    for (int r = gw; r < T; r += ngw) {
        const bool smp = r >= TP; const int ts = (r - TP) & 2047, prow = ts >> 6, pcol = ts & 63;
        const int krow = smp ? TP + ((r - TP) >> 11) * KSEQ + PAST + ts : r;
        const bf16* u = U1 + (size_t)r * AINP;
        {
            float v[8]; unpack8(*(const u32x4*)(u + 8 * lane), v);
            float ss = 0.f;
#pragma unroll
            for (int j = 0; j < 8; ++j) ss += v[j] * v[j];
            ss += __shfl_xor(ss, 1); ss += __shfl_xor(ss, 2); ss += __shfl_xor(ss, 4);
            const float rstd = rsqrtf(ss * (1.f / 64.f) + EPS); const int d0 = 8 * (lane & 7);
#pragma unroll
            for (int j = 0; j < 8; ++j) v[j] = v[j] * rstd * qn[d0 + j];
            float vr[8];
#pragma unroll
            for (int j = 0; j < 8; ++j) vr[j] = v[j];
            rope_head64(vr, lane, prow, pcol, tabg);
#pragma unroll
            for (int j = 0; j < 8; ++j) v[j] = smp ? vr[j] : v[j];
            *(u32x4*)(QC + (size_t)r * 512 + 8 * lane) = pack8(v);
        }
        {
            const int l2 = lane & 31; float v[8], raw[8]; unpack8(*(const u32x4*)(u + 512 + 8 * l2), v);
            float ss = 0.f;
#pragma unroll
            for (int j = 0; j < 8; ++j) { raw[j] = v[j]; ss += v[j] * v[j]; }
            ss += __shfl_xor(ss, 1); ss += __shfl_xor(ss, 2); ss += __shfl_xor(ss, 4);
            const float rstd = rsqrtf(ss * (1.f / 64.f) + EPS); const int d0 = 8 * (lane & 7);
#pragma unroll
            for (int j = 0; j < 8; ++j) v[j] = v[j] * rstd * kn[d0 + j];
            if (lane < 16 && !smp) { float* ok = o_k + (size_t)r * 128 + 8 * lane; *(f32x4*)ok = (f32x4){v[0], v[1], v[2], v[3]}; *(f32x4*)(ok + 4) = (f32x4){v[4], v[5], v[6], v[7]}; }
            float vr[8];
#pragma unroll
            for (int j = 0; j < 8; ++j) vr[j] = v[j];
            rope_head64(vr, lane, prow, pcol, tabg);
#pragma unroll
            for (int j = 0; j < 8; ++j) v[j] = smp ? vr[j] : v[j];
            if (lane < 16) *(u32x4*)(KC + (size_t)krow * 128 + 8 * lane) = pack8(v);
            else if (lane < 32) { const int cv = 8 * (lane - 16);
#pragma unroll
                for (int j = 0; j < 8; ++j) VtC[(size_t)(cv + j) * TK + krow] = f2bf(raw[j]);
                if (!smp) { float* ov = o_v + (size_t)r * 128 + cv; *(f32x4*)ov = (f32x4){raw[0], raw[1], raw[2], raw[3]}; *(f32x4*)(ov + 4) = (f32x4){raw[4], raw[5], raw[6], raw[7]}; } }
        }
        {
            const int l3 = lane < 48 ? lane : 0; float v[8]; unpack8(*(const u32x4*)(u + 768 + 8 * l3), v);
            float ss = 0.f;
#pragma unroll
            for (int j = 0; j < 8; ++j) ss += v[j] * v[j];
            ss = wave_sum(lane < 48 ? ss : 0.f);
            const float rstd = rsqrtf(ss * (1.f / 384.f) + EPS);
#pragma unroll
            for (int j = 0; j < 8; ++j) v[j] = v[j] * rstd * qan[8 * l3 + j];
            if (lane < 48) *(u32x4*)(QA + (size_t)r * QL + 8 * lane) = pack8(v);
        }
        {
            const int l2 = lane & 31; float v[8]; unpack8(*(const u32x4*)(u + 1152 + 8 * l2), v);
            float ss = 0.f;
#pragma unroll
            for (int j = 0; j < 8; ++j) ss += v[j] * v[j];
            ss = wave_sum(lane < 32 ? ss : 0.f);
            const float rstd = rsqrtf(ss * (1.f / 256.f) + EPS);
#pragma unroll
            for (int j = 0; j < 8; ++j) v[j] = v[j] * rstd * kvan[8 * l2 + j];
            if (lane < 32) { *(u32x4*)(CKV + (size_t)krow * KVL + 8 * lane) = pack8(v);
                if (!smp) { float* oc = o_ckv + (size_t)r * 256 + 8 * lane; *(f32x4*)oc = (f32x4){v[0], v[1], v[2], v[3]}; *(f32x4*)(oc + 4) = (f32x4){v[4], v[5], v[6], v[7]}; } }
        }
        {
            const int l4 = lane & 3; float v[8]; unpack8(*(const u32x4*)(u + 1408 + 8 * l4), v);
            const int blk = l4 >> 1, pos = blk ? pcol : prow; const bool second = (l4 & 1) != 0;
            if (lane < 4 && !smp) { float* okr = o_kr + (size_t)r * 32 + 8 * lane; *(f32x4*)okr = (f32x4){v[0], v[1], v[2], v[3]}; *(f32x4*)(okr + 4) = (f32x4){v[4], v[5], v[6], v[7]}; }
#pragma unroll
            for (int j = 0; j < 8; ++j) { const float pv = __shfl_xor(v[j], 1); const f32x2 cs = tabm[pos * 8 + j];
                const float rv = second ? v[j] * cs.x + pv * cs.y : v[j] * cs.x - pv * cs.y; v[j] = smp ? rv : v[j]; }
            if (lane < 4) {
#pragma unroll
                for (int j = 0; j < 8; ++j) KR[(size_t)krow * 32 + 16 * blk + 2 * j + (second ? 1 : 0)] = f2bf(v[j]); }
        }
    }
    for (int cr = gw; cr < NBS * PAST; cr += ngw) {
        const int krow = TP + (cr >> 8) * KSEQ + (cr & 255);
        if (lane < 32) { const f32x4 k4 = *(const f32x4*)(c_k + (size_t)cr * 128 + 4 * lane); *(u32x2*)(KC + (size_t)krow * 128 + 4 * lane) = (u32x2){pk2(k4.x, k4.y), pk2(k4.z, k4.w)};
            const f32x4 v4 = *(const f32x4*)(c_v + (size_t)cr * 128 + 4 * lane);
            VtC[(size_t)(4 * lane + 0) * TK + krow] = f2bf(v4.x); VtC[(size_t)(4 * lane + 1) * TK + krow] = f2bf(v4.y);
            VtC[(size_t)(4 * lane + 2) * TK + krow] = f2bf(v4.z); VtC[(size_t)(4 * lane + 3) * TK + krow] = f2bf(v4.w);
            const int e = lane, blk = e >> 4, loc = e & 15; KR[(size_t)krow * 32 + 16 * blk + 2 * (loc & 7) + (loc >> 3)] = f2bf(c_kr[(size_t)cr * 32 + e]); }
        { const f32x4 c4 = *(const f32x4*)(c_ckv + (size_t)cr * 256 + 4 * lane); *(u32x2*)(CKV + (size_t)krow * KVL + 4 * lane) = (u32x2){pk2(c4.x, c4.y), pk2(c4.z, c4.w)}; }
    }
}

#define MFMA32(a, b, c) __builtin_amdgcn_mfma_f32_32x32x16_bf16((a), (b), (c), 0, 0, 0)
template <bool MLA>
__device__ __forceinline__ void attn_unit(LAS unsigned char* lds, const bf16* Q, int ldq, const bf16* K, int ldk, const bf16* KRp, const bf16* Vt, int nkeys, bf16* O, float c,
                                          const f32x2* tabm, int qpos0, int tid, int wave, int lane) {
    constexpr int NQ = MLA ? 6 : 4;
    constexpr int KB_SZ = 64 * 144, KR_OFF = 2 * KB_SZ, KR_SZ = 64 * 80, VT_OFF = KR_OFF + 2 * KR_SZ, VT_SZ = 64 * 136;
    const int r = lane & 31, h = lane >> 5;
    bf16x8 qf[NQ];
    { const bf16* qrow = Q + (size_t)(32 * wave + r) * ldq + 8 * h;
#pragma unroll
      for (int ks = 0; ks < NQ; ++ks) qf[ks] = *(const bf16x8*)(qrow + 16 * ks); }
    if (MLA && qpos0 >= 0) {
        const int ts = qpos0 + 32 * wave + r, prow = ts >> 6, pcol = ts & 63;
#pragma unroll
        for (int blk = 0; blk < 2; ++blk) { const u32x4 w = __builtin_bit_cast(u32x4, qf[NQ - 2 + blk]); float v[8]; unpack8(w, v); const int pos = blk ? pcol : prow;
#pragma unroll
            for (int jj = 0; jj < 4; ++jj) { const f32x2 cs = tabm[pos * 8 + 4 * h + jj]; const float x1 = v[2 * jj], x2 = v[2 * jj + 1]; v[2 * jj] = x1 * cs.x - x2 * cs.y; v[2 * jj + 1] = x2 * cs.x + x1 * cs.y; }
            qf[NQ - 2 + blk] = __builtin_bit_cast(bf16x8, pack8(v)); }
    }
    f32x16 o0, o1;
#pragma unroll
    for (int i = 0; i < 16; ++i) { o0[i] = 0.f; o1[i] = 0.f; }
    float m = -1e30f, l = 0.f;
    const int skey = tid >> 3, sch = tid & 7;
    const bf16* kg = K + (size_t)skey * ldk + 8 * sch;
    const bf16* vg = Vt + (size_t)skey * TK + 8 * sch;
    const bf16* rg = KRp + (size_t)(tid >> 2) * 32 + 8 * (tid & 3);
    const int kw = skey * 144 + sch * 16, vw = skey * 136 + sch * 16, rw = (tid >> 2) * 80 + (tid & 3) * 16;
    const int nt = nkeys >> 6;
    u32x4 kreg = *(const u32x4*)kg, vreg = *(const u32x4*)vg, rreg = (u32x4){0u, 0u, 0u, 0u};
    if (MLA && tid < 256) rreg = *(const u32x4*)rg;
    *(LAS u32x4*)(lds + kw) = kreg;
    *(LAS u32x2*)(lds + VT_OFF + vw) = (u32x2){vreg.x, vreg.y}; *(LAS u32x2*)(lds + VT_OFF + vw + 8) = (u32x2){vreg.z, vreg.w};
    if (MLA && tid < 256) *(LAS u32x4*)(lds + KR_OFF + rw) = rreg;
    __syncthreads();
    for (int j = 0; j < nt; ++j) {
        const int cur = j & 1; const bool more = j + 1 < nt;
        if (more) { kreg = *(const u32x4*)(kg + (size_t)(j + 1) * 64 * ldk); vreg = *(const u32x4*)(vg + (j + 1) * 64);
            if (MLA && tid < 256) rreg = *(const u32x4*)(rg + (size_t)(j + 1) * 64 * 32); }
        const LAS unsigned char* kb = lds + cur * KB_SZ; const LAS unsigned char* rb = lds + KR_OFF + cur * KR_SZ; const LAS unsigned char* vb = lds + VT_OFF + cur * VT_SZ;
        f32x16 p0, p1;
#pragma unroll
        for (int i = 0; i < 16; ++i) { p0[i] = 0.f; p1[i] = 0.f; }
#pragma unroll
        for (int ks = 0; ks < 4; ++ks) { const bf16x8 a0 = *(const LAS bf16x8*)(kb + r * 144 + ks * 32 + h * 16), a1 = *(const LAS bf16x8*)(kb + (32 + r) * 144 + ks * 32 + h * 16);
            p0 = MFMA32(a0, qf[ks], p0); p1 = MFMA32(a1, qf[ks], p1); }
        if (MLA) {
#pragma unroll
            for (int ks = 0; ks < 2; ++ks) { const bf16x8 a0 = *(const LAS bf16x8*)(rb + r * 80 + ks * 32 + h * 16), a1 = *(const LAS bf16x8*)(rb + (32 + r) * 80 + ks * 32 + h * 16);
                p0 = MFMA32(a0, qf[NQ - 2 + ks], p0); p1 = MFMA32(a1, qf[NQ - 2 + ks], p1); } }
        __builtin_amdgcn_sched_barrier(0);
        float mx = p0[0];
#pragma unroll
        for (int i = 1; i < 16; ++i) mx = fmaxf(mx, p0[i]);
#pragma unroll
        for (int i = 0; i < 16; ++i) mx = fmaxf(mx, p1[i]);
        mx = fmaxf(mx, __shfl_xor(mx, 32));
        const float mn = fmaxf(m, mx), alpha = __builtin_amdgcn_exp2f((m - mn) * c), mc = -mn * c; m = mn;
        float ps = 0.f;
#pragma unroll
        for (int i = 0; i < 16; ++i) { p0[i] = __builtin_amdgcn_exp2f(fmaf(p0[i], c, mc)); ps += p0[i]; }
#pragma unroll
        for (int i = 0; i < 16; ++i) { p1[i] = __builtin_amdgcn_exp2f(fmaf(p1[i], c, mc)); ps += p1[i]; }
        l = l * alpha + ps;
#pragma unroll
        for (int i = 0; i < 16; ++i) { o0[i] *= alpha; o1[i] *= alpha; }
        __builtin_amdgcn_sched_barrier(0);
        bf16x8 pb[2][2];
#pragma unroll
        for (int s = 0; s < 2; ++s) {
            u32x4 w0; w0.x = pk2(p0[8 * s + 0], p0[8 * s + 1]); w0.y = pk2(p0[8 * s + 2], p0[8 * s + 3]); w0.z = pk2(p0[8 * s + 4], p0[8 * s + 5]); w0.w = pk2(p0[8 * s + 6], p0[8 * s + 7]);
            u32x4 w1; w1.x = pk2(p1[8 * s + 0], p1[8 * s + 1]); w1.y = pk2(p1[8 * s + 2], p1[8 * s + 3]); w1.z = pk2(p1[8 * s + 4], p1[8 * s + 5]); w1.w = pk2(p1[8 * s + 6], p1[8 * s + 7]);
            pb[0][s] = __builtin_bit_cast(bf16x8, w0); pb[1][s] = __builtin_bit_cast(bf16x8, w1); }
#pragma unroll
        for (int t = 0; t < 2; ++t)
#pragma unroll
            for (int s = 0; s < 2; ++s) { const int ko = (32 * t + 16 * s + 4 * h) * 2;
                { const u32x2 lo = *(const LAS u32x2*)(vb + r * 136 + ko), hi = *(const LAS u32x2*)(vb + r * 136 + ko + 16);
                  o0 = MFMA32(__builtin_bit_cast(bf16x8, ((u32x4){lo.x, lo.y, hi.x, hi.y})), pb[t][s], o0); }
                { const u32x2 lo = *(const LAS u32x2*)(vb + (32 + r) * 136 + ko), hi = *(const LAS u32x2*)(vb + (32 + r) * 136 + ko + 16);
                  o1 = MFMA32(__builtin_bit_cast(bf16x8, ((u32x4){lo.x, lo.y, hi.x, hi.y})), pb[t][s], o1); }
                __builtin_amdgcn_sched_barrier(0); }
        if (more) { const int nx = cur ^ 1;
            *(LAS u32x4*)(lds + nx * KB_SZ + kw) = kreg;
            *(LAS u32x2*)(lds + VT_OFF + nx * VT_SZ + vw) = (u32x2){vreg.x, vreg.y}; *(LAS u32x2*)(lds + VT_OFF + nx * VT_SZ + vw + 8) = (u32x2){vreg.z, vreg.w};
            if (MLA && tid < 256) *(LAS u32x4*)(lds + KR_OFF + nx * KR_SZ + rw) = rreg; }
        __syncthreads();
    }
    l += __shfl_xor(l, 32);
    const float inv = 1.f / l;
    bf16* orow = O + (size_t)(32 * wave + r) * DM;
#pragma unroll
    for (int g = 0; g < 4; ++g) {
        *(u32x2*)(orow + 8 * g + 4 * h) = (u32x2){pk2(o0[4 * g] * inv, o0[4 * g + 1] * inv), pk2(o0[4 * g + 2] * inv, o0[4 * g + 3] * inv)};
        *(u32x2*)(orow + 32 + 8 * g + 4 * h) = (u32x2){pk2(o1[4 * g] * inv, o1[4 * g + 1] * inv), pk2(o1[4 * g + 2] * inv, o1[4 * g + 3] * inv)}; }
}
__device__ __forceinline__ void phase_attention(unsigned char* ws, LAS unsigned char* lds, const f32x2* tabm, int tid, int wave, int lane, int G) {
    const bf16* QC = (const bf16*)(ws + WS_C + C_QC); const bf16* MQ = (const bf16*)(ws + WS_C + C_MQ); const bf16* KN = (const bf16*)(ws + WS_C + C_KN);
    const bf16* VTM = (const bf16*)(ws + WS_C + C_VTM); const bf16* KC = (const bf16*)(ws + WS_A + A_KC); const bf16* VTC = (const bf16*)(ws + WS_A + A_VTC);
    const bf16* KR = (const bf16*)(ws + WS_A + A_KR); bf16* ATT = (bf16*)(ws + WS_B);
    constexpr float C_G = 0.125f * 1.4426950408889634f, C_M = 0.10206207261596577f * 1.4426950408889634f;
    for (int i = blockIdx.x; i < 1280; i += G) {
        bool mla; int row0, key0, nkeys, hh, qpos0;
        if (i < 1024) { mla = i < 512; const int ii = i & 511, b = ii >> 6, qb = ii & 7; hh = (ii >> 3) & 7; row0 = TP + b * SEQS + qb * 256; key0 = TP + b * KSEQ; nkeys = KSEQ; qpos0 = qb * 256; }
        else { mla = i < 1152; const int ii = (i - 1024) & 127, b = ii >> 3; hh = ii & 7; row0 = b * 256; key0 = row0; nkeys = 256; qpos0 = -1; }
        if (mla) attn_unit<true>(lds, MQ + (size_t)row0 * MQD + hh * 96, MQD, KN + (size_t)key0 * 512 + hh * 64, 512, KR + (size_t)key0 * 32, VTM + (size_t)(hh * 64) * TK + key0, nkeys,
                                 ATT + (size_t)row0 * DM + 512 + hh * 64, C_M, tabm, qpos0, tid, wave, lane);
        else attn_unit<false>(lds, QC + (size_t)row0 * 512 + hh * 64, 512, KC + (size_t)key0 * 128 + (hh >> 2) * 64, 128, KR, VTC + (size_t)((hh >> 2) * 64) * TK + key0, nkeys,
                              ATT + (size_t)row0 * DM + hh * 64, C_G, tabm, -1, tid, wave, lane);
    }
}

#define XB_TMO      128
#define XB_XCNT(j)  (256  + 64 * (j))
#define XB_XSUB(j)  (1280 + 64 * (j))
#define XB_XGEN(j)  (2304 + 64 * (j))
#define XB_TOP      3328
#define XB_TOPGEN   3392
#define XCD_BAR_WORDS 3456
#define XB_SPIN_CAP (1u << 18)

__device__ __forceinline__ unsigned xb_ld(unsigned* p)              { return __hip_atomic_load(p, __ATOMIC_RELAXED, __HIP_MEMORY_SCOPE_AGENT); }
__device__ __forceinline__ unsigned xb_add(unsigned* p, unsigned v) { return __hip_atomic_fetch_add(p, v, __ATOMIC_RELAXED, __HIP_MEMORY_SCOPE_AGENT); }
__device__ __forceinline__ unsigned xb_xcc_id() { return (unsigned)__builtin_amdgcn_s_getreg((3 << 11) | 20) & 0xFu; }
#define XB_SPIN(cond, bar) do { unsigned _sp = 0; while (cond) { __builtin_amdgcn_s_sleep(1); \
    if ((++_sp & 255u) == 0u) { if (xb_ld(&(bar)[XB_TMO])) break; if (_sp > XB_SPIN_CAP) { atomicAdd(&(bar)[XB_TMO], 1u); break; } } } } while (0)

struct XcdBarrier {
    unsigned* bar; unsigned x;
    volatile LAS unsigned* st;
};

__device__ __forceinline__ XcdBarrier xcd_barrier_post(unsigned* bar, volatile LAS unsigned* st) {
    XcdBarrier b; b.bar = bar; b.x = xb_xcc_id(); b.st = st;
    if (threadIdx.x == 0) (void)xb_add(&bar[XB_XCNT(b.x)], 1u);
    return b;
}
__device__ __forceinline__ void xcd_barrier_complete(unsigned* bar, unsigned x, unsigned& nloc, unsigned& nx) {
    const unsigned G = gridDim.x * gridDim.y * gridDim.z;
    unsigned sum, cnt, mine, sp = 0u;
    for (;;) {
        sum = 0u; cnt = 0u; mine = 0u;
#pragma unroll
        for (unsigned j = 0; j < 16; ++j) { const unsigned c = xb_ld(&bar[XB_XCNT(j)]); sum += c; cnt += (c > 0u) ? 1u : 0u; mine = (j == x) ? c : mine; }
        if (sum == G) break;
        __builtin_amdgcn_s_sleep(1);
        if ((++sp & 255u) == 0u) { if (xb_ld(&bar[XB_TMO])) break; if (sp > XB_SPIN_CAP) { atomicAdd(&bar[XB_TMO], 1u); break; } }
    }
    nloc = mine > 0u ? mine : 1u; nx = cnt > 0u ? cnt : 1u;
}

__device__ __forceinline__ void xcd_barrier(const XcdBarrier& b) {
    asm volatile("s_waitcnt vmcnt(0)" ::: "memory");
    __syncthreads();
    if (threadIdx.x == 0) {
        unsigned* bar = b.bar;
        __builtin_amdgcn_s_waitcnt(0);
        unsigned nloc = b.st[0], nx = b.st[1];
        if (nloc == 0u) { xcd_barrier_complete(bar, b.x, nloc, nx); b.st[0] = nloc; b.st[1] = nx; }
        const unsigned old = xb_add(&bar[XB_XSUB(b.x)], 1u);
        const unsigned gen = old / nloc;
        if (old + 1u == (gen + 1u) * nloc) {
            __builtin_amdgcn_fence(__ATOMIC_RELEASE, "agent");
            asm volatile("s_waitcnt vmcnt(0)" ::: "memory");
            const unsigned og = xb_add(&bar[XB_TOP], 1u);
            const unsigned tg = og / nx;
            if (og + 1u == (tg + 1u) * nx) xb_add(&bar[XB_TOPGEN], 1u);
            else XB_SPIN(xb_ld(&bar[XB_TOPGEN]) == tg, bar);
            __builtin_amdgcn_fence(__ATOMIC_ACQUIRE, "agent");
            xb_add(&bar[XB_XGEN(b.x)], 1u);
            asm volatile("s_waitcnt vmcnt(0)" ::: "memory");
        } else {
            XB_SPIN(xb_ld(&bar[XB_XGEN(b.x)]) == gen, bar);
            __builtin_amdgcn_fence(__ATOMIC_ACQUIRE, "agent");
            asm volatile("s_waitcnt vmcnt(0)" ::: "memory");
        }
    }
    __syncthreads();
}

struct Args { const float* in[32]; float* out; unsigned char* ws; int ph_lo, ph_hi; };
constexpr int NPHASE = 18;

template <class Epi>
__device__ __forceinline__ void run_gemm(LAS unsigned char* lds, const bf16* A, const bf16* Bt, int M, int N, int K, int G, int cid, const Epi& E) {
    pg8::Gemm g{A, Bt, M, N, K}; pg8::StaticOrder S; S.init(M, N, G, cid);
    pg8::gemm_phase<Epi, pg8::StaticOrder, true, true>(lds, g, S, E);
}

__global__ void __launch_bounds__(NTHR, 2) fwd_kernel(Args args) {
    extern __shared__ __attribute__((aligned(16))) unsigned char lds_raw[];
    LAS unsigned char* lds = (LAS unsigned char*)lds_raw;
#if MK_CG_SYNC
    cg::grid_group grid = cg::this_grid();
#endif
    const int tid = threadIdx.x, lane = tid & 63, wave = __builtin_amdgcn_readfirstlane(tid >> 6);
    const int G = gridDim.x, bid = blockIdx.x, gw = bid * NWAVES + wave, ngw = G * NWAVES;
    unsigned char* ws = args.ws; const float* const* in = args.in; float* out = args.out;
    const int lo = args.ph_lo, hi = args.ph_hi;
#ifndef REP_PHASE
#define REP_PHASE (-1)
#define REP_N 1
#endif
#define PH(k) if (IN(k)) for (int rp_ = 0; rp_ < ((k) == REP_PHASE ? REP_N : 1); ++rp_)
#ifndef PH_MASK
#define PH_MASK 0x3ffff
#endif
#define IN(k) (((PH_MASK >> (k)) & 1) && lo <= (k) && (k) < hi)
#if MK_CG_SYNC
#define SEAM(k) do { if (IN(k) && IN((k) + 1)) grid.sync(); } while (0)
#else
    if (tid < 2) ((volatile LAS unsigned*)(lds + 131072))[tid] = 0u;
    __syncthreads();
    const XcdBarrier bar = xcd_barrier_post((unsigned*)(args.ws + WS_CTL), (volatile LAS unsigned*)(lds + 131072));
#define SEAM(k) do { if (IN(k) && IN((k) + 1)) xcd_barrier(bar); } while (0)
#endif
    bf16* H = (bf16*)(ws + WS_A); bf16* OB = (bf16*)(ws + WS_A); bf16* MIX = (bf16*)(ws + WS_B); bf16* ATT = (bf16*)(ws + WS_B);
    bf16* U = (bf16*)(ws + WS_C); bf16* ACT = (bf16*)(ws + WS_C);
    const float* MOD0 = (const float*)(ws + WS_MOD); const float* MOD1 = MOD0 + 9 * 6144;
    const f32x2* tabg = (const f32x2*)(ws + WS_TABG); const f32x2* tabm = (const f32x2*)(ws + WS_TABM);
    float* Y = out + OUT_Y;

    PH(0) {
        p0_adaln(in, ws, lds, tid, wave, lane, G);
        if (bid == G - 1) p0_tables(in, ws, tid);
        p0_weights(in, ws, (LAS float*)(lds + 57344 + wave * 8448), gw, ngw, lane);
    }
    SEAM(0);
    PH(1) phase_norm_in(in[0], in[1], in[10] + 0 * DM, MOD0, 0, H, gw, ngw, lane);
    SEAM(1);
    PH(2) run_gemm(lds, H, (const bf16*)(ws + WS_WCIN), T, CIN, 1024, G, bid, EpiStore{U, CIN, (const float*)(ws + WS_BCIN)});
    SEAM(2);
    PH(3) phase_conv(U, MIX, in[13], in[15], in[16], in[17], in[18], lds, tid, wave, lane, G);
    SEAM(3);
    PH(4) run_gemm(lds, MIX, (const bf16*)(ws + WS_WCOUT), T, 1024, 1024, G, bid, EpiStore{OB, DM, in[20]});
    SEAM(4);
    PH(5) phase_post<true>(OB, in[0], in[1], Y, in[11] + 0 * DM, MOD0, 2, in[10] + 1 * DM, MOD0, 3, H, gw, ngw, lane);
    SEAM(5);
    PH(6) run_gemm(lds, H, (const bf16*)(ws + WS_WGU0), T, 2 * FFN, 1024, G, bid, EpiSwiGLU{ACT});
    SEAM(6);
    PH(7) run_gemm(lds, ACT, (const bf16*)(ws + WS_WD0), T, 1024, FFN, G, bid, EpiStore{OB, DM, nullptr});
    SEAM(7);
    PH(8) phase_post<true>(OB, Y, Y + (size_t)TP * DM, Y, in[11] + 1 * DM, MOD0, 5, in[10] + 2 * DM, MOD1, 0, H, gw, ngw, lane);
    SEAM(8);
    PH(9) run_gemm(lds, H, (const bf16*)(ws + WS_WAIN), T, AINP, 1024, G, bid, EpiStore{(bf16*)(ws + WS_C + C_U1), AINP, nullptr});
    SEAM(9);
    PH(10) phase_attn_rows((const bf16*)(ws + WS_C + C_U1), in[22], in[23], in[24], in[26], tabg, tabm,
                                (bf16*)(ws + WS_C + C_QC), (bf16*)(ws + WS_A + A_KC), (bf16*)(ws + WS_A + A_VTC), (bf16*)(ws + WS_A + A_QA), (bf16*)(ws + WS_A + A_CKV), (bf16*)(ws + WS_A + A_KR),
                                out + OUT_K, out + OUT_V, out + OUT_CKV, out + OUT_KR, in[2], in[3], in[4], in[5], gw, ngw, lane);
    SEAM(10);
    PH(11) {
        run_gemm(lds, (const bf16*)(ws + WS_A + A_QA), (const bf16*)(ws + WS_WQB), T, MQD, QL, G, bid, EpiStore{(bf16*)(ws + WS_C + C_MQ), MQD, nullptr});
        run_gemm(lds, (const bf16*)(ws + WS_A + A_CKV), (const bf16*)(ws + WS_WKN), TK, 512, KVL, G, (bid + 240) % G, EpiStore{(bf16*)(ws + WS_C + C_KN), 512, nullptr});
        run_gemm(lds, (const bf16*)(ws + WS_WVT), (const bf16*)(ws + WS_A + A_CKV), 512, TK, KVL, G, (bid + 160) % G, EpiStore{(bf16*)(ws + WS_C + C_VTM), TK, nullptr});
    }
    SEAM(11);
    PH(12) phase_attention(ws, lds, tabm, tid, wave, lane, G);
    SEAM(12);
    PH(13) run_gemm(lds, ATT, (const bf16*)(ws + WS_WAOUT), T, 1024, 1024, G, bid, EpiStore{OB, DM, nullptr});
    SEAM(13);
    PH(14) phase_post<true>(OB, Y, Y + (size_t)TP * DM, Y, in[11] + 2 * DM, MOD1, 2, in[10] + 3 * DM, MOD1, 3, H, gw, ngw, lane);
    SEAM(14);
    PH(15) run_gemm(lds, H, (const bf16*)(ws + WS_WGU1), T, 2 * FFN, 1024, G, bid, EpiSwiGLU{ACT});
    SEAM(15);
    PH(16) run_gemm(lds, ACT, (const bf16*)(ws + WS_WD1), T, 1024, FFN, G, bid, EpiStore{OB, DM, nullptr});
    SEAM(16);
    PH(17) phase_post<false>(OB, Y, Y + (size_t)TP * DM, Y, in[11] + 3 * DM, MOD1, 5, nullptr, nullptr, 0, nullptr, gw, ngw, lane);
#undef IN
#undef SEAM
}

#ifndef MK_ONE_LAUNCH
#define MK_ONE_LAUNCH 1
#endif
extern "C" void kernel_launch(void* const* d_in, const int* in_sizes, int n_in, void* d_out, int out_size, void* d_ws, size_t ws_size, hipStream_t stream) {
    static int grid = 0;
    if (grid == 0) {
        if (n_in != 32 || ws_size < WS_END) { fprintf(stderr, "kernel_launch: unexpected inputs (n_in %d, ws %zu)\n", n_in, ws_size); grid = -1; return; }
        int dev = 0, cus = 0, per_cu = 0;
        (void)hipGetDevice(&dev); (void)hipDeviceGetAttribute(&cus, hipDeviceAttributeMultiprocessorCount, dev);
        if (hipFuncSetAttribute((const void*)fwd_kernel, hipFuncAttributeMaxDynamicSharedMemorySize, LDS_BYTES) != hipSuccess) { fprintf(stderr, "kernel_launch: hipFuncSetAttribute failed\n"); grid = -1; return; }
        if (hipOccupancyMaxActiveBlocksPerMultiprocessor(&per_cu, (const void*)fwd_kernel, NTHR, LDS_BYTES) != hipSuccess || per_cu < 1) { fprintf(stderr, "kernel_launch: occupancy query says %d\n", per_cu); per_cu = 1; }
        (void)hipGetLastError();
        grid = cus;
    }
    if (grid < 0) return;
    Args a{};
    for (int i = 0; i < 32; ++i) a.in[i] = (const float*)d_in[i];
    a.out = (float*)d_out; a.ws = (unsigned char*)d_ws;
#if MK_ONE_LAUNCH && MK_CG_SYNC
    a.ph_lo = 0; a.ph_hi = NPHASE;
    void* kargs[] = {&a};
    hipError_t e = hipLaunchCooperativeKernel((const void*)fwd_kernel, dim3(grid), dim3(NTHR), kargs, LDS_BYTES, stream);
    if (e != hipSuccess) fprintf(stderr, "kernel_launch: cooperative launch failed: %s (grid %d)\n", hipGetErrorString(e), grid);
#elif MK_ONE_LAUNCH
    if (hipMemsetAsync((char*)d_ws + WS_CTL, 0, 16384, stream) != hipSuccess) { fprintf(stderr, "kernel_launch: memset failed\n"); return; }
    a.ph_lo = 0; a.ph_hi = NPHASE;
    hipLaunchKernelGGL(fwd_kernel, dim3(grid), dim3(NTHR), LDS_BYTES, stream, a);
#else
    for (int p = 0; p < NPHASE; ++p) { a.ph_lo = p; a.ph_hi = p + 1; hipLaunchKernelGGL(fwd_kernel, dim3(grid), dim3(NTHR), LDS_BYTES, stream, a); }
#endif
}
```

```cpp
#include <hip/hip_runtime.h>
#include <hip/hip_cooperative_groups.h>
#include <cstdio>
#include <cstdint>
namespace cg = cooperative_groups;
#ifndef MK_CG_SYNC
#define MK_CG_SYNC 0
#endif
namespace pg8 {
#define PG8_LAS __attribute__((address_space(3)))
typedef unsigned short bf16_t;
typedef short bf16x8 __attribute__((ext_vector_type(8)));
typedef float f32x4 __attribute__((ext_vector_type(4)));
typedef unsigned u32x4 __attribute__((ext_vector_type(4)));
constexpr int BM = 256, BK = 64, HALF = 128, HTB = HALF * BK * 2  , STAGE_BYTES = 8 * HTB, NXCD = 8, WGM = 8;

__host__ __device__ __forceinline__ int lds_byte(int r, int c) { const int st = (r >> 4) * 2 + (c >> 5), rr = r & 15, cc = c & 31, ob = rr * 64 + cc * 2; return st * 1024 + (ob ^ (((ob >> 9) & 1) << 5)); }
__host__ __device__ __forceinline__ void stage_rc(int b, int& R, int& C) { const int st = b / 1024, sb = b % 1024, swz = sb ^ (((sb >> 9) & 1) << 5); R = (st >> 1) * 16 + swz / 64; C = (st & 1) * 32 + (swz % 64) / 2; }
__host__ __device__ __forceinline__ int perm32(int rho) { const int n = rho >> 4, i = rho & 15; return 8 * (i >> 2) + 4 * n + (i & 3); }

struct Unit { int pm, pn, koff, nt, part; };
struct Gemm { const bf16_t* A; const bf16_t* Bt; int M, N, K; };

struct StaticOrder {
    int nM, nN, nwg, G, c;
    __host__ __device__ void init(int M, int N, int G_, int c_) { nM = M / BM; nN = N / BM; nwg = nM * nN; G = G_; c = c_; }
    __host__ __device__ bool next(int i, Unit& u) const {
        const long L = (long)i * G + c; if (L >= nwg) return false;
        int wgid = (int)L; { const int q = nwg / NXCD, r = nwg % NXCD, xcd = wgid % NXCD, off = wgid / NXCD; wgid = (xcd < r ? xcd * (q + 1) : r * (q + 1) + (xcd - r) * q) + off; }
        const int nig = WGM * nN, gid = wgid / nig, fm = gid * WGM, gsz = (nM - fm) < WGM ? (nM - fm) : WGM;
        u.pm = fm + ((wgid % nig) % gsz); u.pn = (wgid % nig) / gsz; return true;
    }
    __device__ __forceinline__ void a_ready(const Unit&) const {}
    __device__ __forceinline__ void done(const Unit&) const {}
};

__device__ __forceinline__ unsigned cvt_pk_bf16(float lo, float hi) { unsigned r; asm volatile("v_cvt_pk_bf16_f32 %0, %1, %2" : "=v"(r) : "v"(lo), "v"(hi)); return r; }
template <class Epi, class Sched, bool ALIGN_EPI = false, bool SP2 = false>
__device__ __forceinline__ void gemm_phase(PG8_LAS unsigned char* lds, const Gemm g, const Sched& S, const Epi& E) {
    const int tid = threadIdx.x, wid = __builtin_amdgcn_readfirstlane(tid >> 6), lane = tid & 63, wr = wid >> 2, wc = wid & 3, fr = lane & 15, fq = lane >> 4;
    const int K = g.K;
    unsigned voffA[2], voffB[2];
#pragma unroll
    for (int i = 0; i < 2; ++i) { int R, C; stage_rc(tid * 16 + i * 8192, R, C); const int Rb = Epi::PERM ? ((R & ~31) + perm32(R & 31)) : R;
        voffA[i] = (unsigned)(R * K + C) * 2u; voffB[i] = (unsigned)(Rb * K + C) * 2u; }
    const size_t kstep = (size_t)(BK * 2);
    const size_t hstep = (size_t)HALF * K * 2;
    const size_t tstep = 2 * hstep;
    const unsigned ldsw = (unsigned)wid * 1024u;
    const int aoff = lds_byte(wr * 64 + fr, fq * 8), boff = lds_byte(wc * 32 + fr, fq * 8);
#define PG8_SA(b, h) (((b) * 2 + (h)) * HTB)
#define PG8_SB(b, h) ((4 + (b) * 2 + (h)) * HTB)
#define PG8_STAGE(bufoff, gbase, voff) do { _Pragma("unroll") for (int _i = 0; _i < 2; ++_i) \
        __builtin_amdgcn_global_load_lds((const unsigned*)((const char*)(gbase) + (voff)[_i]), (PG8_LAS unsigned*)(lds + (bufoff) + ldsw + _i * 8192), 16, 0, 0); } while (0)
#define PG8_LDA(dst, b, h) do { _Pragma("unroll") for (int m = 0; m < 4; ++m) _Pragma("unroll") for (int k = 0; k < 2; ++k) dst[m][k] = *(const PG8_LAS bf16x8*)(lds + PG8_SA(b, h) + aoff + m * 2048 + k * 1024); } while (0)
#define PG8_LDB(dst, b, h) do { _Pragma("unroll") for (int n = 0; n < 2; ++n) _Pragma("unroll") for (int k = 0; k < 2; ++k) dst[n][k] = *(const PG8_LAS bf16x8*)(lds + PG8_SB(b, h) + boff + n * 2048 + k * 1024); } while (0)
#define PG8_MMA(ai, bj, At, Bt) do { __builtin_amdgcn_s_setprio(1); _Pragma("unroll") for (int m = 0; m < 4; ++m) _Pragma("unroll") for (int n = 0; n < 2; ++n) _Pragma("unroll") for (int k = 0; k < 2; ++k) \
        acc[ai][bj][m][n] = __builtin_amdgcn_mfma_f32_16x16x32_bf16(Bt[n][k], At[m][k], acc[ai][bj][m][n], 0, 0, 0); __builtin_amdgcn_s_setprio(0); } while (0)
#define PG8_WAIT_V(n) asm volatile("s_waitcnt vmcnt(" #n ")" ::: "memory")
#define PG8_WAIT_L(n) asm volatile("s_waitcnt lgkmcnt(" #n ")" ::: "memory")
#define PG8_BAR __builtin_amdgcn_s_barrier()
#define PG8_SCHED __builtin_amdgcn_sched_barrier(0)
    Unit cur, nxt; int ui = 0;
    if (!S.next(0, cur)) return;
    int nt = cur.nt;
    f32x4 acc[2][2][4][2];
#pragma unroll
    for (int a = 0; a < 2; ++a)
#pragma unroll
        for (int b = 0; b < 2; ++b)
#pragma unroll
            for (int m = 0; m < 4; ++m)
#pragma unroll
                for (int n = 0; n < 2; ++n) acc[a][b][m][n] = (f32x4){0.f, 0.f, 0.f, 0.f};
    bf16x8 At[4][2], B0[2][2], B1[2][2];
    const char* cA = (const char*)g.A + (size_t)cur.pm * tstep + (size_t)cur.koff * 2; const char* cB = (const char*)g.Bt + (size_t)cur.pn * tstep + (size_t)cur.koff * 2;
    S.a_ready(cur);
    if constexpr (SP2) {
        PG8_STAGE(PG8_SB(0, 0), cB, voffB); PG8_STAGE(PG8_SB(0, 1), cB + hstep, voffB); PG8_STAGE(PG8_SA(0, 0), cA, voffA); PG8_STAGE(PG8_SA(0, 1), cA + hstep, voffA);
        if (wr == 1) PG8_BAR;
        PG8_WAIT_V(2); PG8_BAR;
        PG8_STAGE(PG8_SB(1, 0), cB + kstep, voffB); PG8_STAGE(PG8_SA(1, 0), cA + kstep, voffA); PG8_STAGE(PG8_SB(1, 1), cB + hstep + kstep, voffB);
        PG8_WAIT_V(6); PG8_BAR;
    } else {
        PG8_STAGE(PG8_SB(0, 0), cB, voffB); PG8_STAGE(PG8_SA(0, 0), cA, voffA); PG8_STAGE(PG8_SB(0, 1), cB + hstep, voffB); PG8_STAGE(PG8_SA(0, 1), cA + hstep, voffA);
        if (wr == 1) PG8_BAR;
        PG8_WAIT_V(4); PG8_BAR;
        PG8_STAGE(PG8_SB(1, 0), cB + kstep, voffB); PG8_STAGE(PG8_SA(1, 0), cA + kstep, voffA); PG8_STAGE(PG8_SB(1, 1), cB + hstep + kstep, voffB);
        PG8_WAIT_V(6); PG8_BAR;
    }
    for (;;) {
        const bool has_next = S.next(ui + 1, nxt);
        const char* nA = has_next ? (const char*)g.A + (size_t)nxt.pm * tstep + (size_t)nxt.koff * 2 : cA; const char* nB = has_next ? (const char*)g.Bt + (size_t)nxt.pn * tstep + (size_t)nxt.koff * 2 : cB;
        for (int t = 0; t < nt; t += 2) {
            const bool last = (t == nt - 2);
            const char* a1 = cA + (size_t)(t + 1) * kstep;
            const char* a2 = last ? nA : cA + (size_t)(t + 2) * kstep; const char* b2 = last ? nB : cB + (size_t)(t + 2) * kstep;
            const char* a3 = a2 + kstep; const char* b3 = b2 + kstep;
            if (last && has_next) S.a_ready(nxt);
            if constexpr (SP2) {
            PG8_LDB(B0, 0, 0); PG8_LDB(B1, 0, 1); PG8_SCHED; PG8_LDA(At, 0, 0); PG8_STAGE(PG8_SA(1, 1), a1 + hstep, voffA);
            PG8_WAIT_V(8); PG8_WAIT_L(0); PG8_BAR; PG8_MMA(0, 0, At, B0); PG8_MMA(0, 1, At, B1); PG8_BAR; PG8_SCHED;
            PG8_LDA(At, 0, 1); PG8_STAGE(PG8_SB(0, 0), b2, voffB); PG8_STAGE(PG8_SB(0, 1), b2 + hstep, voffB); PG8_STAGE(PG8_SA(0, 0), a2, voffA);
            PG8_WAIT_V(8); PG8_WAIT_L(0); PG8_BAR; PG8_MMA(1, 0, At, B0); PG8_MMA(1, 1, At, B1); PG8_BAR; PG8_SCHED;
            PG8_LDB(B0, 1, 0); PG8_LDB(B1, 1, 1); PG8_SCHED; PG8_LDA(At, 1, 0); PG8_STAGE(PG8_SA(0, 1), a2 + hstep, voffA);
            PG8_WAIT_V(8); PG8_WAIT_L(0); PG8_BAR; PG8_MMA(0, 0, At, B0); PG8_MMA(0, 1, At, B1); PG8_BAR; PG8_SCHED;
            PG8_LDA(At, 1, 1); PG8_STAGE(PG8_SB(1, 0), b3, voffB); PG8_STAGE(PG8_SB(1, 1), b3 + hstep, voffB); PG8_STAGE(PG8_SA(1, 0), a3, voffA);
            PG8_WAIT_V(8); PG8_WAIT_L(0); PG8_BAR; PG8_MMA(1, 0, At, B0); PG8_MMA(1, 1, At, B1); PG8_BAR; PG8_SCHED;
            } else {
            PG8_LDB(B0, 0, 0); PG8_SCHED; PG8_LDA(At, 0, 0); PG8_STAGE(PG8_SA(1, 1), a1 + hstep, voffA);
            PG8_WAIT_L(8); PG8_BAR; PG8_WAIT_L(0); PG8_MMA(0, 0, At, B0); PG8_BAR; PG8_SCHED;
            PG8_LDB(B1, 0, 1); PG8_STAGE(PG8_SB(0, 0), b2, voffB);
            PG8_BAR; PG8_WAIT_L(0); PG8_MMA(0, 1, At, B1); PG8_BAR;
            PG8_LDA(At, 0, 1); PG8_STAGE(PG8_SA(0, 0), a2, voffA);
            PG8_BAR; PG8_WAIT_L(0); PG8_MMA(1, 0, At, B0); PG8_BAR; PG8_SCHED;
            PG8_STAGE(PG8_SB(0, 1), b2 + hstep, voffB);
            PG8_WAIT_V(6); PG8_BAR; PG8_MMA(1, 1, At, B1); PG8_BAR;
            PG8_LDB(B0, 1, 0); PG8_SCHED; PG8_LDA(At, 1, 0); PG8_STAGE(PG8_SA(0, 1), a2 + hstep, voffA);
            PG8_WAIT_L(8); PG8_BAR; PG8_WAIT_L(0); PG8_MMA(0, 0, At, B0); PG8_BAR; PG8_SCHED;
            PG8_LDB(B1, 1, 1); PG8_STAGE(PG8_SB(1, 0), b3, voffB);
            PG8_BAR; PG8_WAIT_L(0); PG8_MMA(0, 1, At, B1); PG8_BAR;
            PG8_LDA(At, 1, 1); PG8_STAGE(PG8_SA(1, 0), a3, voffA);
            PG8_BAR; PG8_WAIT_L(0); PG8_MMA(1, 0, At, B0); PG8_BAR; PG8_SCHED;
            PG8_STAGE(PG8_SB(1, 1), b3 + hstep, voffB);
            PG8_WAIT_V(6); PG8_BAR; PG8_MMA(1, 1, At, B1); PG8_BAR;
            }
        }
        if constexpr (ALIGN_EPI) { if (wr == 0) PG8_BAR; }
        if constexpr (!Epi::AFTER_DRAIN) { E(acc, cur, wr, wc, fr, fq); S.done(cur); }
        if (!has_next) break;
#pragma unroll
        for (int a = 0; a < 2; ++a)
#pragma unroll
            for (int b = 0; b < 2; ++b)
#pragma unroll
                for (int m = 0; m < 4; ++m)
#pragma unroll
                    for (int n = 0; n < 2; ++n) acc[a][b][m][n] = (f32x4){0.f, 0.f, 0.f, 0.f};
        cur = nxt; cA = nA; cB = nB; nt = cur.nt; ++ui;
        if constexpr (ALIGN_EPI) { if (wr == 1) PG8_BAR; }
    }
    PG8_WAIT_V(0);
    if constexpr (!ALIGN_EPI) { if (wr == 0) PG8_BAR; }
    PG8_BAR;
    if constexpr (Epi::AFTER_DRAIN) { E.fused(acc, cur, wr, wc, fr, fq, lds, wid, lane); S.done(cur); }
#undef PG8_SA
#undef PG8_SB
#undef PG8_STAGE
#undef PG8_LDA
#undef PG8_LDB
#undef PG8_MMA
#undef PG8_WAIT_V
#undef PG8_WAIT_L
#undef PG8_BAR
#undef PG8_SCHED
}
}

#define LAS __attribute__((address_space(3)))
typedef unsigned short bf16;
typedef float f32x4 __attribute__((ext_vector_type(4)));
typedef float f32x2 __attribute__((ext_vector_type(2)));
typedef float f32x16 __attribute__((ext_vector_type(16)));
typedef short bf16x8 __attribute__((ext_vector_type(8)));
typedef unsigned u32x4 __attribute__((ext_vector_type(4)));
typedef unsigned u32x2 __attribute__((ext_vector_type(2)));

constexpr int DM = 1024, TP = 4096, TS = 16384, T = TP + TS, SEQS = 2048, NBS = 8, PAST = 256;
constexpr int KSEQ = PAST + SEQS;
constexpr int TK = TP + NBS * KSEQ;
constexpr int FFN = 2816, CIN = 2560, AIN = 1440, AINP = 1536, QL = 384, KVL = 256, MQD = 768;
constexpr float EPS = 1e-6f;
constexpr int NWAVES = 8, NTHR = 512;
constexpr int LDS_BYTES = 147456;
constexpr int SPLIT_ROW0 = 16384;
constexpr size_t SLAB_ELEMS = (size_t)(T - SPLIT_ROW0) * DM;

constexpr size_t MiB = (size_t)1 << 20;
constexpr size_t al256(size_t x) { return (x + 255) & ~(size_t)255; }
constexpr size_t WS_CTL = 0;
constexpr size_t WS_MOD = 1 * MiB;
constexpr size_t WS_TABG = WS_MOD + al256((size_t)2 * 9 * 6144 * 4);
constexpr size_t WS_TABM = WS_TABG + al256(64 * 16 * 8);
constexpr size_t WS_BCIN = WS_TABM + al256(64 * 8 * 8);
constexpr size_t WS_WCIN = 2 * MiB;
constexpr size_t WS_WCOUT = WS_WCIN + (size_t)2560 * 1024 * 2;
constexpr size_t WS_WGU0 = WS_WCOUT + (size_t)1024 * 1024 * 2;
constexpr size_t WS_WD0 = WS_WGU0 + (size_t)5632 * 1024 * 2;
constexpr size_t WS_WGU1 = WS_WD0 + (size_t)1024 * 2816 * 2;
constexpr size_t WS_WD1 = WS_WGU1 + (size_t)5632 * 1024 * 2;
constexpr size_t WS_WAIN = WS_WD1 + (size_t)1024 * 2816 * 2;
constexpr size_t WS_WQB = WS_WAIN + (size_t)1536 * 1024 * 2;
constexpr size_t WS_WKN = WS_WQB + (size_t)768 * 384 * 2;
constexpr size_t WS_WVT = WS_WKN + (size_t)512 * 256 * 2;
constexpr size_t WS_WAOUT = WS_WVT + (size_t)512 * 256 * 2;
constexpr size_t WS_WEND = WS_WAOUT + (size_t)1024 * 1024 * 2;
constexpr size_t WS_A = 50 * MiB;
constexpr size_t WS_B = 90 * MiB;
constexpr size_t WS_C = 130 * MiB;
constexpr size_t WS_END = 240 * MiB;
static_assert(WS_BCIN + 2560 * 4 <= WS_WCIN && WS_WEND <= WS_A, "ws map");
constexpr size_t A_QA = 0;
constexpr size_t A_CKV = A_QA + (size_t)T * QL * 2;
constexpr size_t A_KR = A_CKV + (size_t)TK * KVL * 2;
constexpr size_t A_KC = A_KR + (size_t)TK * 32 * 2;
constexpr size_t A_VTC = A_KC + (size_t)TK * 128 * 2;
static_assert(A_VTC + (size_t)128 * TK * 2 <= 40 * MiB, "region A");
constexpr size_t C_U1 = 0;
constexpr size_t C_QC = (size_t)T * AINP * 2;
constexpr size_t C_VTM = C_QC + (size_t)T * 512 * 2;
constexpr size_t C_MQ = 0;
constexpr size_t C_KN = (size_t)T * MQD * 2;
static_assert(C_KN + (size_t)TK * 512 * 2 <= C_QC && C_VTM + (size_t)512 * TK * 2 <= 110 * MiB, "region C");
constexpr size_t OUT_Y = 0, OUT_K = (size_t)T * DM, OUT_V = OUT_K + (size_t)TP * 128, OUT_CKV = OUT_V + (size_t)TP * 128, OUT_KR = OUT_CKV + (size_t)TP * 256;

__device__ __forceinline__ unsigned pk2(float lo, float hi) { return pg8::cvt_pk_bf16(lo, hi); }
__device__ __forceinline__ bf16 f2bf(float x) { return (bf16)(pk2(x, 0.f) & 0xffffu); }
__device__ __forceinline__ float bf2f(bf16 b) { return __uint_as_float((unsigned)b << 16); }
__device__ __forceinline__ float bflo(unsigned w) { return __uint_as_float(w << 16); }
__device__ __forceinline__ float bfhi(unsigned w) { return __uint_as_float(w & 0xffff0000u); }
__device__ __forceinline__ float wave_sum(float v) {
#pragma unroll
    for (int o = 1; o < 64; o <<= 1) v += __shfl_xor(v, o);
    return v;
}
__device__ __forceinline__ float fsigmoid(float x) { return __builtin_amdgcn_rcpf(1.f + __builtin_amdgcn_exp2f(-1.4426950408889634f * x)); }
__device__ __forceinline__ float fsilu(float x) { return x * fsigmoid(x); }
__device__ __forceinline__ const float* xrow_in(const float* xp, const float* xs, int r) { return r < TP ? xp + (size_t)r * DM : xs + (size_t)(r - TP) * DM; }
__device__ __forceinline__ int cond_of(int r) { return r < TP ? 0 : 1 + ((r - TP) >> 11); }
__device__ __forceinline__ void unpack8(u32x4 w, float (&v)[8]) {
    v[0] = bflo(w.x); v[1] = bfhi(w.x); v[2] = bflo(w.y); v[3] = bfhi(w.y); v[4] = bflo(w.z); v[5] = bfhi(w.z); v[6] = bflo(w.w); v[7] = bfhi(w.w);
}
__device__ __forceinline__ u32x4 pack8(const float (&v)[8]) { u32x4 w; w.x = pk2(v[0], v[1]); w.y = pk2(v[2], v[3]); w.z = pk2(v[4], v[5]); w.w = pk2(v[6], v[7]); return w; }

struct EpiStore {
    static constexpr bool PERM = true, AFTER_DRAIN = false;
    bf16* O; int ldc; const float* bias; bf16* slab;
    __device__ __forceinline__ void operator()(const f32x4 (&acc)[2][2][4][2], const pg8::Unit& u, int wr, int wc, int fr, int fq) const {
        const int row0 = u.pm * 256 + wr * 64 + fr, col0 = u.pn * 256 + wc * 32 + 8 * fq;
        bf16* base = u.part == 0 ? O : slab + (size_t)(u.part - 1) * SLAB_ELEMS - (size_t)SPLIT_ROW0 * DM;
        const bool hb = bias != nullptr && u.part == 0;
        f32x4 bv[2][2];
#pragma unroll
        for (int bj = 0; bj < 2; ++bj)
#pragma unroll
            for (int n = 0; n < 2; ++n) bv[bj][n] = hb ? *(const f32x4*)(bias + col0 + bj * 128 + 4 * n) : (f32x4){0.f, 0.f, 0.f, 0.f};
#pragma unroll
        for (int ai = 0; ai < 2; ++ai)
#pragma unroll
            for (int m = 0; m < 4; ++m) { bf16* rowp = base + (size_t)(row0 + ai * 128 + m * 16) * ldc + col0;
#pragma unroll
                for (int bj = 0; bj < 2; ++bj) { const f32x4 v0 = acc[ai][bj][m][0] + bv[bj][0], v1 = acc[ai][bj][m][1] + bv[bj][1];
                    u32x4 w; w.x = pk2(v0[0], v0[1]); w.y = pk2(v0[2], v0[3]); w.z = pk2(v1[0], v1[1]); w.w = pk2(v1[2], v1[3]);
                    *(u32x4*)(rowp + bj * 128) = w; } }
    }
};
struct EpiSwiGLU {
    static constexpr bool PERM = true, AFTER_DRAIN = false;
    bf16* O;
    __device__ __forceinline__ void operator()(const f32x4 (&acc)[2][2][4][2], const pg8::Unit& u, int wr, int wc, int fr, int fq) const {
        const int row0 = u.pm * 256 + wr * 64 + fr, col0 = u.pn * 128 + wc * 32 + 8 * fq;
#pragma unroll
        for (int ai = 0; ai < 2; ++ai)
#pragma unroll
            for (int m = 0; m < 4; ++m) { bf16* rowp = O + (size_t)(row0 + ai * 128 + m * 16) * FFN + col0;
                const f32x4 g0 = acc[ai][0][m][0], g1 = acc[ai][0][m][1], u0 = acc[ai][1][m][0], u1 = acc[ai][1][m][1];
                u32x4 w; w.x = pk2(fsilu(g0[0]) * u0[0], fsilu(g0[1]) * u0[1]); w.y = pk2(fsilu(g0[2]) * u0[2], fsilu(g0[3]) * u0[3]);
                w.z = pk2(fsilu(g1[0]) * u1[0], fsilu(g1[1]) * u1[1]); w.w = pk2(fsilu(g1[2]) * u1[2], fsilu(g1[3]) * u1[3]);
                *(u32x4*)rowp = w; }
    }
};
__device__ __forceinline__ void tr_item(const float* src, int ldw, bf16* WT, int K, int k0, int drow0, LAS float* scr, int lane) {
    float tv[32];
#pragma unroll
    for (int i = 0; i < 32; ++i) { const int kk = 2 * i + (lane >> 5); tv[i] = src ? src[(size_t)(k0 + kk) * ldw] : 0.f; }
#pragma unroll
    for (int i = 0; i < 32; ++i) { const int kk = 2 * i + (lane >> 5); scr[kk * 33 + (lane & 31)] = tv[i]; }
    asm volatile("s_waitcnt lgkmcnt(0)" ::: "memory");
    const int c = lane & 7;
#pragma unroll
    for (int j = 0; j < 4; ++j) { const int n = (lane >> 3) + 8 * j; const LAS float* s = scr + (8 * c) * 33 + n;
        u32x4 o; o.x = pk2(s[0 * 33], s[1 * 33]); o.y = pk2(s[2 * 33], s[3 * 33]); o.z = pk2(s[4 * 33], s[5 * 33]); o.w = pk2(s[6 * 33], s[7 * 33]);
        *(u32x4*)(WT + (size_t)(drow0 + n) * K + k0 + 8 * c) = o; }
    asm volatile("s_waitcnt lgkmcnt(0)" ::: "memory");
}

__device__ __forceinline__ void p0_weights(const float* const* in, unsigned char* ws, LAS float* scr, int gw, int ngw, int lane) {
    constexpr int I_CIN = 16 * 80, I_COUT = 16 * 32, I_GU = 16 * 176, I_D = 44 * 32, I_AIN = 16 * 48, I_QB = 6 * 24, I_KN = 4 * 16, I_AOUT = 16 * 32;
    constexpr int NITEMS = I_CIN + I_COUT + 2 * I_GU + 2 * I_D + I_AIN + I_QB + 2 * I_KN + I_AOUT;
    const int ln = lane & 31;
    for (int it = gw; it < NITEMS; it += ngw) {
        int r = it;
        if (r < I_CIN) { const int nblk = 80, kb = r / nblk, nb = r % nblk, n = 32 * nb + ln;
            tr_item(in[12] + n, CIN, (bf16*)(ws + WS_WCIN), 1024, 64 * kb, 32 * nb, scr, lane); continue; } r -= I_CIN;
        if (r < I_COUT) { const int nblk = 32, kb = r / nblk, nb = r % nblk, n = 32 * nb + ln;
            tr_item(in[19] + n, 1024, (bf16*)(ws + WS_WCOUT), 1024, 64 * kb, 32 * nb, scr, lane); continue; } r -= I_COUT;
        if (r < 2 * (I_GU + I_D)) { const int l = r >= (I_GU + I_D) ? 1 : 0; r -= l * (I_GU + I_D);
            if (r < I_GU) { const int nblk = 176, kb = r / nblk, nb = r % nblk, n = 32 * nb + ln, t = n >> 8, w = n & 255;
                const float* src = (w < 128 ? in[29] : in[30]) + (size_t)l * 1024 * FFN + 128 * t + (w & 127);
                tr_item(src, FFN, (bf16*)(ws + (l ? WS_WGU1 : WS_WGU0)), 1024, 64 * kb, 32 * nb, scr, lane); }
            else { r -= I_GU; const int nblk = 32, kb = r / nblk, nb = r % nblk, n = 32 * nb + ln;
                tr_item(in[31] + (size_t)l * FFN * 1024 + n, 1024, (bf16*)(ws + (l ? WS_WD1 : WS_WD0)), FFN, 64 * kb, 32 * nb, scr, lane); }
            continue; } r -= 2 * (I_GU + I_D);
        if (r < I_AIN) { const int nblk = 48, kb = r / nblk, nb = r % nblk, n = 32 * nb + ln;
            tr_item(n < AIN ? in[21] + n : nullptr, AIN, (bf16*)(ws + WS_WAIN), 1024, 64 * kb, 32 * nb, scr, lane); continue; } r -= I_AIN;
        if (r < I_QB) { const int nblk = 24, kb = r / nblk, nb = r % nblk, n = 32 * nb + ln, hh = n / 96, w = n % 96;
            int sc = n; if (w >= 64) { const int e = w - 64, blk = e >> 4, loc = e & 15; sc = hh * 96 + 64 + 16 * blk + 8 * (loc & 1) + (loc >> 1); }
            tr_item(in[25] + sc, MQD, (bf16*)(ws + WS_WQB), QL, 64 * kb, 32 * nb, scr, lane); continue; } r -= I_QB;
        if (r < I_KN) { const int nblk = 16, kb = r / nblk, nb = r % nblk, n = 32 * nb + ln;
            tr_item(in[27] + (n >> 6) * 128 + (n & 63), 1024, (bf16*)(ws + WS_WKN), KVL, 64 * kb, 32 * nb, scr, lane); continue; } r -= I_KN;
        if (r < I_KN) { const int nblk = 16, kb = r / nblk, nb = r % nblk, n = 32 * nb + ln;
            tr_item(in[27] + (n >> 6) * 128 + 64 + (n & 63), 1024, (bf16*)(ws + WS_WVT), KVL, 64 * kb, 32 * nb, scr, lane); continue; } r -= I_KN;
        { const int nblk = 32, kb = r / nblk, nb = r % nblk, n = 32 * nb + ln;
            tr_item(in[28] + n, 1024, (bf16*)(ws + WS_WAOUT), 1024, 64 * kb, 32 * nb, scr, lane); }
    }
}

__device__ __forceinline__ void p0_adaln(const float* const* in, unsigned char* ws, LAS unsigned char* lds, int tid, int wave, int lane, int G) {
    LAS float* sS = (LAS float*)lds;
    LAS float* red = (LAS float*)(lds + 9 * 1024 * 4);
    float* MOD = (float*)(ws + WS_MOD);
    for (int i = tid; i < 9 * 1024; i += NTHR) { const int cnd = i >> 10, k = i & 1023; const float x = cnd == 0 ? in[7][k] : in[6][(cnd - 1) * 1024 + k]; sS[i] = fsilu(x); }
    __syncthreads();
    const int lc = lane < 48 ? lane : 47;
    for (int it = blockIdx.x; it < 256; it += G) {
        const int l = it >> 7, n0 = 48 * (it & 127);
        const float* wp = in[8] + (size_t)l * 1024 * 6144 + n0 + lc;
        float acc[9];
#pragma unroll
        for (int c = 0; c < 9; ++c) acc[c] = 0.f;
        const int kb = 128 * wave;
#pragma unroll 1
        for (int k = kb; k < kb + 128; k += 16) {
            float wv[16];
#pragma unroll
            for (int q = 0; q < 16; ++q) wv[q] = wp[(size_t)(k + q) * 6144];
#pragma unroll
            for (int q4 = 0; q4 < 4; ++q4)
#pragma unroll
                for (int c = 0; c < 9; ++c) { const f32x4 sv = *(const LAS f32x4*)(sS + c * 1024 + k + 4 * q4); acc[c] += sv.x * wv[4 * q4] + sv.y * wv[4 * q4 + 1] + sv.z * wv[4 * q4 + 2] + sv.w * wv[4 * q4 + 3]; }
        }
#pragma unroll
        for (int c = 0; c < 9; ++c) red[(wave * 9 + c) * 64 + lane] = acc[c];
        __syncthreads();
        for (int idx = tid; idx < 576; idx += NTHR) { const int c = idx >> 6, ln = idx & 63;
            if (ln < 48) { float sum = in[9][l * 6144 + n0 + ln];
#pragma unroll
                for (int w = 0; w < 8; ++w) sum += red[(w * 9 + c) * 64 + ln];
                MOD[(size_t)(l * 9 + c) * 6144 + n0 + ln] = sum; } }
        __syncthreads();
    }
}
__device__ __forceinline__ void p0_tables(const float* const* in, unsigned char* ws, int tid) {
    f32x2* tabg = (f32x2*)(ws + WS_TABG); f32x2* tabm = (f32x2*)(ws + WS_TABM); float* bcin = (float*)(ws + WS_BCIN);
    for (int i = tid; i < 64 * 16; i += NTHR) { const int pos = i >> 4, f = i & 15; const float inv = exp2f(-(float)f * (13.287712379549449f / 16.f)), a = (float)pos * inv; tabg[i] = (f32x2){__cosf(a), __sinf(a)}; }
    for (int i = tid; i < 64 * 8; i += NTHR) { const int pos = i >> 3, f = i & 7; const float inv = exp2f(-(float)f * (13.287712379549449f / 8.f)), a = (float)pos * inv; tabm[i] = (f32x2){__cosf(a), __sinf(a)}; }
    for (int i = tid; i < CIN; i += NTHR) bcin[i] = i < 1536 ? 0.f : in[14][i - 1536];
}

__device__ __forceinline__ void phase_norm_in(const float* xp, const float* xs, const float* gpre, const float* modl, int sidx, bf16* H, int gw, int ngw, int lane) {
    for (int r = gw; r < T; r += ngw) {
        const f32x4* x4 = (const f32x4*)xrow_in(xp, xs, r) + lane;
        f32x4 v[4]; float ss = 0.f;
#pragma unroll
        for (int j = 0; j < 4; ++j) { v[j] = x4[64 * j]; ss += (v[j].x * v[j].x + v[j].y * v[j].y) + (v[j].z * v[j].z + v[j].w * v[j].w); }
        const float rstd = rsqrtf(wave_sum(ss) * (1.f / DM) + EPS);
        const float* mb = modl + (size_t)cond_of(r) * 6144;
        const f32x4* g4 = (const f32x4*)gpre + lane; const f32x4* sh4 = (const f32x4*)(mb + sidx * DM) + lane; const f32x4* sc4 = (const f32x4*)(mb + (sidx + 1) * DM) + lane;
        u32x2* h2 = (u32x2*)(H + (size_t)r * DM) + lane;
#pragma unroll
        for (int j = 0; j < 4; ++j) { const f32x4 g = g4[64 * j], sh = sh4[64 * j], sc = sc4[64 * j]; const f32x4 o = v[j] * rstd * g * (1.f + sc) + sh;
            h2[64 * j] = (u32x2){pk2(o.x, o.y), pk2(o.z, o.w)}; }
    }
}
template <bool NEXT>
__device__ __forceinline__ void phase_post(const bf16* O, const bf16* slab, const float* xp, const float* xs, float* Y, const float* gpost, const float* modl, int gidx,
                                           const float* gpre_n, const float* modn, int sidx_n, bf16* H, int gw, int ngw, int lane) {
    for (int r = gw; r < T; r += ngw) {
        const u32x2* o2 = (const u32x2*)(O + (size_t)r * DM) + lane; const f32x4* x4 = (const f32x4*)xrow_in(xp, xs, r) + lane;
        f32x4 o[4], x[4]; float ss = 0.f;
#pragma unroll
        for (int j = 0; j < 4; ++j) { const u32x2 w = o2[64 * j]; o[j] = (f32x4){bflo(w.x), bfhi(w.x), bflo(w.y), bfhi(w.y)}; x[j] = x4[64 * j]; }
        if (r >= SPLIT_ROW0) {
#pragma unroll
            for (int p = 0; p < 3; ++p) { const u32x2* s2 = (const u32x2*)(slab + (size_t)p * SLAB_ELEMS + (size_t)(r - SPLIT_ROW0) * DM) + lane;
#pragma unroll
                for (int j = 0; j < 4; ++j) { const u32x2 w = s2[64 * j]; o[j] = o[j] + (f32x4){bflo(w.x), bfhi(w.x), bflo(w.y), bfhi(w.y)}; } } }
#pragma unroll
        for (int j = 0; j < 4; ++j) ss += (o[j].x * o[j].x + o[j].y * o[j].y) + (o[j].z * o[j].z + o[j].w * o[j].w);
        const float ro = rsqrtf(wave_sum(ss) * (1.f / DM) + EPS);
        const int cnd = cond_of(r);
        const f32x4* gp4 = (const f32x4*)gpost + lane; const f32x4* gt4 = (const f32x4*)(modl + (size_t)cnd * 6144 + gidx * DM) + lane;
        f32x4* y4 = (f32x4*)(Y + (size_t)r * DM) + lane; float s2 = 0.f;
#pragma unroll
        for (int j = 0; j < 4; ++j) { const f32x4 gp = gp4[64 * j], gt = gt4[64 * j]; x[j] = x[j] + gt * (o[j] * ro * gp); y4[64 * j] = x[j];
            s2 += (x[j].x * x[j].x + x[j].y * x[j].y) + (x[j].z * x[j].z + x[j].w * x[j].w); }
        if (NEXT) {
            const float rx = rsqrtf(wave_sum(s2) * (1.f / DM) + EPS);
            const float* mb = modn + (size_t)cnd * 6144;
            const f32x4* g4 = (const f32x4*)gpre_n + lane; const f32x4* sh4 = (const f32x4*)(mb + sidx_n * DM) + lane; const f32x4* sc4 = (const f32x4*)(mb + (sidx_n + 1) * DM) + lane;
            u32x2* h2 = (u32x2*)(H + (size_t)r * DM) + lane;
#pragma unroll
            for (int j = 0; j < 4; ++j) { const f32x4 g = g4[64 * j], sh = sh4[64 * j], sc = sc4[64 * j]; const f32x4 h = x[j] * rx * g * (1.f + sc) + sh;
                h2[64 * j] = (u32x2){pk2(h.x, h.y), pk2(h.z, h.w)}; }
        }
    }
}

__device__ __forceinline__ void phase_conv(const bf16* U, bf16* MIX, const float* sc_w, const float* dw_w, const float* dw_b, const float* ln_g, const float* ln_b,
                                           LAS unsigned char* lds, int tid, int wave, int lane, int G) {
    LAS bf16* zsb = (LAS bf16*)lds;
    LAS bf16* pbuf = (LAS bf16*)(lds + 62 * 1024);
    LAS bf16* zbuf = (LAS bf16*)(lds + 96 * 1024);
    LAS float* part = (LAS float*)(lds + 129 * 1024);
    LAS float* stat = part + 512;
    const int c = tid, srow = tid >> 6, ch8 = tid & 63;
    float w[31];
#pragma unroll
    for (int j = 0; j < 31; ++j) w[j] = dw_w[j * 512 + c];
    const float bdw = dw_b[c], lg = ln_g[c], lb = ln_b[c];
    float scw[3][8];
#pragma unroll
    for (int j = 0; j < 3; ++j)
#pragma unroll
        for (int k = 0; k < 8; ++k) scw[j][k] = sc_w[j * 512 + 8 * ch8 + k];
    for (int ch = blockIdx.x; ch < T / 32; ch += G) {
        const int r0 = 32 * ch;
        const int sq0 = r0 < TP ? (r0 & ~255) : TP + ((r0 - TP) & ~2047), sq1 = sq0 + (r0 < TP ? 256 : 2048);
        u32x4 bv[8], bg[8], ac[5], ax[5];
        {   const bf16* ub = U + (size_t)(r0 - 15 + srow) * CIN + 8 * ch8;
#pragma unroll
            for (int p = 0; p < 8; ++p) { const int row = srow + 8 * p; const bf16* up = ub + (size_t)(row < 62 ? 8 * p : 0) * CIN; bv[p] = *(const u32x4*)(up + 1536); bg[p] = *(const u32x4*)(up + 2048); }
            const bf16* ua = U + (size_t)(r0 - 1 + srow) * CIN + 8 * ch8;
#pragma unroll
            for (int p = 0; p < 5; ++p) { const int row = srow + 8 * p; const bf16* up = ua + (size_t)(row < 34 ? 8 * p : 0) * CIN; ac[p] = *(const u32x4*)(up + 512); ax[p] = *(const u32x4*)(up + 1024); } }
#pragma unroll
        for (int p = 0; p < 8; ++p) { const int row = srow + 8 * p, rr = r0 - 15 + row; const bool ok = rr >= sq0 && rr < sq1;
            float a[8], g[8]; unpack8(bv[p], a); unpack8(bg[p], g);
#pragma unroll
            for (int k = 0; k < 8; ++k) a[k] = ok ? a[k] * fsigmoid(g[k]) : 0.f;
            if (row < 62) *(LAS u32x4*)(zsb + row * 512 + 8 * ch8) = pack8(a); }
#pragma unroll
        for (int p = 0; p < 5; ++p) { const int row = srow + 8 * p, rr = r0 - 1 + row; const bool ok = rr >= sq0 && rr < sq1;
            float a[8], g[8]; unpack8(ac[p], a); unpack8(ax[p], g);
#pragma unroll
            for (int k = 0; k < 8; ++k) a[k] = ok ? a[k] * g[k] : 0.f;
            if (row < 34) *(LAS u32x4*)(pbuf + row * 512 + 8 * ch8) = pack8(a); }
        __syncthreads();
        u32x4 gb[4];
        {   const bf16* ug = U + (size_t)(r0 + srow) * CIN + 8 * ch8;
#pragma unroll
            for (int p = 0; p < 4; ++p) gb[p] = *(const u32x4*)(ug + (size_t)(8 * p) * CIN); }
        float z1[32];
        {   float z0[62];
#pragma unroll
            for (int j = 0; j < 62; ++j) z0[j] = bf2f(zsb[j * 512 + c]);
#pragma unroll
            for (int t = 0; t < 32; ++t) z1[t] = bdw;
#pragma unroll
            for (int j = 0; j < 31; ++j)
#pragma unroll
                for (int t = 0; t < 32; ++t) z1[t] += w[j] * z0[t + j]; }
        {   float v1[32], v2[32];
#pragma unroll
            for (int t = 0; t < 32; ++t) { v1[t] = z1[t]; v2[t] = z1[t] * z1[t]; }
#pragma unroll
            for (int st = 0; st < 5; ++st) { const int B = 32 >> st, n = 16 >> st; const bool hi = (lane & B) != 0;
#pragma unroll
                for (int i = 0; i < 16; ++i) if (i < n) {
                    const float s1 = hi ? v1[i] : v1[i + n], k1 = hi ? v1[i + n] : v1[i]; v1[i] = k1 + __shfl_xor(s1, B);
                    const float s2 = hi ? v2[i] : v2[i + n], k2 = hi ? v2[i + n] : v2[i]; v2[i] = k2 + __shfl_xor(s2, B); } }
            v1[0] += __shfl_xor(v1[0], 1); v2[0] += __shfl_xor(v2[0], 1);
            if ((lane & 1) == 0) { part[wave * 32 + (lane >> 1)] = v1[0]; part[256 + wave * 32 + (lane >> 1)] = v2[0]; } }
        __syncthreads();
        if (tid < 32) { float a = 0.f, b = 0.f;
#pragma unroll
            for (int q = 0; q < 8; ++q) { a += part[q * 32 + tid]; b += part[256 + q * 32 + tid]; }
            const float mean = a * (1.f / 512.f), var = fmaxf(b * (1.f / 512.f) - mean * mean, 0.f);
            stat[2 * tid] = mean; stat[2 * tid + 1] = rsqrtf(var + EPS); }
        __syncthreads();
#pragma unroll
        for (int t = 0; t < 32; ++t) { const f32x2 ms = *(const LAS f32x2*)(stat + 2 * t); const float y = (z1[t] - ms.x) * ms.y * lg + lb; zbuf[t * 512 + c] = f2bf(fsilu(y)); }
#pragma unroll
        for (int p = 0; p < 4; ++p) { const int t = srow + 8 * p;
            float g[8], p0[8], p1[8], p2[8]; unpack8(gb[p], g);
            unpack8(*(const LAS u32x4*)(pbuf + t * 512 + 8 * ch8), p0); unpack8(*(const LAS u32x4*)(pbuf + (t + 1) * 512 + 8 * ch8), p1); unpack8(*(const LAS u32x4*)(pbuf + (t + 2) * 512 + 8 * ch8), p2);
#pragma unroll
            for (int k = 0; k < 8; ++k) g[k] = g[k] * (scw[0][k] * p0[k] + scw[1][k] * p1[k] + scw[2][k] * p2[k]);
            *(u32x4*)(MIX + (size_t)(r0 + t) * DM + 8 * ch8) = pack8(g); }
        __syncthreads();
#pragma unroll
        for (int p = 0; p < 4; ++p) { const int t = srow + 8 * p; *(u32x4*)(MIX + (size_t)(r0 + t) * DM + 512 + 8 * ch8) = *(const LAS u32x4*)(zbuf + t * 512 + 8 * ch8); }
    }
}

__device__ __forceinline__ void rope_head64(float (&v)[8], int lane, int prow, int pcol, const f32x2* tabg) {
    const int pos = (lane & 4) ? pcol : prow, i0 = 8 * (lane & 1); const bool second = (lane & 2) != 0;
#pragma unroll
    for (int j = 0; j < 8; ++j) { const float pv = __shfl_xor(v[j], 2); const f32x2 cs = tabg[pos * 16 + i0 + j];
        v[j] = second ? v[j] * cs.x + pv * cs.y : v[j] * cs.x - pv * cs.y; }
}
__device__ __forceinline__ void phase_attn_rows(const bf16* U1, const float* qn, const float* kn, const float* qan, const float* kvan, const f32x2* tabg, const f32x2* tabm,
                                                bf16* QC, bf16* KC, bf16* VtC, bf16* QA, bf16* CKV, bf16* KR, float* o_k, float* o_v, float* o_ckv, float* o_kr,
                                                const float* c_k, const float* c_v, const float* c_ckv, const float* c_kr, int gw, int ngw, int lane) {
    for (int r = gw; r < T; r += ngw) {
        const bool smp = r >= TP; const int ts = (r - TP) & 2047, prow = ts >> 6, pcol = ts & 63;
        const int krow = smp ? TP + ((r - TP) >> 11) * KSEQ + PAST + ts : r;
        const bf16* u = U1 + (size_t)r * AINP;
        {
            float v[8]; unpack8(*(const u32x4*)(u + 8 * lane), v);
            float ss = 0.f;
#pragma unroll
            for (int j = 0; j < 8; ++j) ss += v[j] * v[j];
            ss += __shfl_xor(ss, 1); ss += __shfl_xor(ss, 2); ss += __shfl_xor(ss, 4);
            const float rstd = rsqrtf(ss * (1.f / 64.f) + EPS); const int d0 = 8 * (lane & 7);
#pragma unroll
            for (int j = 0; j < 8; ++j) v[j] = v[j] * rstd * qn[d0 + j];
            float vr[8];
#pragma unroll
            for (int j = 0; j < 8; ++j) vr[j] = v[j];
            rope_head64(vr, lane, prow, pcol, tabg);
#pragma unroll
            for (int j = 0; j < 8; ++j) v[j] = smp ? vr[j] : v[j];
            *(u32x4*)(QC + (size_t)r * 512 + 8 * lane) = pack8(v);
        }
        {
            const int l2 = lane & 31; float v[8], raw[8]; unpack8(*(const u32x4*)(u + 512 + 8 * l2), v);
            float ss = 0.f;
#pragma unroll
            for (int j = 0; j < 8; ++j) { raw[j] = v[j]; ss += v[j] * v[j]; }
            ss += __shfl_xor(ss, 1); ss += __shfl_xor(ss, 2); ss += __shfl_xor(ss, 4);
            const float rstd = rsqrtf(ss * (1.f / 64.f) + EPS); const int d0 = 8 * (lane & 7);
#pragma unroll
            for (int j = 0; j < 8; ++j) v[j] = v[j] * rstd * kn[d0 + j];
            if (lane < 16 && !smp) { float* ok = o_k + (size_t)r * 128 + 8 * lane; *(f32x4*)ok = (f32x4){v[0], v[1], v[2], v[3]}; *(f32x4*)(ok + 4) = (f32x4){v[4], v[5], v[6], v[7]}; }
            float vr[8];
#pragma unroll
            for (int j = 0; j < 8; ++j) vr[j] = v[j];
            rope_head64(vr, lane, prow, pcol, tabg);
#pragma unroll
            for (int j = 0; j < 8; ++j) v[j] = smp ? vr[j] : v[j];
            if (lane < 16) *(u32x4*)(KC + (size_t)krow * 128 + 8 * lane) = pack8(v);
            else if (lane < 32) { const int cv = 8 * (lane - 16);
#pragma unroll
                for (int j = 0; j < 8; ++j) VtC[(size_t)(cv + j) * TK + krow] = f2bf(raw[j]);
                if (!smp) { float* ov = o_v + (size_t)r * 128 + cv; *(f32x4*)ov = (f32x4){raw[0], raw[1], raw[2], raw[3]}; *(f32x4*)(ov + 4) = (f32x4){raw[4], raw[5], raw[6], raw[7]}; } }
        }
        {
            const int l3 = lane < 48 ? lane : 0; float v[8]; unpack8(*(const u32x4*)(u + 768 + 8 * l3), v);
            float ss = 0.f;
#pragma unroll
            for (int j = 0; j < 8; ++j) ss += v[j] * v[j];
            ss = wave_sum(lane < 48 ? ss : 0.f);
            const float rstd = rsqrtf(ss * (1.f / 384.f) + EPS);
#pragma unroll
            for (int j = 0; j < 8; ++j) v[j] = v[j] * rstd * qan[8 * l3 + j];
            if (lane < 48) *(u32x4*)(QA + (size_t)r * QL + 8 * lane) = pack8(v);
        }
        {
            const int l2 = lane & 31; float v[8]; unpack8(*(const u32x4*)(u + 1152 + 8 * l2), v);
            float ss = 0.f;
#pragma unroll
            for (int j = 0; j < 8; ++j) ss += v[j] * v[j];
            ss = wave_sum(lane < 32 ? ss : 0.f);
            const float rstd = rsqrtf(ss * (1.f / 256.f) + EPS);
#pragma unroll
            for (int j = 0; j < 8; ++j) v[j] = v[j] * rstd * kvan[8 * l2 + j];
            if (lane < 32) { *(u32x4*)(CKV + (size_t)krow * KVL + 8 * lane) = pack8(v);
                if (!smp) { float* oc = o_ckv + (size_t)r * 256 + 8 * lane; *(f32x4*)oc = (f32x4){v[0], v[1], v[2], v[3]}; *(f32x4*)(oc + 4) = (f32x4){v[4], v[5], v[6], v[7]}; } }
        }
        {
            const int l4 = lane & 3; float v[8]; unpack8(*(const u32x4*)(u + 1408 + 8 * l4), v);
            const int blk = l4 >> 1, pos = blk ? pcol : prow; const bool second = (l4 & 1) != 0;
            if (lane < 4 && !smp) { float* okr = o_kr + (size_t)r * 32 + 8 * lane; *(f32x4*)okr = (f32x4){v[0], v[1], v[2], v[3]}; *(f32x4*)(okr + 4) = (f32x4){v[4], v[5], v[6], v[7]}; }
#pragma unroll
            for (int j = 0; j < 8; ++j) { const float pv = __shfl_xor(v[j], 1); const f32x2 cs = tabm[pos * 8 + j];
                const float rv = second ? v[j] * cs.x + pv * cs.y : v[j] * cs.x - pv * cs.y; v[j] = smp ? rv : v[j]; }
            if (lane < 4) {
#pragma unroll
                for (int j = 0; j < 8; ++j) KR[(size_t)krow * 32 + 16 * blk + 2 * j + (second ? 1 : 0)] = f2bf(v[j]); }
        }
    }
    for (int cr = gw; cr < NBS * PAST; cr += ngw) {
        const int krow = TP + (cr >> 8) * KSEQ + (cr & 255);
        if (lane < 32) { const f32x4 k4 = *(const f32x4*)(c_k + (size_t)cr * 128 + 4 * lane); *(u32x2*)(KC + (size_t)krow * 128 + 4 * lane) = (u32x2){pk2(k4.x, k4.y), pk2(k4.z, k4.w)};
            const f32x4 v4 = *(const f32x4*)(c_v + (size_t)cr * 128 + 4 * lane);
            VtC[(size_t)(4 * lane + 0) * TK + krow] = f2bf(v4.x); VtC[(size_t)(4 * lane + 1) * TK + krow] = f2bf(v4.y);
            VtC[(size_t)(4 * lane + 2) * TK + krow] = f2bf(v4.z); VtC[(size_t)(4 * lane + 3) * TK + krow] = f2bf(v4.w);
            const int e = lane, blk = e >> 4, loc = e & 15; KR[(size_t)krow * 32 + 16 * blk + 2 * (loc & 7) + (loc >> 3)] = f2bf(c_kr[(size_t)cr * 32 + e]); }
        { const f32x4 c4 = *(const f32x4*)(c_ckv + (size_t)cr * 256 + 4 * lane); *(u32x2*)(CKV + (size_t)krow * KVL + 4 * lane) = (u32x2){pk2(c4.x, c4.y), pk2(c4.z, c4.w)}; }
    }
}

#define MFMA32(a, b, c) __builtin_amdgcn_mfma_f32_32x32x16_bf16((a), (b), (c), 0, 0, 0)
template <bool MLA>
__device__ __forceinline__ void attn_unit(LAS unsigned char* lds, const bf16* Q, int ldq, const bf16* K, int ldk, const bf16* KRp, const bf16* Vt, int nkeys, bf16* O, float c,
                                          const f32x2* tabm, int qpos0, int tid, int wave, int lane) {
    constexpr int NQ = MLA ? 6 : 4;
    constexpr int KB_SZ = 64 * 144, KR_OFF = 2 * KB_SZ, KR_SZ = 64 * 80, VT_OFF = KR_OFF + 2 * KR_SZ, VT_SZ = 64 * 136;
    const int r = lane & 31, h = lane >> 5;
    bf16x8 qf[NQ];
    { const bf16* qrow = Q + (size_t)(32 * wave + r) * ldq + 8 * h;
#pragma unroll
      for (int ks = 0; ks < NQ; ++ks) qf[ks] = *(const bf16x8*)(qrow + 16 * ks); }
    if (MLA && qpos0 >= 0) {
        const int ts = qpos0 + 32 * wave + r, prow = ts >> 6, pcol = ts & 63;
#pragma unroll
        for (int blk = 0; blk < 2; ++blk) { const u32x4 w = __builtin_bit_cast(u32x4, qf[NQ - 2 + blk]); float v[8]; unpack8(w, v); const int pos = blk ? pcol : prow;
#pragma unroll
            for (int jj = 0; jj < 4; ++jj) { const f32x2 cs = tabm[pos * 8 + 4 * h + jj]; const float x1 = v[2 * jj], x2 = v[2 * jj + 1]; v[2 * jj] = x1 * cs.x - x2 * cs.y; v[2 * jj + 1] = x2 * cs.x + x1 * cs.y; }
            qf[NQ - 2 + blk] = __builtin_bit_cast(bf16x8, pack8(v)); }
    }
    f32x16 o0, o1;
#pragma unroll
    for (int i = 0; i < 16; ++i) { o0[i] = 0.f; o1[i] = 0.f; }
    float m = -1e30f, l = 0.f;
    const int skey = tid >> 3, sch = tid & 7;
    const bf16* kg = K + (size_t)skey * ldk + 8 * sch;
    const bf16* vg = Vt + (size_t)skey * TK + 8 * sch;
    const bf16* rg = KRp + (size_t)(tid >> 2) * 32 + 8 * (tid & 3);
    const int kw = skey * 144 + sch * 16, vw = skey * 136 + sch * 16, rw = (tid >> 2) * 80 + (tid & 3) * 16;
    const int nt = nkeys >> 6;
    u32x4 kreg = *(const u32x4*)kg, vreg = *(const u32x4*)vg, rreg = (u32x4){0u, 0u, 0u, 0u};
    if (MLA && tid < 256) rreg = *(const u32x4*)rg;
    *(LAS u32x4*)(lds + kw) = kreg;
    *(LAS u32x2*)(lds + VT_OFF + vw) = (u32x2){vreg.x, vreg.y}; *(LAS u32x2*)(lds + VT_OFF + vw + 8) = (u32x2){vreg.z, vreg.w};
    if (MLA && tid < 256) *(LAS u32x4*)(lds + KR_OFF + rw) = rreg;
    __syncthreads();
    for (int j = 0; j < nt; ++j) {
        const int cur = j & 1; const bool more = j + 1 < nt;
        if (more) { kreg = *(const u32x4*)(kg + (size_t)(j + 1) * 64 * ldk); vreg = *(const u32x4*)(vg + (j + 1) * 64);
            if (MLA && tid < 256) rreg = *(const u32x4*)(rg + (size_t)(j + 1) * 64 * 32); }
        const LAS unsigned char* kb = lds + cur * KB_SZ; const LAS unsigned char* rb = lds + KR_OFF + cur * KR_SZ; const LAS unsigned char* vb = lds + VT_OFF + cur * VT_SZ;
        f32x16 p0, p1;
#pragma unroll
        for (int i = 0; i < 16; ++i) { p0[i] = 0.f; p1[i] = 0.f; }
#pragma unroll
        for (int ks = 0; ks < 4; ++ks) { const bf16x8 a0 = *(const LAS bf16x8*)(kb + r * 144 + ks * 32 + h * 16), a1 = *(const LAS bf16x8*)(kb + (32 + r) * 144 + ks * 32 + h * 16);
            p0 = MFMA32(a0, qf[ks], p0); p1 = MFMA32(a1, qf[ks], p1); }
        if (MLA) {
#pragma unroll
            for (int ks = 0; ks < 2; ++ks) { const bf16x8 a0 = *(const LAS bf16x8*)(rb + r * 80 + ks * 32 + h * 16), a1 = *(const LAS bf16x8*)(rb + (32 + r) * 80 + ks * 32 + h * 16);
                p0 = MFMA32(a0, qf[NQ - 2 + ks], p0); p1 = MFMA32(a1, qf[NQ - 2 + ks], p1); } }
        __builtin_amdgcn_sched_barrier(0);
        float mx = p0[0];
#pragma unroll
        for (int i = 1; i < 16; ++i) mx = fmaxf(mx, p0[i]);
#pragma unroll
        for (int i = 0; i < 16; ++i) mx = fmaxf(mx, p1[i]);
        mx = fmaxf(mx, __shfl_xor(mx, 32));
        const float mn = fmaxf(m, mx), alpha = __builtin_amdgcn_exp2f((m - mn) * c), mc = -mn * c; m = mn;
        float ps = 0.f;
#pragma unroll
        for (int i = 0; i < 16; ++i) { p0[i] = __builtin_amdgcn_exp2f(fmaf(p0[i], c, mc)); ps += p0[i]; }
#pragma unroll
        for (int i = 0; i < 16; ++i) { p1[i] = __builtin_amdgcn_exp2f(fmaf(p1[i], c, mc)); ps += p1[i]; }
        l = l * alpha + ps;
#pragma unroll
        for (int i = 0; i < 16; ++i) { o0[i] *= alpha; o1[i] *= alpha; }
        __builtin_amdgcn_sched_barrier(0);
        bf16x8 pb[2][2];
#pragma unroll
        for (int s = 0; s < 2; ++s) {
            u32x4 w0; w0.x = pk2(p0[8 * s + 0], p0[8 * s + 1]); w0.y = pk2(p0[8 * s + 2], p0[8 * s + 3]); w0.z = pk2(p0[8 * s + 4], p0[8 * s + 5]); w0.w = pk2(p0[8 * s + 6], p0[8 * s + 7]);
            u32x4 w1; w1.x = pk2(p1[8 * s + 0], p1[8 * s + 1]); w1.y = pk2(p1[8 * s + 2], p1[8 * s + 3]); w1.z = pk2(p1[8 * s + 4], p1[8 * s + 5]); w1.w = pk2(p1[8 * s + 6], p1[8 * s + 7]);
            pb[0][s] = __builtin_bit_cast(bf16x8, w0); pb[1][s] = __builtin_bit_cast(bf16x8, w1); }
#pragma unroll
        for (int t = 0; t < 2; ++t)
#pragma unroll
            for (int s = 0; s < 2; ++s) { const int ko = (32 * t + 16 * s + 4 * h) * 2;
                { const u32x2 lo = *(const LAS u32x2*)(vb + r * 136 + ko), hi = *(const LAS u32x2*)(vb + r * 136 + ko + 16);
                  o0 = MFMA32(__builtin_bit_cast(bf16x8, ((u32x4){lo.x, lo.y, hi.x, hi.y})), pb[t][s], o0); }
                { const u32x2 lo = *(const LAS u32x2*)(vb + (32 + r) * 136 + ko), hi = *(const LAS u32x2*)(vb + (32 + r) * 136 + ko + 16);
                  o1 = MFMA32(__builtin_bit_cast(bf16x8, ((u32x4){lo.x, lo.y, hi.x, hi.y})), pb[t][s], o1); }
                __builtin_amdgcn_sched_barrier(0); }
        if (more) { const int nx = cur ^ 1;
            *(LAS u32x4*)(lds + nx * KB_SZ + kw) = kreg;
            *(LAS u32x2*)(lds + VT_OFF + nx * VT_SZ + vw) = (u32x2){vreg.x, vreg.y}; *(LAS u32x2*)(lds + VT_OFF + nx * VT_SZ + vw + 8) = (u32x2){vreg.z, vreg.w};
            if (MLA && tid < 256) *(LAS u32x4*)(lds + KR_OFF + nx * KR_SZ + rw) = rreg; }
        __syncthreads();
    }
    l += __shfl_xor(l, 32);
    const float inv = 1.f / l;
    bf16* orow = O + (size_t)(32 * wave + r) * DM;
#pragma unroll
    for (int g = 0; g < 4; ++g) {
        *(u32x2*)(orow + 8 * g + 4 * h) = (u32x2){pk2(o0[4 * g] * inv, o0[4 * g + 1] * inv), pk2(o0[4 * g + 2] * inv, o0[4 * g + 3] * inv)};
        *(u32x2*)(orow + 32 + 8 * g + 4 * h) = (u32x2){pk2(o1[4 * g] * inv, o1[4 * g + 1] * inv), pk2(o1[4 * g + 2] * inv, o1[4 * g + 3] * inv)}; }
}
__device__ __forceinline__ void phase_attention(unsigned char* ws, LAS unsigned char* lds, const f32x2* tabm, int tid, int wave, int lane, int G) {
    const bf16* QC = (const bf16*)(ws + WS_C + C_QC); const bf16* MQ = (const bf16*)(ws + WS_C + C_MQ); const bf16* KN = (const bf16*)(ws + WS_C + C_KN);
    const bf16* VTM = (const bf16*)(ws + WS_C + C_VTM); const bf16* KC = (const bf16*)(ws + WS_A + A_KC); const bf16* VTC = (const bf16*)(ws + WS_A + A_VTC);
    const bf16* KR = (const bf16*)(ws + WS_A + A_KR); bf16* ATT = (bf16*)(ws + WS_B);
    constexpr float C_G = 0.125f * 1.4426950408889634f, C_M = 0.10206207261596577f * 1.4426950408889634f;
    for (int i = blockIdx.x; i < 1280; i += G) {
        bool mla; int row0, key0, nkeys, hh, qpos0;
        if (i < 1024) { mla = i < 512; const int ii = i & 511, b = ii >> 6, qb = ii & 7; hh = (ii >> 3) & 7; row0 = TP + b * SEQS + qb * 256; key0 = TP + b * KSEQ; nkeys = KSEQ; qpos0 = qb * 256; }
        else { mla = i < 1152; const int ii = (i - 1024) & 127, b = ii >> 3; hh = ii & 7; row0 = b * 256; key0 = row0; nkeys = 256; qpos0 = -1; }
        if (mla) attn_unit<true>(lds, MQ + (size_t)row0 * MQD + hh * 96, MQD, KN + (size_t)key0 * 512 + hh * 64, 512, KR + (size_t)key0 * 32, VTM + (size_t)(hh * 64) * TK + key0, nkeys,
                                 ATT + (size_t)row0 * DM + 512 + hh * 64, C_M, tabm, qpos0, tid, wave, lane);
        else attn_unit<false>(lds, QC + (size_t)row0 * 512 + hh * 64, 512, KC + (size_t)key0 * 128 + (hh >> 2) * 64, 128, KR, VTC + (size_t)((hh >> 2) * 64) * TK + key0, nkeys,
                              ATT + (size_t)row0 * DM + hh * 64, C_G, tabm, -1, tid, wave, lane);
    }
}

#define XB_TMO      128
#define XB_XCNT(j)  (256  + 64 * (j))
#define XB_XSUB(j)  (1280 + 64 * (j))
#define XB_XGEN(j)  (2304 + 64 * (j))
#define XB_TOP      3328
#define XB_TOPGEN   3392
#define XCD_BAR_WORDS 3456
#define XB_SPIN_CAP (1u << 18)

__device__ __forceinline__ unsigned xb_ld(unsigned* p)              { return __hip_atomic_load(p, __ATOMIC_RELAXED, __HIP_MEMORY_SCOPE_AGENT); }
__device__ __forceinline__ unsigned xb_add(unsigned* p, unsigned v) { return __hip_atomic_fetch_add(p, v, __ATOMIC_RELAXED, __HIP_MEMORY_SCOPE_AGENT); }
__device__ __forceinline__ unsigned xb_xcc_id() { return (unsigned)__builtin_amdgcn_s_getreg((3 << 11) | 20) & 0xFu; }
#define XB_SPIN(cond, bar) do { unsigned _sp = 0; while (cond) { __builtin_amdgcn_s_sleep(1); \
    if ((++_sp & 255u) == 0u) { if (xb_ld(&(bar)[XB_TMO])) break; if (_sp > XB_SPIN_CAP) { atomicAdd(&(bar)[XB_TMO], 1u); break; } } } } while (0)

struct XcdBarrier {
    unsigned* bar; unsigned x;
    volatile LAS unsigned* st;
};

__device__ __forceinline__ XcdBarrier xcd_barrier_post(unsigned* bar, volatile LAS unsigned* st) {
    XcdBarrier b; b.bar = bar; b.x = xb_xcc_id(); b.st = st;
    if (threadIdx.x == 0) (void)xb_add(&bar[XB_XCNT(b.x)], 1u);
    return b;
}
__device__ __forceinline__ void xcd_barrier_complete(unsigned* bar, unsigned x, unsigned& nloc, unsigned& nx) {
    const unsigned G = gridDim.x * gridDim.y * gridDim.z;
    unsigned sum, cnt, mine, sp = 0u;
    for (;;) {
        sum = 0u; cnt = 0u; mine = 0u;
#pragma unroll
        for (unsigned j = 0; j < 16; ++j) { const unsigned c = xb_ld(&bar[XB_XCNT(j)]); sum += c; cnt += (c > 0u) ? 1u : 0u; mine = (j == x) ? c : mine; }
        if (sum == G) break;
        __builtin_amdgcn_s_sleep(1);
        if ((++sp & 255u) == 0u) { if (xb_ld(&bar[XB_TMO])) break; if (sp > XB_SPIN_CAP) { atomicAdd(&bar[XB_TMO], 1u); break; } }
    }
    nloc = mine > 0u ? mine : 1u; nx = cnt > 0u ? cnt : 1u;
}

__device__ __forceinline__ void xcd_barrier(const XcdBarrier& b) {
    asm volatile("s_waitcnt vmcnt(0)" ::: "memory");
    __syncthreads();
    if (threadIdx.x == 0) {
        unsigned* bar = b.bar;
        __builtin_amdgcn_s_waitcnt(0);
        unsigned nloc = b.st[0], nx = b.st[1];
        if (nloc == 0u) { xcd_barrier_complete(bar, b.x, nloc, nx); b.st[0] = nloc; b.st[1] = nx; }
        const unsigned old = xb_add(&bar[XB_XSUB(b.x)], 1u);
        const unsigned gen = old / nloc;
        if (old + 1u == (gen + 1u) * nloc) {
            __builtin_amdgcn_fence(__ATOMIC_RELEASE, "agent");
            asm volatile("s_waitcnt vmcnt(0)" ::: "memory");
            const unsigned og = xb_add(&bar[XB_TOP], 1u);
            const unsigned tg = og / nx;
            if (og + 1u == (tg + 1u) * nx) xb_add(&bar[XB_TOPGEN], 1u);
            else XB_SPIN(xb_ld(&bar[XB_TOPGEN]) == tg, bar);
            __builtin_amdgcn_fence(__ATOMIC_ACQUIRE, "agent");
            xb_add(&bar[XB_XGEN(b.x)], 1u);
            asm volatile("s_waitcnt vmcnt(0)" ::: "memory");
        } else {
            XB_SPIN(xb_ld(&bar[XB_XGEN(b.x)]) == gen, bar);
            __builtin_amdgcn_fence(__ATOMIC_ACQUIRE, "agent");
            asm volatile("s_waitcnt vmcnt(0)" ::: "memory");
        }
    }
    __syncthreads();
}

struct Args { const float* in[32]; float* out; unsigned char* ws; int ph_lo, ph_hi; };
constexpr int NPHASE = 18;

struct FullOrder {
    pg8::StaticOrder S; int nt;
    __device__ __forceinline__ void init(int M, int N, int K, int G, int c) { S.init(M, N, G, c); nt = K / 64; }
    __device__ __forceinline__ bool next(int i, pg8::Unit& u) const { if (!S.next(i, u)) return false; u.koff = 0; u.nt = nt; u.part = 0; return true; }
    __device__ __forceinline__ void a_ready(const pg8::Unit&) const {}
    __device__ __forceinline__ void done(const pg8::Unit&) const {}
};
struct SplitTailOrder {
    int c, K;
    __device__ __forceinline__ bool next(int i, pg8::Unit& u) const {
        if (i == 0) { const int x = c & 7, slot = c >> 3; u.pm = x * 8 + (slot >> 2); u.pn = slot & 3; u.koff = 0; u.nt = K / 64; u.part = 0; return true; }
        if (i == 1) { u.pm = 64 + (c >> 4); u.pn = (c >> 2) & 3; u.part = c & 3;
            if (K == 1024) { u.koff = 256 * u.part; u.nt = 4; } else { u.koff = 64 * (u.part < 2 ? 12 * u.part : 24 + 10 * (u.part - 2)); u.nt = u.part < 2 ? 12 : 10; }
            return true; }
        return false;
    }
    __device__ __forceinline__ void a_ready(const pg8::Unit&) const {}
    __device__ __forceinline__ void done(const pg8::Unit&) const {}
};
template <class Epi>
__device__ __forceinline__ void run_gemm(LAS unsigned char* lds, const bf16* A, const bf16* Bt, int M, int N, int K, int G, int cid, const Epi& E) {
    pg8::Gemm g{A, Bt, M, N, K}; FullOrder S; S.init(M, N, K, G, cid);
    pg8::gemm_phase<Epi, FullOrder, true, true>(lds, g, S, E);
}
template <class Epi>
__device__ __forceinline__ void run_gemm_split(LAS unsigned char* lds, const bf16* A, const bf16* Bt, int K, int cid, const Epi& E) {
    pg8::Gemm g{A, Bt, T, 1024, K}; SplitTailOrder S{cid, K};
    pg8::gemm_phase<Epi, SplitTailOrder, true, true>(lds, g, S, E);
}

__global__ void __launch_bounds__(NTHR, 2) fwd_kernel(Args args) {
    extern __shared__ __attribute__((aligned(16))) unsigned char lds_raw[];
    LAS unsigned char* lds = (LAS unsigned char*)lds_raw;
#if MK_CG_SYNC
    cg::grid_group grid = cg::this_grid();
#endif
    const int tid = threadIdx.x, lane = tid & 63, wave = __builtin_amdgcn_readfirstlane(tid >> 6);
    const int G = gridDim.x, bid = blockIdx.x, gw = bid * NWAVES + wave, ngw = G * NWAVES;
    unsigned char* ws = args.ws; const float* const* in = args.in; float* out = args.out;
    const int lo = args.ph_lo, hi = args.ph_hi;
#ifndef REP_PHASE
#define REP_PHASE (-1)
#define REP_N 1
#endif
#define PH(k) if (IN(k)) for (int rp_ = 0; rp_ < ((k) == REP_PHASE ? REP_N : 1); ++rp_)
#ifndef PH_MASK
#define PH_MASK 0x3ffff
#endif
#define IN(k) (((PH_MASK >> (k)) & 1) && lo <= (k) && (k) < hi)
#if MK_CG_SYNC
#define SEAM(k) do { if (IN(k) && IN((k) + 1)) grid.sync(); } while (0)
#else
    if (tid < 2) ((volatile LAS unsigned*)(lds + 131072))[tid] = 0u;
    __syncthreads();
    const XcdBarrier bar = xcd_barrier_post((unsigned*)(args.ws + WS_CTL), (volatile LAS unsigned*)(lds + 131072));
#define SEAM(k) do { if (IN(k) && IN((k) + 1)) xcd_barrier(bar); } while (0)
#endif
    bf16* H = (bf16*)(ws + WS_A); bf16* OB = (bf16*)(ws + WS_A); bf16* MIX = (bf16*)(ws + WS_B); bf16* ATT = (bf16*)(ws + WS_B);
    bf16* U = (bf16*)(ws + WS_C); bf16* ACT = (bf16*)(ws + WS_C);
    bf16* SLABB = (bf16*)(ws + WS_B); bf16* SLABC = (bf16*)(ws + WS_C);
    const float* MOD0 = (const float*)(ws + WS_MOD); const float* MOD1 = MOD0 + 9 * 6144;
    const f32x2* tabg = (const f32x2*)(ws + WS_TABG); const f32x2* tabm = (const f32x2*)(ws + WS_TABM);
    float* Y = out + OUT_Y;

    PH(0) {
        p0_adaln(in, ws, lds, tid, wave, lane, G);
        if (bid == G - 1) p0_tables(in, ws, tid);
        p0_weights(in, ws, (LAS float*)(lds + 57344 + wave * 8448), gw, ngw, lane);
    }
    SEAM(0);
    PH(1) phase_norm_in(in[0], in[1], in[10] + 0 * DM, MOD0, 0, H, gw, ngw, lane);
    SEAM(1);
    PH(2) run_gemm(lds, H, (const bf16*)(ws + WS_WCIN), T, CIN, 1024, G, bid, EpiStore{U, CIN, (const float*)(ws + WS_BCIN), nullptr});
    SEAM(2);
    PH(3) phase_conv(U, MIX, in[13], in[15], in[16], in[17], in[18], lds, tid, wave, lane, G);
    SEAM(3);
    PH(4) run_gemm_split(lds, MIX, (const bf16*)(ws + WS_WCOUT), 1024, bid, EpiStore{OB, DM, in[20], SLABC});
    SEAM(4);
    PH(5) phase_post<true>(OB, SLABC, in[0], in[1], Y, in[11] + 0 * DM, MOD0, 2, in[10] + 1 * DM, MOD0, 3, H, gw, ngw, lane);
    SEAM(5);
    PH(6) run_gemm(lds, H, (const bf16*)(ws + WS_WGU0), T, 2 * FFN, 1024, G, bid, EpiSwiGLU{ACT});
    SEAM(6);
    PH(7) run_gemm_split(lds, ACT, (const bf16*)(ws + WS_WD0), FFN, bid, EpiStore{OB, DM, nullptr, SLABB});
    SEAM(7);
    PH(8) phase_post<true>(OB, SLABB, Y, Y + (size_t)TP * DM, Y, in[11] + 1 * DM, MOD0, 5, in[10] + 2 * DM, MOD1, 0, H, gw, ngw, lane);
    SEAM(8);
    PH(9) run_gemm(lds, H, (const bf16*)(ws + WS_WAIN), T, AINP, 1024, G, bid, EpiStore{(bf16*)(ws + WS_C + C_U1), AINP, nullptr, nullptr});
    SEAM(9);
    PH(10) phase_attn_rows((const bf16*)(ws + WS_C + C_U1), in[22], in[23], in[24], in[26], tabg, tabm,
                                (bf16*)(ws + WS_C + C_QC), (bf16*)(ws + WS_A + A_KC), (bf16*)(ws + WS_A + A_VTC), (bf16*)(ws + WS_A + A_QA), (bf16*)(ws + WS_A + A_CKV), (bf16*)(ws + WS_A + A_KR),
                                out + OUT_K, out + OUT_V, out + OUT_CKV, out + OUT_KR, in[2], in[3], in[4], in[5], gw, ngw, lane);
    SEAM(10);
    PH(11) {
        run_gemm(lds, (const bf16*)(ws + WS_A + A_QA), (const bf16*)(ws + WS_WQB), T, MQD, QL, G, bid, EpiStore{(bf16*)(ws + WS_C + C_MQ), MQD, nullptr, nullptr});
        run_gemm(lds, (const bf16*)(ws + WS_A + A_CKV), (const bf16*)(ws + WS_WKN), TK, 512, KVL, G, (bid + 240) % G, EpiStore{(bf16*)(ws + WS_C + C_KN), 512, nullptr, nullptr});
        run_gemm(lds, (const bf16*)(ws + WS_WVT), (const bf16*)(ws + WS_A + A_CKV), 512, TK, KVL, G, (bid + 160) % G, EpiStore{(bf16*)(ws + WS_C + C_VTM), TK, nullptr, nullptr});
    }
    SEAM(11);
    PH(12) phase_attention(ws, lds, tabm, tid, wave, lane, G);
    SEAM(12);
    PH(13) run_gemm_split(lds, ATT, (const bf16*)(ws + WS_WAOUT), 1024, bid, EpiStore{OB, DM, nullptr, SLABC});
    SEAM(13);
    PH(14) phase_post<true>(OB, SLABC, Y, Y + (size_t)TP * DM, Y, in[11] + 2 * DM, MOD1, 2, in[10] + 3 * DM, MOD1, 3, H, gw, ngw, lane);
    SEAM(14);
    PH(15) run_gemm(lds, H, (const bf16*)(ws + WS_WGU1), T, 2 * FFN, 1024, G, bid, EpiSwiGLU{ACT});
    SEAM(15);
    PH(16) run_gemm_split(lds, ACT, (const bf16*)(ws + WS_WD1), FFN, bid, EpiStore{OB, DM, nullptr, SLABB});
    SEAM(16);
    PH(17) phase_post<false>(OB, SLABB, Y, Y + (size_t)TP * DM, Y, in[11] + 3 * DM, MOD1, 5, nullptr, nullptr, 0, nullptr, gw, ngw, lane);
#undef IN
#undef SEAM
}

#ifndef MK_ONE_LAUNCH
#define MK_ONE_LAUNCH 1
#endif
extern "C" void kernel_launch(void* const* d_in, const int* in_sizes, int n_in, void* d_out, int out_size, void* d_ws, size_t ws_size, hipStream_t stream) {
    static int grid = 0;
    if (grid == 0) {
        if (n_in != 32 || ws_size < WS_END) { fprintf(stderr, "kernel_launch: unexpected inputs (n_in %d, ws %zu)\n", n_in, ws_size); grid = -1; return; }
        int dev = 0, cus = 0, per_cu = 0;
        (void)hipGetDevice(&dev); (void)hipDeviceGetAttribute(&cus, hipDeviceAttributeMultiprocessorCount, dev);
        if (hipFuncSetAttribute((const void*)fwd_kernel, hipFuncAttributeMaxDynamicSharedMemorySize, LDS_BYTES) != hipSuccess) { fprintf(stderr, "kernel_launch: hipFuncSetAttribute failed\n"); grid = -1; return; }
        if (hipOccupancyMaxActiveBlocksPerMultiprocessor(&per_cu, (const void*)fwd_kernel, NTHR, LDS_BYTES) != hipSuccess || per_cu < 1) { fprintf(stderr, "kernel_launch: occupancy query says %d\n", per_cu); per_cu = 1; }
        (void)hipGetLastError();
        if (cus != 256) { fprintf(stderr, "kernel_launch: built for a 256-CU device (one workgroup per CU), found %d CUs; nothing launched\n", cus); grid = -1; return; }
        grid = cus;
    }
    if (grid < 0) return;
    Args a{};
    for (int i = 0; i < 32; ++i) a.in[i] = (const float*)d_in[i];
    a.out = (float*)d_out; a.ws = (unsigned char*)d_ws;
#if MK_ONE_LAUNCH && MK_CG_SYNC
    a.ph_lo = 0; a.ph_hi = NPHASE;
    void* kargs[] = {&a};
    hipError_t e = hipLaunchCooperativeKernel((const void*)fwd_kernel, dim3(grid), dim3(NTHR), kargs, LDS_BYTES, stream);
    if (e != hipSuccess) fprintf(stderr, "kernel_launch: cooperative launch failed: %s (grid %d)\n", hipGetErrorString(e), grid);
#elif MK_ONE_LAUNCH
    if (hipMemsetAsync((char*)d_ws + WS_CTL, 0, 16384, stream) != hipSuccess) { fprintf(stderr, "kernel_launch: memset failed\n"); return; }
    a.ph_lo = 0; a.ph_hi = NPHASE;
    hipLaunchKernelGGL(fwd_kernel, dim3(grid), dim3(NTHR), LDS_BYTES, stream, a);
#else
    for (int p = 0; p < NPHASE; ++p) { a.ph_lo = p; a.ph_hi = p + 1; hipLaunchKernelGGL(fwd_kernel, dim3(grid), dim3(NTHR), LDS_BYTES, stream, a); }
#endif
}
```

```cpp
#include <hip/hip_runtime.h>
#include <hip/hip_cooperative_groups.h>
#include <cstdio>
#include <cstdint>
namespace cg = cooperative_groups;
#ifndef MK_CG_SYNC
#define MK_CG_SYNC 0
#endif
namespace pg8 {
#define PG8_LAS __attribute__((address_space(3)))
typedef unsigned short bf16_t;
typedef short bf16x8 __attribute__((ext_vector_type(8)));
typedef float f32x4 __attribute__((ext_vector_type(4)));
typedef unsigned u32x4 __attribute__((ext_vector_type(4)));
constexpr int BM = 256, BK = 64, HALF = 128, HTB = HALF * BK * 2  , STAGE_BYTES = 8 * HTB, NXCD = 8, WGM = 4;

__host__ __device__ __forceinline__ int lds_byte(int r, int c) { const int st = (r >> 4) * 2 + (c >> 5), rr = r & 15, cc = c & 31, ob = rr * 64 + cc * 2; return st * 1024 + (ob ^ (((ob >> 9) & 1) << 5)); }
__host__ __device__ __forceinline__ void stage_rc(int b, int& R, int& C) { const int st = b / 1024, sb = b % 1024, swz = sb ^ (((sb >> 9) & 1) << 5); R = (st >> 1) * 16 + swz / 64; C = (st & 1) * 32 + (swz % 64) / 2; }
__host__ __device__ __forceinline__ int perm32(int rho) { const int n = rho >> 4, i = rho & 15; return 8 * (i >> 2) + 4 * n + (i & 3); }

struct Unit { int pm, pn, koff, nt, part; };
struct Gemm { const bf16_t* A; const bf16_t* Bt; int M, N, K; };

struct StaticOrder {
    int nM, nN, nwg, G, c;
    __host__ __device__ void init(int M, int N, int G_, int c_) { nM = M / BM; nN = N / BM; nwg = nM * nN; G = G_; c = c_; }
    __host__ __device__ bool next(int i, Unit& u) const {
        const long L = (long)i * G + c; if (L >= nwg) return false;
        int wgid = (int)L; { const int q = nwg / NXCD, r = nwg % NXCD, xcd = wgid % NXCD, off = wgid / NXCD; wgid = (xcd < r ? xcd * (q + 1) : r * (q + 1) + (xcd - r) * q) + off; }
        const int nig = WGM * nN, gid = wgid / nig, fm = gid * WGM, gsz = (nM - fm) < WGM ? (nM - fm) : WGM;
        u.pm = fm + ((wgid % nig) % gsz); u.pn = (wgid % nig) / gsz; return true;
    }
    __device__ __forceinline__ void a_ready(const Unit&) const {}
    __device__ __forceinline__ void done(const Unit&) const {}
};

__device__ __forceinline__ unsigned cvt_pk_bf16(float lo, float hi) { unsigned r; asm volatile("v_cvt_pk_bf16_f32 %0, %1, %2" : "=v"(r) : "v"(lo), "v"(hi)); return r; }
template <class Epi, class Sched, bool ALIGN_EPI = false, bool SP2 = false>
__device__ __forceinline__ void gemm_phase(PG8_LAS unsigned char* lds, const Gemm g, const Sched& S, const Epi& E) {
    const int tid = threadIdx.x, wid = __builtin_amdgcn_readfirstlane(tid >> 6), lane = tid & 63, wr = wid >> 2, wc = wid & 3, fr = lane & 15, fq = lane >> 4;
    const int K = g.K;
    unsigned voffA[2], voffB[2];
#pragma unroll
    for (int i = 0; i < 2; ++i) { int R, C; stage_rc(tid * 16 + i * 8192, R, C); const int Rb = Epi::PERM ? ((R & ~31) + perm32(R & 31)) : R;
        voffA[i] = (unsigned)(R * K + C) * 2u; voffB[i] = (unsigned)(Rb * K + C) * 2u; }
    const size_t kstep = (size_t)(BK * 2);
    const size_t hstep = (size_t)HALF * K * 2;
    const size_t tstep = 2 * hstep;
    const unsigned ldsw = (unsigned)wid * 1024u;
    const int aoff = lds_byte(wr * 64 + fr, fq * 8), boff = lds_byte(wc * 32 + fr, fq * 8);
#define PG8_SA(b, h) (((b) * 2 + (h)) * HTB)
#define PG8_SB(b, h) ((4 + (b) * 2 + (h)) * HTB)
#define PG8_STAGE(bufoff, gbase, voff) do { _Pragma("unroll") for (int _i = 0; _i < 2; ++_i) \
        __builtin_amdgcn_global_load_lds((const unsigned*)((const char*)(gbase) + (voff)[_i]), (PG8_LAS unsigned*)(lds + (bufoff) + ldsw + _i * 8192), 16, 0, 0); } while (0)
#define PG8_LDA(dst, b, h) do { _Pragma("unroll") for (int m = 0; m < 4; ++m) _Pragma("unroll") for (int k = 0; k < 2; ++k) dst[m][k] = *(const PG8_LAS bf16x8*)(lds + PG8_SA(b, h) + aoff + m * 2048 + k * 1024); } while (0)
#define PG8_LDB(dst, b, h) do { _Pragma("unroll") for (int n = 0; n < 2; ++n) _Pragma("unroll") for (int k = 0; k < 2; ++k) dst[n][k] = *(const PG8_LAS bf16x8*)(lds + PG8_SB(b, h) + boff + n * 2048 + k * 1024); } while (0)
#define PG8_MMA(ai, bj, At, Bt) do { __builtin_amdgcn_s_setprio(1); _Pragma("unroll") for (int m = 0; m < 4; ++m) _Pragma("unroll") for (int n = 0; n < 2; ++n) _Pragma("unroll") for (int k = 0; k < 2; ++k) \
        acc[ai][bj][m][n] = __builtin_amdgcn_mfma_f32_16x16x32_bf16(Bt[n][k], At[m][k], acc[ai][bj][m][n], 0, 0, 0); __builtin_amdgcn_s_setprio(0); } while (0)
#define PG8_WAIT_V(n) asm volatile("s_waitcnt vmcnt(" #n ")" ::: "memory")
#define PG8_WAIT_L(n) asm volatile("s_waitcnt lgkmcnt(" #n ")" ::: "memory")
#define PG8_BAR __builtin_amdgcn_s_barrier()
#define PG8_SCHED __builtin_amdgcn_sched_barrier(0)
    Unit cur, nxt; int ui = 0;
    if (!S.next(0, cur)) return;
    int nt = cur.nt;
    f32x4 acc[2][2][4][2];
#pragma unroll
    for (int a = 0; a < 2; ++a)
#pragma unroll
        for (int b = 0; b < 2; ++b)
#pragma unroll
            for (int m = 0; m < 4; ++m)
#pragma unroll
                for (int n = 0; n < 2; ++n) acc[a][b][m][n] = (f32x4){0.f, 0.f, 0.f, 0.f};
    bf16x8 At[4][2], B0[2][2], B1[2][2];
    const char* cA = (const char*)g.A + (size_t)cur.pm * tstep + (size_t)cur.koff * 2; const char* cB = (const char*)g.Bt + (size_t)cur.pn * tstep + (size_t)cur.koff * 2;
    S.a_ready(cur);
    if constexpr (SP2) {
        PG8_STAGE(PG8_SB(0, 0), cB, voffB); PG8_STAGE(PG8_SB(0, 1), cB + hstep, voffB); PG8_STAGE(PG8_SA(0, 0), cA, voffA); PG8_STAGE(PG8_SA(0, 1), cA + hstep, voffA);
        if (wr == 1) PG8_BAR;
        PG8_WAIT_V(2); PG8_BAR;
        PG8_STAGE(PG8_SB(1, 0), cB + kstep, voffB); PG8_STAGE(PG8_SA(1, 0), cA + kstep, voffA); PG8_STAGE(PG8_SB(1, 1), cB + hstep + kstep, voffB);
        PG8_WAIT_V(6); PG8_BAR;
    } else {
        PG8_STAGE(PG8_SB(0, 0), cB, voffB); PG8_STAGE(PG8_SA(0, 0), cA, voffA); PG8_STAGE(PG8_SB(0, 1), cB + hstep, voffB); PG8_STAGE(PG8_SA(0, 1), cA + hstep, voffA);
        if (wr == 1) PG8_BAR;
        PG8_WAIT_V(4); PG8_BAR;
        PG8_STAGE(PG8_SB(1, 0), cB + kstep, voffB); PG8_STAGE(PG8_SA(1, 0), cA + kstep, voffA); PG8_STAGE(PG8_SB(1, 1), cB + hstep + kstep, voffB);
        PG8_WAIT_V(6); PG8_BAR;
    }
    for (;;) {
        const bool has_next = S.next(ui + 1, nxt);
        const char* nA = has_next ? (const char*)g.A + (size_t)nxt.pm * tstep + (size_t)nxt.koff * 2 : cA; const char* nB = has_next ? (const char*)g.Bt + (size_t)nxt.pn * tstep + (size_t)nxt.koff * 2 : cB;
        for (int t = 0; t < nt; t += 2) {
            const bool last = (t == nt - 2);
            const char* a1 = cA + (size_t)(t + 1) * kstep;
            const char* a2 = last ? nA : cA + (size_t)(t + 2) * kstep; const char* b2 = last ? nB : cB + (size_t)(t + 2) * kstep;
            const char* a3 = a2 + kstep; const char* b3 = b2 + kstep;
            if (last && has_next) S.a_ready(nxt);
            if constexpr (SP2) {
            PG8_LDB(B0, 0, 0); PG8_LDB(B1, 0, 1); PG8_SCHED; PG8_LDA(At, 0, 0); PG8_STAGE(PG8_SA(1, 1), a1 + hstep, voffA);
            PG8_WAIT_V(8); PG8_WAIT_L(0); PG8_BAR; PG8_MMA(0, 0, At, B0); PG8_MMA(0, 1, At, B1); PG8_BAR; PG8_SCHED;
            PG8_LDA(At, 0, 1); PG8_STAGE(PG8_SB(0, 0), b2, voffB); PG8_STAGE(PG8_SB(0, 1), b2 + hstep, voffB); PG8_STAGE(PG8_SA(0, 0), a2, voffA);
            PG8_WAIT_V(8); PG8_WAIT_L(0); PG8_BAR; PG8_MMA(1, 0, At, B0); PG8_MMA(1, 1, At, B1); PG8_BAR; PG8_SCHED;
            PG8_LDB(B0, 1, 0); PG8_LDB(B1, 1, 1); PG8_SCHED; PG8_LDA(At, 1, 0); PG8_STAGE(PG8_SA(0, 1), a2 + hstep, voffA);
            PG8_WAIT_V(8); PG8_WAIT_L(0); PG8_BAR; PG8_MMA(0, 0, At, B0); PG8_MMA(0, 1, At, B1); PG8_BAR; PG8_SCHED;
            PG8_LDA(At, 1, 1); PG8_STAGE(PG8_SB(1, 0), b3, voffB); PG8_STAGE(PG8_SB(1, 1), b3 + hstep, voffB); PG8_STAGE(PG8_SA(1, 0), a3, voffA);
            PG8_WAIT_V(8); PG8_WAIT_L(0); PG8_BAR; PG8_MMA(1, 0, At, B0); PG8_MMA(1, 1, At, B1); PG8_BAR; PG8_SCHED;
            } else {
            PG8_LDB(B0, 0, 0); PG8_SCHED; PG8_LDA(At, 0, 0); PG8_STAGE(PG8_SA(1, 1), a1 + hstep, voffA);
            PG8_WAIT_L(8); PG8_BAR; PG8_WAIT_L(0); PG8_MMA(0, 0, At, B0); PG8_BAR; PG8_SCHED;
            PG8_LDB(B1, 0, 1); PG8_STAGE(PG8_SB(0, 0), b2, voffB);
            PG8_BAR; PG8_WAIT_L(0); PG8_MMA(0, 1, At, B1); PG8_BAR;
            PG8_LDA(At, 0, 1); PG8_STAGE(PG8_SA(0, 0), a2, voffA);
            PG8_BAR; PG8_WAIT_L(0); PG8_MMA(1, 0, At, B0); PG8_BAR; PG8_SCHED;
            PG8_STAGE(PG8_SB(0, 1), b2 + hstep, voffB);
            PG8_WAIT_V(6); PG8_BAR; PG8_MMA(1, 1, At, B1); PG8_BAR;
            PG8_LDB(B0, 1, 0); PG8_SCHED; PG8_LDA(At, 1, 0); PG8_STAGE(PG8_SA(0, 1), a2 + hstep, voffA);
            PG8_WAIT_L(8); PG8_BAR; PG8_WAIT_L(0); PG8_MMA(0, 0, At, B0); PG8_BAR; PG8_SCHED;
            PG8_LDB(B1, 1, 1); PG8_STAGE(PG8_SB(1, 0), b3, voffB);
            PG8_BAR; PG8_WAIT_L(0); PG8_MMA(0, 1, At, B1); PG8_BAR;
            PG8_LDA(At, 1, 1); PG8_STAGE(PG8_SA(1, 0), a3, voffA);
            PG8_BAR; PG8_WAIT_L(0); PG8_MMA(1, 0, At, B0); PG8_BAR; PG8_SCHED;
            PG8_STAGE(PG8_SB(1, 1), b3 + hstep, voffB);
            PG8_WAIT_V(6); PG8_BAR; PG8_MMA(1, 1, At, B1); PG8_BAR;
            }
        }
        if constexpr (ALIGN_EPI) { if (wr == 0) PG8_BAR; }
        if constexpr (!Epi::AFTER_DRAIN) { E(acc, cur, wr, wc, fr, fq); S.done(cur); }
        if (!has_next) break;
#pragma unroll
        for (int a = 0; a < 2; ++a)
#pragma unroll
            for (int b = 0; b < 2; ++b)
#pragma unroll
                for (int m = 0; m < 4; ++m)
#pragma unroll
                    for (int n = 0; n < 2; ++n) acc[a][b][m][n] = (f32x4){0.f, 0.f, 0.f, 0.f};
        cur = nxt; cA = nA; cB = nB; nt = cur.nt; ++ui;
        if constexpr (ALIGN_EPI) { if (wr == 1) PG8_BAR; }
    }
    PG8_WAIT_V(0);
    if constexpr (!ALIGN_EPI) { if (wr == 0) PG8_BAR; }
    PG8_BAR;
    if constexpr (Epi::AFTER_DRAIN) { E.fused(acc, cur, wr, wc, fr, fq, lds, wid, lane); S.done(cur); }
#undef PG8_SA
#undef PG8_SB
#undef PG8_STAGE
#undef PG8_LDA
#undef PG8_LDB
#undef PG8_MMA
#undef PG8_WAIT_V
#undef PG8_WAIT_L
#undef PG8_BAR
#undef PG8_SCHED
}
}

#define LAS __attribute__((address_space(3)))
typedef unsigned short bf16;
typedef float f32x4 __attribute__((ext_vector_type(4)));
typedef float f32x2 __attribute__((ext_vector_type(2)));
typedef float f32x16 __attribute__((ext_vector_type(16)));
typedef short bf16x8 __attribute__((ext_vector_type(8)));
typedef unsigned u32x4 __attribute__((ext_vector_type(4)));
typedef unsigned u32x2 __attribute__((ext_vector_type(2)));

constexpr int DM = 1024, TP = 4096, TS = 16384, T = TP + TS, SEQS = 2048, NBS = 8, PAST = 256;
constexpr int KSEQ = PAST + SEQS;
constexpr int TK = TP + NBS * KSEQ;
constexpr int FFN = 2816, CIN = 2560, CU2 = 1536, AIN = 1440, AINP = 1536, QL = 384, KVL = 256, MQD = 768;
constexpr float EPS = 1e-6f;
constexpr int NWAVES = 8, NTHR = 512;
constexpr int LDS_BYTES = 147456;
constexpr int SPLIT_ROW0 = 16384;
constexpr size_t SLAB_ELEMS = (size_t)(T - SPLIT_ROW0) * DM;

constexpr size_t MiB = (size_t)1 << 20;
constexpr size_t al256(size_t x) { return (x + 255) & ~(size_t)255; }
constexpr size_t WS_CTL = 0;
constexpr size_t WS_MOD = 1 * MiB;
constexpr size_t WS_TABG = WS_MOD + al256((size_t)2 * 9 * 6144 * 4);
constexpr size_t WS_TABM = WS_TABG + al256(64 * 16 * 8);
constexpr size_t WS_BCIN = WS_TABM + al256(64 * 8 * 8);
constexpr size_t WS_WCIN = 2 * MiB;
constexpr size_t WS_WCOUT = WS_WCIN + (size_t)2560 * 1024 * 2;
constexpr size_t WS_WGU0 = WS_WCOUT + (size_t)1024 * 1024 * 2;
constexpr size_t WS_WD0 = WS_WGU0 + (size_t)5632 * 1024 * 2;
constexpr size_t WS_WGU1 = WS_WD0 + (size_t)1024 * 2816 * 2;
constexpr size_t WS_WD1 = WS_WGU1 + (size_t)5632 * 1024 * 2;
constexpr size_t WS_WAIN = WS_WD1 + (size_t)1024 * 2816 * 2;
constexpr size_t WS_WQB = WS_WAIN + (size_t)1536 * 1024 * 2;
constexpr size_t WS_WKN = WS_WQB + (size_t)768 * 384 * 2;
constexpr size_t WS_WVT = WS_WKN + (size_t)512 * 256 * 2;
constexpr size_t WS_WAOUT = WS_WVT + (size_t)512 * 256 * 2;
constexpr size_t WS_WEND = WS_WAOUT + (size_t)1024 * 1024 * 2;
constexpr size_t WS_A = 50 * MiB;
constexpr size_t WS_B = 90 * MiB;
constexpr size_t WS_C = 130 * MiB;
constexpr size_t WS_END = 240 * MiB;
static_assert(WS_BCIN + 2560 * 4 <= WS_WCIN && WS_WEND <= WS_A, "ws map");
constexpr size_t A_QA = 0;
constexpr size_t A_CKV = A_QA + (size_t)T * QL * 2;
constexpr size_t A_KR = A_CKV + (size_t)TK * KVL * 2;
constexpr size_t A_KC = A_KR + (size_t)TK * 32 * 2;
constexpr size_t A_VTC = A_KC + (size_t)TK * 128 * 2;
static_assert(A_VTC + (size_t)128 * TK * 2 <= 40 * MiB, "region A");
constexpr int U1W = AINP - 512;
constexpr size_t C_U1 = 0;
constexpr size_t C_QC = (size_t)T * U1W * 2;
constexpr size_t C_VTM = C_QC + (size_t)T * 512 * 2;
constexpr size_t C_MQ = 0;
constexpr size_t C_KN = C_VTM + (size_t)512 * TK * 2;
static_assert((size_t)T * MQD * 2 <= C_QC && C_KN + (size_t)TK * 512 * 2 <= 110 * MiB, "region C");
constexpr size_t OUT_Y = 0, OUT_K = (size_t)T * DM, OUT_V = OUT_K + (size_t)TP * 128, OUT_CKV = OUT_V + (size_t)TP * 128, OUT_KR = OUT_CKV + (size_t)TP * 256;

typedef __bf16 bf16x2_t __attribute__((ext_vector_type(2)));
__device__ __forceinline__ unsigned pk2(float lo, float hi) { bf16x2_t v = {(__bf16)lo, (__bf16)hi}; return __builtin_bit_cast(unsigned, v); }
__device__ __forceinline__ bf16 f2bf(float x) { return (bf16)(pk2(x, 0.f) & 0xffffu); }
__device__ __forceinline__ float bf2f(bf16 b) { return __uint_as_float((unsigned)b << 16); }
__device__ __forceinline__ float bflo(unsigned w) { return __uint_as_float(w << 16); }
__device__ __forceinline__ float bfhi(unsigned w) { return __uint_as_float(w & 0xffff0000u); }
__device__ __forceinline__ float wave_sum(float v) {
#pragma unroll
    for (int o = 1; o < 64; o <<= 1) v += __shfl_xor(v, o);
    return v;
}
__device__ __forceinline__ float fsigmoid(float x) { return __builtin_amdgcn_rcpf(1.f + __builtin_amdgcn_exp2f(-1.4426950408889634f * x)); }
__device__ __forceinline__ float fsilu(float x) { return x * fsigmoid(x); }
__device__ __forceinline__ const float* xrow_in(const float* xp, const float* xs, int r) { return r < TP ? xp + (size_t)r * DM : xs + (size_t)(r - TP) * DM; }
__device__ __forceinline__ int cond_of(int r) { return r < TP ? 0 : 1 + ((r - TP) >> 11); }
__device__ __forceinline__ void unpack8(u32x4 w, float (&v)[8]) {
    v[0] = bflo(w.x); v[1] = bfhi(w.x); v[2] = bflo(w.y); v[3] = bfhi(w.y); v[4] = bflo(w.z); v[5] = bfhi(w.z); v[6] = bflo(w.w); v[7] = bfhi(w.w);
}
__device__ __forceinline__ u32x4 pack8(const float (&v)[8]) { u32x4 w; w.x = pk2(v[0], v[1]); w.y = pk2(v[2], v[3]); w.z = pk2(v[4], v[5]); w.w = pk2(v[6], v[7]); return w; }

struct EpiAttnIn {
    static constexpr bool PERM = true, AFTER_DRAIN = false;
    bf16* Q; bf16* U;
    __device__ __forceinline__ void operator()(const f32x4 (&acc)[2][2][4][2], const pg8::Unit& u, int wr, int wc, int fr, int fq) const {
        const bool isq = u.pn < 2; const int ldc = isq ? 512 : U1W;
        const int row0 = u.pm * 256 + wr * 64 + fr, col0 = (isq ? u.pn : u.pn - 2) * 256 + wc * 32 + 8 * fq;
        bf16* base = isq ? Q : U;
#pragma unroll
        for (int ai = 0; ai < 2; ++ai)
#pragma unroll
            for (int m = 0; m < 4; ++m) { bf16* rowp = base + (size_t)(row0 + ai * 128 + m * 16) * ldc + col0;
#pragma unroll
                for (int bj = 0; bj < 2; ++bj) { const f32x4 v0 = acc[ai][bj][m][0], v1 = acc[ai][bj][m][1];
                    u32x4 w; w.x = pk2(v0[0], v0[1]); w.y = pk2(v0[2], v0[3]); w.z = pk2(v1[0], v1[1]); w.w = pk2(v1[2], v1[3]);
                    *(u32x4*)(rowp + bj * 128) = w; } }
    }
};
struct EpiStore {
    static constexpr bool PERM = true, AFTER_DRAIN = false;
    bf16* O; int ldc; const float* bias; bf16* slab;
    __device__ __forceinline__ void operator()(const f32x4 (&acc)[2][2][4][2], const pg8::Unit& u, int wr, int wc, int fr, int fq) const {
        const int row0 = u.pm * 256 + wr * 64 + fr, col0 = u.pn * 256 + wc * 32 + 8 * fq;
        bf16* base = u.part == 0 ? O : slab + (size_t)(u.part - 1) * SLAB_ELEMS - (size_t)(2048 + 2048 * (u.pm / 10)) * DM;
        const bool hb = bias != nullptr && u.part == 0;
        f32x4 bv[2][2];
#pragma unroll
        for (int bj = 0; bj < 2; ++bj)
#pragma unroll
            for (int n = 0; n < 2; ++n) bv[bj][n] = hb ? *(const f32x4*)(bias + col0 + bj * 128 + 4 * n) : (f32x4){0.f, 0.f, 0.f, 0.f};
#pragma unroll
        for (int ai = 0; ai < 2; ++ai)
#pragma unroll
            for (int m = 0; m < 4; ++m) { bf16* rowp = base + (size_t)(row0 + ai * 128 + m * 16) * ldc + col0;
#pragma unroll
                for (int bj = 0; bj < 2; ++bj) { const f32x4 v0 = acc[ai][bj][m][0] + bv[bj][0], v1 = acc[ai][bj][m][1] + bv[bj][1];
                    u32x4 w; w.x = pk2(v0[0], v0[1]); w.y = pk2(v0[2], v0[3]); w.z = pk2(v1[0], v1[1]); w.w = pk2(v1[2], v1[3]);
                    *(u32x4*)(rowp + bj * 128) = w; } }
    }
};
struct EpiConvIn {
    static constexpr bool PERM = true, AFTER_DRAIN = false;
    bf16* O; const float* bias;
    __device__ __forceinline__ void operator()(const f32x4 (&acc)[2][2][4][2], const pg8::Unit& u, int wr, int wc, int fr, int fq) const {
        const int row0 = u.pm * 256 + wr * 64 + fr, cin = u.pn * 256 + wc * 32 + 8 * fq;
        if (u.pn < 2) {
#pragma unroll
            for (int ai = 0; ai < 2; ++ai)
#pragma unroll
                for (int m = 0; m < 4; ++m) { bf16* rowp = O + (size_t)(row0 + ai * 128 + m * 16) * CU2 + cin;
#pragma unroll
                    for (int bj = 0; bj < 2; ++bj) { const f32x4 v0 = acc[ai][bj][m][0], v1 = acc[ai][bj][m][1];
                        u32x4 w; w.x = pk2(v0[0], v0[1]); w.y = pk2(v0[2], v0[3]); w.z = pk2(v1[0], v1[1]); w.w = pk2(v1[2], v1[3]);
                        *(u32x4*)(rowp + bj * 128) = w; } }
        } else {
            const bool glu = u.pn >= 6; const int col0 = 512 + (u.pn - 2) * 128 + wc * 32 + 8 * fq;
            f32x4 ba[2], bg[2];
#pragma unroll
            for (int n = 0; n < 2; ++n) { ba[n] = glu ? *(const f32x4*)(bias + cin + 4 * n) : (f32x4){0.f, 0.f, 0.f, 0.f}; bg[n] = glu ? *(const f32x4*)(bias + cin + 128 + 4 * n) : (f32x4){0.f, 0.f, 0.f, 0.f}; }
#pragma unroll
            for (int ai = 0; ai < 2; ++ai)
#pragma unroll
                for (int m = 0; m < 4; ++m) { bf16* rowp = O + (size_t)(row0 + ai * 128 + m * 16) * CU2 + col0;
                    f32x4 o[2];
#pragma unroll
                    for (int n = 0; n < 2; ++n) { const f32x4 a = acc[ai][0][m][n] + ba[n], g = acc[ai][1][m][n] + bg[n];
                        o[n] = glu ? (f32x4){a[0] * fsigmoid(g[0]), a[1] * fsigmoid(g[1]), a[2] * fsigmoid(g[2]), a[3] * fsigmoid(g[3])} : a * g; }
                    u32x4 w; w.x = pk2(o[0][0], o[0][1]); w.y = pk2(o[0][2], o[0][3]); w.z = pk2(o[1][0], o[1][1]); w.w = pk2(o[1][2], o[1][3]);
                    *(u32x4*)rowp = w; }
        }
    }
};
struct EpiSwiGLU {
    static constexpr bool PERM = true, AFTER_DRAIN = false;
    bf16* O;
    __device__ __forceinline__ void operator()(const f32x4 (&acc)[2][2][4][2], const pg8::Unit& u, int wr, int wc, int fr, int fq) const {
        const int row0 = u.pm * 256 + wr * 64 + fr, col0 = u.pn * 128 + wc * 32 + 8 * fq;
#pragma unroll
        for (int ai = 0; ai < 2; ++ai)
#pragma unroll
            for (int m = 0; m < 4; ++m) { bf16* rowp = O + (size_t)(row0 + ai * 128 + m * 16) * FFN + col0;
                const f32x4 g0 = acc[ai][0][m][0], g1 = acc[ai][0][m][1], u0 = acc[ai][1][m][0], u1 = acc[ai][1][m][1];
                u32x4 w; w.x = pk2(fsilu(g0[0]) * u0[0], fsilu(g0[1]) * u0[1]); w.y = pk2(fsilu(g0[2]) * u0[2], fsilu(g0[3]) * u0[3]);
                w.z = pk2(fsilu(g1[0]) * u1[0], fsilu(g1[1]) * u1[1]); w.w = pk2(fsilu(g1[2]) * u1[2], fsilu(g1[3]) * u1[3]);
                *(u32x4*)rowp = w; }
    }
};
__device__ __forceinline__ int cin_src_col(int n) {
    if (n < 512) return n;
    const int q = n - 512, grp = q >> 10, t4 = (q >> 8) & 3, w = q & 255;
    return 512 + grp * 1024 + (w >> 7) * 512 + 128 * t4 + (w & 127);
}
struct TrItem { const float* src; int ldw; bf16* WT; int K, k0, drow0; };
__device__ __forceinline__ void tr_load(const TrItem& t, float (&tv)[32], int lane) {
#pragma unroll
    for (int i = 0; i < 32; ++i) { const int kk = 2 * i + (lane >> 5); tv[i] = t.src ? t.src[(size_t)(t.k0 + kk) * t.ldw] : 0.f; }
}
__device__ __forceinline__ void tr_store(const TrItem& t, const float (&tv)[32], LAS float* scr, int lane) {
#pragma unroll
    for (int i = 0; i < 32; ++i) { const int kk = 2 * i + (lane >> 5); scr[kk * 33 + (lane & 31)] = tv[i]; }
    asm volatile("s_waitcnt lgkmcnt(0)" ::: "memory");
    const int c = lane & 7;
#pragma unroll
    for (int j = 0; j < 4; ++j) { const int n = (lane >> 3) + 8 * j; const LAS float* s = scr + (8 * c) * 33 + n;
        u32x4 o; o.x = pk2(s[0 * 33], s[1 * 33]); o.y = pk2(s[2 * 33], s[3 * 33]); o.z = pk2(s[4 * 33], s[5 * 33]); o.w = pk2(s[6 * 33], s[7 * 33]);
        *(u32x4*)(t.WT + (size_t)(t.drow0 + n) * t.K + t.k0 + 8 * c) = o; }
    asm volatile("s_waitcnt lgkmcnt(0)" ::: "memory");
}
constexpr int P0_ITEMS_L0 = 16 * 80 + 16 * 32 + 16 * 176 + 44 * 32, P0_ITEMS_ALL = P0_ITEMS_L0 + 16 * 176 + 44 * 32 + 16 * 48 + 6 * 24 + 2 * 4 * 16 + 16 * 32;
__device__ __forceinline__ TrItem p0_decode(const float* const* in, unsigned char* ws, int it, int ln) {
    constexpr int I_CIN = 16 * 80, I_COUT = 16 * 32, I_GU = 16 * 176, I_D = 44 * 32, I_AIN = 16 * 48, I_QB = 6 * 24, I_KN = 4 * 16, I_AOUT = 16 * 32;
    constexpr int NITEMS = I_CIN + I_COUT + 2 * I_GU + 2 * I_D + I_AIN + I_QB + 2 * I_KN + I_AOUT;
    static_assert(NITEMS == P0_ITEMS_ALL, "item count");

        int r = it;
        if (r < I_CIN) { const int nblk = 80, kb = r / nblk, nb = r % nblk, n = 32 * nb + ln;
            return TrItem{in[12] + cin_src_col(n), CIN, (bf16*)(ws + WS_WCIN), 1024, 64 * kb, 32 * nb}; } r -= I_CIN;
        if (r < I_COUT) { const int nblk = 32, kb = r / nblk, nb = r % nblk, n = 32 * nb + ln;
            return TrItem{in[19] + n, 1024, (bf16*)(ws + WS_WCOUT), 1024, 64 * kb, 32 * nb}; } r -= I_COUT;
        if (r < 2 * (I_GU + I_D)) { const int l = r >= (I_GU + I_D) ? 1 : 0; r -= l * (I_GU + I_D);
            if (r < I_GU) { const int nblk = 176, kb = r / nblk, nb = r % nblk, n = 32 * nb + ln, t = n >> 8, w = n & 255;
                const float* src = (w < 128 ? in[29] : in[30]) + (size_t)l * 1024 * FFN + 128 * t + (w & 127);
                return TrItem{src, FFN, (bf16*)(ws + (l ? WS_WGU1 : WS_WGU0)), 1024, 64 * kb, 32 * nb}; }
            else { r -= I_GU; const int nblk = 32, kb = r / nblk, nb = r % nblk, n = 32 * nb + ln;
                return TrItem{in[31] + (size_t)l * FFN * 1024 + n, 1024, (bf16*)(ws + (l ? WS_WD1 : WS_WD0)), FFN, 64 * kb, 32 * nb}; }
            } r -= 2 * (I_GU + I_D);
        if (r < I_AIN) { const int nblk = 48, kb = r / nblk, nb = r % nblk, n = 32 * nb + ln;
            return TrItem{n < AIN ? in[21] + n : nullptr, AIN, (bf16*)(ws + WS_WAIN), 1024, 64 * kb, 32 * nb}; } r -= I_AIN;
        if (r < I_QB) { const int nblk = 24, kb = r / nblk, nb = r % nblk, n = 32 * nb + ln, hh = n / 96, w = n % 96;
            int sc = n; if (w >= 64) { const int e = w - 64, blk = e >> 4, loc = e & 15; sc = hh * 96 + 64 + 16 * blk + 8 * (loc & 1) + (loc >> 1); }
            return TrItem{in[25] + sc, MQD, (bf16*)(ws + WS_WQB), QL, 64 * kb, 32 * nb}; } r -= I_QB;
        if (r < I_KN) { const int nblk = 16, kb = r / nblk, nb = r % nblk, n = 32 * nb + ln;
            return TrItem{in[27] + (n >> 6) * 128 + (n & 63), 1024, (bf16*)(ws + WS_WKN), KVL, 64 * kb, 32 * nb}; } r -= I_KN;
        if (r < I_KN) { const int nblk = 16, kb = r / nblk, nb = r % nblk, n = 32 * nb + ln;
            return TrItem{in[27] + (n >> 6) * 128 + 64 + (n & 63), 1024, (bf16*)(ws + WS_WVT), KVL, 64 * kb, 32 * nb}; } r -= I_KN;
        { const int nblk = 32, kb = r / nblk, nb = r % nblk, n = 32 * nb + ln;
            return TrItem{in[28] + n, 1024, (bf16*)(ws + WS_WAOUT), 1024, 64 * kb, 32 * nb}; }
}
__device__ __forceinline__ void p0_weights(const float* const* in, unsigned char* ws, LAS float* scr, int gw, int ngw, int lane, int item_lo, int item_hi) {
    const int ln = lane & 31;
    int it = item_lo + gw;
    if (it >= item_hi) return;
    TrItem a = p0_decode(in, ws, it, ln); float ta[32], tb[32];
    tr_load(a, ta, lane);
    for (;;) {
        const int nx = it + ngw; const bool more = nx < item_hi;
        TrItem b = a;
        if (more) { b = p0_decode(in, ws, nx, ln); tr_load(b, tb, lane); }
        tr_store(a, ta, scr, lane);
        if (!more) break;
        a = b; it = nx;
#pragma unroll
        for (int i = 0; i < 32; ++i) ta[i] = tb[i];
    }
}
__device__ __forceinline__ void p0_adaln(const float* const* in, unsigned char* ws, LAS unsigned char* lds, int tid, int wave, int lane, int b0, int nb, int item_lo, int item_hi) {
    LAS float* sS = (LAS float*)lds;
    LAS float* red = (LAS float*)(lds + 1024 * 12 * 4);
    float* MOD = (float*)(ws + WS_MOD);
    {   float xv[18];
#pragma unroll
        for (int q = 0; q < 18; ++q) { const int i = tid + NTHR * q, cnd = i >> 10, k = i & 1023; xv[q] = cnd == 0 ? in[7][k] : in[6][(cnd - 1) * 1024 + k]; }
#pragma unroll
        for (int q = 0; q < 18; ++q) { const int i = tid + NTHR * q, cnd = i >> 10, k = i & 1023; sS[k * 12 + cnd] = fsilu(xv[q]); } }
    __syncthreads();
    const int la = lane < 48 ? lane : 47, g = la / 12, cq = la - 12 * g;
    const int krow0 = 128 * wave + 32 * g;
    for (int it = item_lo + b0; it < item_hi; it += nb) {
        const int l = it >> 7, n0 = 48 * (it & 127);
        const float* wp = in[8] + (size_t)l * 1024 * 6144 + n0 + 4 * cq + (size_t)krow0 * 6144;
        f32x4 acc[9];
#pragma unroll
        for (int c = 0; c < 9; ++c) acc[c] = (f32x4){0.f, 0.f, 0.f, 0.f};
#pragma unroll 1
        for (int kk = 0; kk < 32; kk += 16) {
            f32x4 wv[16];
#pragma unroll
            for (int q = 0; q < 16; ++q) wv[q] = *(const f32x4*)(wp + (size_t)(kk + q) * 6144);
#pragma unroll
            for (int q = 0; q < 16; ++q) { const LAS f32x4* s4 = (const LAS f32x4*)(sS + (krow0 + kk + q) * 12); const f32x4 s0 = s4[0], s1 = s4[1], s2 = s4[2];
                acc[0] += s0.x * wv[q]; acc[1] += s0.y * wv[q]; acc[2] += s0.z * wv[q]; acc[3] += s0.w * wv[q];
                acc[4] += s1.x * wv[q]; acc[5] += s1.y * wv[q]; acc[6] += s1.z * wv[q]; acc[7] += s1.w * wv[q]; acc[8] += s2.x * wv[q]; }
        }
        if (lane < 48) {
#pragma unroll
            for (int c = 0; c < 9; ++c) *(LAS f32x4*)(red + ((wave * 4 + g) * 9 + c) * 48 + 4 * cq) = acc[c]; }
        __syncthreads();
        if (tid < 432) { const int c = tid / 48, col = tid - 48 * c; float sum = in[9][l * 6144 + n0 + col];
#pragma unroll
            for (int pp = 0; pp < 32; ++pp) sum += red[(pp * 9 + c) * 48 + col];
            MOD[(size_t)(l * 9 + c) * 6144 + n0 + col] = sum; }
        __syncthreads();
    }
}
__device__ __forceinline__ void p0_tables(const float* const* in, unsigned char* ws, int tid) {
    f32x2* tabg = (f32x2*)(ws + WS_TABG); f32x2* tabm = (f32x2*)(ws + WS_TABM); float* bcin = (float*)(ws + WS_BCIN);
    for (int i = tid; i < 64 * 16; i += NTHR) { const int pos = i >> 4, f = i & 15; const float inv = exp2f(-(float)f * (13.287712379549449f / 16.f)), a = (float)pos * inv; tabg[i] = (f32x2){__cosf(a), __sinf(a)}; }
    for (int i = tid; i < 64 * 8; i += NTHR) { const int pos = i >> 3, f = i & 7; const float inv = exp2f(-(float)f * (13.287712379549449f / 8.f)), a = (float)pos * inv; tabm[i] = (f32x2){__cosf(a), __sinf(a)}; }
    static_assert(CIN == 5 * NTHR, "bias permutation loop");
    {   float bv_[5];
#pragma unroll
        for (int q = 0; q < 5; ++q) { const int sc = cin_src_col(tid + NTHR * q); bv_[q] = sc < 1536 ? 0.f : in[14][sc - 1536]; }
#pragma unroll
        for (int q = 0; q < 5; ++q) bcin[tid + NTHR * q] = bv_[q]; }
}

constexpr int NIT = T / (256 * NWAVES);
static_assert(NIT * 256 * NWAVES == T && NIT == 10, "row phases assume a 256-workgroup grid");
__device__ __forceinline__ int row0_of(int bid, int wave) { return 2560 * (bid & 7) + 8 * (bid >> 3) + wave; }
__device__ __forceinline__ int slab_off_of(int bid) { return 2048 + 2048 * (bid & 7); }
__device__ __forceinline__ f32x4 bf4(u32x2 w) { return (f32x4){bflo(w.x), bfhi(w.x), bflo(w.y), bfhi(w.y)}; }
__device__ __forceinline__ float sq4(f32x4 v) { return (v.x * v.x + v.y * v.y) + (v.z * v.z + v.w * v.w); }
__device__ __forceinline__ void phase_norm_in(const float* xp, const float* xs, const float* gpre, const float* modl, int sidx, bf16* H, int gw, int lane) {
    f32x4 g[4];
#pragma unroll
    for (int j = 0; j < 4; ++j) g[j] = ((const f32x4*)gpre + lane)[64 * j];
    f32x4 cur[4], nxt[4];
    { const f32x4* x4 = (const f32x4*)xrow_in(xp, xs, gw) + lane;
#pragma unroll
      for (int j = 0; j < 4; ++j) cur[j] = x4[64 * j]; }
    f32x4 sh[4], sc[4]; int pcnd = -1;
#pragma unroll
    for (int i = 0; i < NIT; ++i) {
        const int r = gw + 256 * i, cnd = cond_of(r);
        if (cnd != pcnd) {
            pcnd = cnd; const float* mb = modl + (size_t)cnd * 6144;
#pragma unroll
            for (int j = 0; j < 4; ++j) { sh[j] = ((const f32x4*)(mb + sidx * DM) + lane)[64 * j]; sc[j] = ((const f32x4*)(mb + (sidx + 1) * DM) + lane)[64 * j]; }
        }
        if (i + 1 < NIT) { const f32x4* x4 = (const f32x4*)xrow_in(xp, xs, r + 256) + lane;
#pragma unroll
            for (int j = 0; j < 4; ++j) nxt[j] = x4[64 * j]; }
        float ss = 0.f;
#pragma unroll
        for (int j = 0; j < 4; ++j) ss += sq4(cur[j]);
        const float rstd = rsqrtf(wave_sum(ss) * (1.f / DM) + EPS);
        u32x2* h2 = (u32x2*)(H + (size_t)r * DM) + lane;
#pragma unroll
        for (int j = 0; j < 4; ++j) { const f32x4 o = cur[j] * rstd * g[j] * (1.f + sc[j]) + sh[j]; h2[64 * j] = (u32x2){pk2(o.x, o.y), pk2(o.z, o.w)}; }
#pragma unroll
        for (int j = 0; j < 4; ++j) cur[j] = nxt[j];
    }
}
template <bool NEXT, bool XIN16, bool XOUT16, bool SLAB>
__device__ __forceinline__ void phase_post(const bf16* O, const bf16* slab, const float* xp, const float* xs, float* Y, const float* gpost, const float* modl, int gidx,
                                           const float* gpre_n, const float* modn, int sidx_n, bf16* H, int gw, int slab_off, int lane) {
    f32x4 gp[4], gn[4];
#pragma unroll
    for (int j = 0; j < 4; ++j) { gp[j] = ((const f32x4*)gpost + lane)[64 * j]; if (NEXT) gn[j] = ((const f32x4*)gpre_n + lane)[64 * j]; }
    u32x2 co[4], no[4], cxb[4], nxb[4], cs[3][4], ns[3][4]; f32x4 cxf[4], nxf[4];
#define POST_LOAD(rr, it, po, pxb, pxf, ps) do { \
        const u32x2* o2_ = (const u32x2*)(O + (size_t)(rr) * DM) + lane; \
        _Pragma("unroll") for (int j = 0; j < 4; ++j) po[j] = o2_[64 * j]; \
        if (XIN16) { const u32x2* b2_ = (const u32x2*)(Y + (size_t)(rr) * DM) + lane; _Pragma("unroll") for (int j = 0; j < 4; ++j) pxb[j] = b2_[64 * j]; } \
        else { const f32x4* x4_ = (const f32x4*)xrow_in(xp, xs, (rr)) + lane; _Pragma("unroll") for (int j = 0; j < 4; ++j) pxf[j] = x4_[64 * j]; } \
        if (SLAB && (it) >= 8) { _Pragma("unroll") for (int p = 0; p < 3; ++p) { const u32x2* s2_ = (const u32x2*)(slab + (size_t)p * SLAB_ELEMS + (size_t)((rr) - slab_off) * DM) + lane; \
            _Pragma("unroll") for (int j = 0; j < 4; ++j) ps[p][j] = s2_[64 * j]; } } } while (0)
    POST_LOAD(gw, 0, co, cxb, cxf, cs);
    f32x4 gt[4], sh[4], sc[4]; int pcnd = -1;
#pragma unroll
    for (int i = 0; i < NIT; ++i) {
        const int r = gw + 256 * i, cnd = cond_of(r);
        if (cnd != pcnd) {
            pcnd = cnd;
#pragma unroll
            for (int j = 0; j < 4; ++j) { gt[j] = ((const f32x4*)(modl + (size_t)cnd * 6144 + gidx * DM) + lane)[64 * j];
                if (NEXT) { sh[j] = ((const f32x4*)(modn + (size_t)cnd * 6144 + sidx_n * DM) + lane)[64 * j]; sc[j] = ((const f32x4*)(modn + (size_t)cnd * 6144 + (sidx_n + 1) * DM) + lane)[64 * j]; } }
        }
        if (i + 1 < NIT) POST_LOAD(r + 256, i + 1, no, nxb, nxf, ns);
        f32x4 o[4], x[4]; float ss = 0.f;
#pragma unroll
        for (int j = 0; j < 4; ++j) { o[j] = bf4(co[j]); x[j] = XIN16 ? bf4(cxb[j]) : cxf[j]; }
        if (SLAB && i >= 8) {
#pragma unroll
            for (int p = 0; p < 3; ++p)
#pragma unroll
                for (int j = 0; j < 4; ++j) o[j] = o[j] + bf4(cs[p][j]); }
#pragma unroll
        for (int j = 0; j < 4; ++j) ss += sq4(o[j]);
        const float ro = rsqrtf(wave_sum(ss) * (1.f / DM) + EPS);
        f32x4* y4 = (f32x4*)(Y + (size_t)r * DM) + lane; u32x2* yb2 = (u32x2*)(Y + (size_t)r * DM) + lane; float s2 = 0.f;
#pragma unroll
        for (int j = 0; j < 4; ++j) { x[j] = x[j] + gt[j] * (o[j] * ro * gp[j]);
            if (XOUT16) yb2[64 * j] = (u32x2){pk2(x[j].x, x[j].y), pk2(x[j].z, x[j].w)}; else y4[64 * j] = x[j];
            s2 += sq4(x[j]); }
        if (NEXT) {
            const float rx = rsqrtf(wave_sum(s2) * (1.f / DM) + EPS);
            u32x2* h2 = (u32x2*)(H + (size_t)r * DM) + lane;
#pragma unroll
            for (int j = 0; j < 4; ++j) { const f32x4 h = x[j] * rx * gn[j] * (1.f + sc[j]) + sh[j]; h2[64 * j] = (u32x2){pk2(h.x, h.y), pk2(h.z, h.w)}; }
        }
#pragma unroll
        for (int j = 0; j < 4; ++j) { co[j] = no[j]; cxb[j] = nxb[j]; cxf[j] = nxf[j];
#pragma unroll
            for (int p = 0; p < 3; ++p) cs[p][j] = ns[p][j]; }
    }
#undef POST_LOAD
}

__device__ __forceinline__ void phase_conv(const bf16* U, bf16* MIX, const float* sc_w, const float* dw_w, const float* dw_b, const float* ln_g, const float* ln_b,
                                           LAS unsigned char* lds, int tid, int wave, int lane, int G) {
    LAS bf16* zsb = (LAS bf16*)lds;
    LAS bf16* pbuf = (LAS bf16*)(lds + 62 * 1024);
    LAS bf16* zbuf = (LAS bf16*)(lds + 96 * 1024);
    LAS float* part = (LAS float*)(lds + 129 * 1024);
    LAS float* stat = part + 512;
    const int c = tid, srow = tid >> 6, ch8 = tid & 63;
    float w[31];
#pragma unroll
    for (int j = 0; j < 31; ++j) w[j] = dw_w[j * 512 + c];
    const float bdw = dw_b[c], lg = ln_g[c], lb = ln_b[c];
    u32x4 bv[8], ac[5];
#define CONV_LOAD(chn) do { const int r0n_ = 32 * (chn); const bf16* ub_ = U + (size_t)(r0n_ - 15 + srow) * CU2 + 1024 + 8 * ch8; \
        _Pragma("unroll") for (int p = 0; p < 8; ++p) { const int row = srow + 8 * p; bv[p] = *(const u32x4*)(ub_ + (size_t)(row < 62 ? 8 * p : 0) * CU2); } } while (0)
#define CONV_LOAD_A(chn) do { const int r0n_ = 32 * (chn); const bf16* ua_ = U + (size_t)(r0n_ - 1 + srow) * CU2 + 512 + 8 * ch8; \
        _Pragma("unroll") for (int p = 0; p < 5; ++p) { const int row = srow + 8 * p; ac[p] = *(const u32x4*)(ua_ + (size_t)(row < 34 ? 8 * p : 0) * CU2); } } while (0)
    const int cx = 80 * ((int)blockIdx.x & 7), cs0 = (int)blockIdx.x >> 3;
    CONV_LOAD(cx + cs0); CONV_LOAD_A(cx + cs0);
    for (int cs = cs0; cs < 80; cs += 32) { const int ch = cx + cs;
        const int r0 = 32 * ch;
        const int sq0 = r0 < TP ? (r0 & ~255) : TP + ((r0 - TP) & ~2047), sq1 = sq0 + (r0 < TP ? 256 : 2048);
#pragma unroll
        for (int p = 0; p < 8; ++p) { const int row = srow + 8 * p, rr = r0 - 15 + row; const bool ok = rr >= sq0 && rr < sq1;
            if (row < 62) *(LAS u32x4*)(zsb + row * 512 + 8 * ch8) = ok ? bv[p] : (u32x4){0u, 0u, 0u, 0u}; }
#pragma unroll
        for (int p = 0; p < 5; ++p) { const int row = srow + 8 * p, rr = r0 - 1 + row; const bool ok = rr >= sq0 && rr < sq1;
            if (row < 34) *(LAS u32x4*)(pbuf + row * 512 + 8 * ch8) = ok ? ac[p] : (u32x4){0u, 0u, 0u, 0u}; }
        __syncthreads();
        float z1[32];
        {   float z0[62];
#pragma unroll
            for (int j = 0; j < 62; ++j) z0[j] = bf2f(zsb[j * 512 + c]);
#pragma unroll
            for (int t = 0; t < 32; ++t) z1[t] = bdw;
#pragma unroll
            for (int j = 0; j < 31; ++j)
#pragma unroll
                for (int t = 0; t < 32; ++t) z1[t] += w[j] * z0[t + j]; }
        __builtin_amdgcn_sched_barrier(0);
        u32x4 gb[4];
        {   const bf16* ug = U + (size_t)(r0 + srow) * CU2 + 8 * ch8;
#pragma unroll
            for (int p = 0; p < 4; ++p) gb[p] = *(const u32x4*)(ug + (size_t)(8 * p) * CU2); }
        if (cs + 32 < 80) CONV_LOAD(ch + 32);
        __builtin_amdgcn_sched_barrier(0);
#pragma unroll
        for (int pass = 0; pass < 2; ++pass) { float v1[32];
#pragma unroll
            for (int t = 0; t < 32; ++t) v1[t] = pass ? z1[t] * z1[t] : z1[t];
#pragma unroll
            for (int st = 0; st < 5; ++st) { const int B = 32 >> st, n = 16 >> st; const bool hi = (lane & B) != 0;
#pragma unroll
                for (int i = 0; i < 16; ++i) if (i < n) { const float s1 = hi ? v1[i] : v1[i + n], k1 = hi ? v1[i + n] : v1[i]; v1[i] = k1 + __shfl_xor(s1, B); } }
            v1[0] += __shfl_xor(v1[0], 1);
            if ((lane & 1) == 0) part[pass * 256 + wave * 32 + (lane >> 1)] = v1[0];
            __builtin_amdgcn_sched_barrier(0); }
        __syncthreads();
        if (tid < 32) { float a = 0.f, b = 0.f;
#pragma unroll
            for (int q = 0; q < 8; ++q) { a += part[q * 32 + tid]; b += part[256 + q * 32 + tid]; }
            const float mean = a * (1.f / 512.f), var = fmaxf(b * (1.f / 512.f) - mean * mean, 0.f);
            stat[2 * tid] = mean; stat[2 * tid + 1] = rsqrtf(var + EPS); }
        __syncthreads();
#pragma unroll
        for (int t = 0; t < 32; ++t) { const f32x2 ms = *(const LAS f32x2*)(stat + 2 * t); const float y = (z1[t] - ms.x) * ms.y * lg + lb; zbuf[t * 512 + c] = f2bf(fsilu(y)); }
        float scw[3][8];
#pragma unroll
        for (int j = 0; j < 3; ++j) { const f32x4 a = *(const f32x4*)(sc_w + j * 512 + 8 * ch8), b = *(const f32x4*)(sc_w + j * 512 + 8 * ch8 + 4);
            scw[j][0] = a.x; scw[j][1] = a.y; scw[j][2] = a.z; scw[j][3] = a.w; scw[j][4] = b.x; scw[j][5] = b.y; scw[j][6] = b.z; scw[j][7] = b.w; }
#pragma unroll
        for (int p = 0; p < 4; ++p) { const int t = srow + 8 * p;
            float g[8], p0[8], p1[8], p2[8]; unpack8(gb[p], g);
            unpack8(*(const LAS u32x4*)(pbuf + t * 512 + 8 * ch8), p0); unpack8(*(const LAS u32x4*)(pbuf + (t + 1) * 512 + 8 * ch8), p1); unpack8(*(const LAS u32x4*)(pbuf + (t + 2) * 512 + 8 * ch8), p2);
#pragma unroll
            for (int k = 0; k < 8; ++k) g[k] = g[k] * (scw[0][k] * p0[k] + scw[1][k] * p1[k] + scw[2][k] * p2[k]);
            *(u32x4*)(MIX + (size_t)(r0 + t) * DM + 8 * ch8) = pack8(g); }
        __builtin_amdgcn_sched_barrier(0);
        if (cs + 32 < 80) CONV_LOAD_A(ch + 32);
        __syncthreads();
#pragma unroll
        for (int p = 0; p < 4; ++p) { const int t = srow + 8 * p; *(u32x4*)(MIX + (size_t)(r0 + t) * DM + 512 + 8 * ch8) = *(const LAS u32x4*)(zbuf + t * 512 + 8 * ch8); }
    }
#undef CONV_LOAD
#undef CONV_LOAD_A
}

__device__ __forceinline__ void rope_head64(float (&v)[8], int lane, const f32x2 (&cs)[8]) {
    const bool second = (lane & 2) != 0;
#pragma unroll
    for (int j = 0; j < 8; ++j) { const float pv = __shfl_xor(v[j], 2);
        v[j] = second ? v[j] * cs[j].x + pv * cs[j].y : v[j] * cs[j].x - pv * cs[j].y; }
}
__device__ __forceinline__ void phase_attn_rows(const bf16* U1, const float* qn, const float* kn, const float* qan, const float* kvan, const f32x2* tabg, const f32x2* tabm,
                                                bf16* QC, bf16* KC, bf16* VtC, bf16* QA, bf16* CKV, bf16* KR, float* o_k, float* o_v, float* o_ckv, float* o_kr,
                                                const float* c_k, const float* c_v, const float* c_ckv, const float* c_kr, LAS unsigned char* lds, int bid, int tid, int wave, int lane) {
    LAS bf16* vbuf = (LAS bf16*)lds;
    LAS f32x2* ltg = (LAS f32x2*)(lds + 8192);
    LAS f32x2* ltm = ltg + 64 * 16;
    { const u32x4* src = (const u32x4*)tabg; LAS u32x4* dst = (LAS u32x4*)(lds + 8192); dst[tid] = src[tid]; if (tid < 256) dst[512 + tid] = src[512 + tid]; }
    const int pb = (bid & 7) * 32 + (bid >> 3);
    const int gw = pb * NWAVES + wave, rb0 = 2560 * (bid & 7) + 8 * (bid >> 3), r0 = rb0 + wave, l2 = lane & 31,
    l3 = lane < 48 ? lane : 0, l4 = lane & 3, d0 = 8 * (lane & 7);
    const bool hi32 = lane >= 32, krl = lane >= 48 && lane < 52;
    float knv[8], qav[8], kvv[8];
#pragma unroll
    for (int j = 0; j < 8; ++j) { knv[j] = kn[d0 + j]; qav[j] = qan[8 * l3 + j]; kvv[j] = kvan[8 * l2 + j]; }
    u32x4 ckv_, cqa, nkv, nqa;
    const int okv = hi32 ? 640 + 8 * l2 : 8 * l2, oqa = lane < 48 ? 256 + 8 * lane : 896 + 8 * l4;
#define AR_LOAD(rr, pkv, pqa) do { const bf16* u_ = U1 + (size_t)(rr) * U1W; pkv = *(const u32x4*)(u_ + okv); pqa = *(const u32x4*)(u_ + oqa); } while (0)
    AR_LOAD(r0, ckv_, cqa);
    const f32x4 ck4 = *(const f32x4*)(c_k + (size_t)gw * 128 + 4 * l2), cv4 = *(const f32x4*)(c_v + (size_t)gw * 128 + 4 * l2), cc4 = *(const f32x4*)(c_ckv + (size_t)gw * 256 + 4 * lane);
    const float ckr1 = c_kr[(size_t)gw * 32 + l2];
    __syncthreads();
#pragma unroll 1
    for (int i = 0; i < NIT; ++i) {
        const int r = r0 + 256 * i;
        if (i + 1 < NIT) AR_LOAD(r + 256, nkv, nqa);
        const bool smp = r >= TP; const int ts = (r - TP) & 2047, prow = ts >> 6, pcol = ts & 63;
        const int krow = smp ? TP + ((r - TP) >> 11) * KSEQ + PAST + ts : r;
        f32x2 csg[8];
        { const LAS f32x4* t4 = (const LAS f32x4*)(ltg + ((lane & 4) ? pcol : prow) * 16 + 8 * (lane & 1));
#pragma unroll
          for (int j = 0; j < 4; ++j) { const f32x4 t = t4[j]; csg[2 * j] = (f32x2){t.x, t.y}; csg[2 * j + 1] = (f32x2){t.z, t.w}; } }
        float ssc;
        {
            float v[8], raw[8]; unpack8(ckv_, v);
            float ss = 0.f;
#pragma unroll
            for (int j = 0; j < 8; ++j) { raw[j] = v[j]; ss += v[j] * v[j]; }
            ssc = ss;
            ss += __shfl_xor(ss, 1); ss += __shfl_xor(ss, 2); ss += __shfl_xor(ss, 4);
            const float rstd = rsqrtf(ss * (1.f / 64.f) + EPS);
#pragma unroll
            for (int j = 0; j < 8; ++j) v[j] = v[j] * rstd * knv[j];
            if (lane < 16 && !smp) { float* ok = o_k + (size_t)r * 128 + 8 * lane; *(f32x4*)ok = (f32x4){v[0], v[1], v[2], v[3]}; *(f32x4*)(ok + 4) = (f32x4){v[4], v[5], v[6], v[7]}; }
            float vr[8];
#pragma unroll
            for (int j = 0; j < 8; ++j) vr[j] = v[j];
            rope_head64(vr, lane, csg);
#pragma unroll
            for (int j = 0; j < 8; ++j) v[j] = smp ? vr[j] : v[j];
            if (lane < 16) *(u32x4*)(KC + (size_t)krow * 128 + 8 * lane) = pack8(v);
            else if (lane < 32) { const int cv = 8 * (lane - 16);
                *(LAS u32x4*)(vbuf + ((i & 1) * 8 + wave) * 128 + cv) = ckv_;
                if (!smp) { float* ov = o_v + (size_t)r * 128 + cv; *(f32x4*)ov = (f32x4){raw[0], raw[1], raw[2], raw[3]}; *(f32x4*)(ov + 4) = (f32x4){raw[4], raw[5], raw[6], raw[7]}; } }
            const float sc = wave_sum(hi32 ? ssc : 0.f);
            const float rc = rsqrtf(sc * (1.f / 256.f) + EPS);
            if (hi32) { float c[8];
#pragma unroll
                for (int j = 0; j < 8; ++j) c[j] = raw[j] * rc * kvv[j];
                *(u32x4*)(CKV + (size_t)krow * KVL + 8 * l2) = pack8(c);
                if (!smp) { float* oc = o_ckv + (size_t)r * 256 + 8 * l2; *(f32x4*)oc = (f32x4){c[0], c[1], c[2], c[3]}; *(f32x4*)(oc + 4) = (f32x4){c[4], c[5], c[6], c[7]}; } }
        }
        {
            float v[8]; unpack8(cqa, v);
            float ss = 0.f;
#pragma unroll
            for (int j = 0; j < 8; ++j) ss += v[j] * v[j];
            ss = wave_sum(lane < 48 ? ss : 0.f);
            const float rstd = rsqrtf(ss * (1.f / 384.f) + EPS);
            if (lane < 48) { float a[8];
#pragma unroll
                for (int j = 0; j < 8; ++j) a[j] = v[j] * rstd * qav[j];
                *(u32x4*)(QA + (size_t)r * QL + 8 * lane) = pack8(a); }
            const int blk = l4 >> 1, pos = blk ? pcol : prow; const bool second = (l4 & 1) != 0;
            if (krl && !smp) { float* okr = o_kr + (size_t)r * 32 + 8 * l4; *(f32x4*)okr = (f32x4){v[0], v[1], v[2], v[3]}; *(f32x4*)(okr + 4) = (f32x4){v[4], v[5], v[6], v[7]}; }
            const LAS f32x4* t4 = (const LAS f32x4*)(ltm + pos * 8);
            unsigned wd[8];
#pragma unroll
            for (int j = 0; j < 4; ++j) { const f32x4 t = t4[j];
#pragma unroll
                for (int q = 0; q < 2; ++q) { const int jj = 2 * j + q; const float cx = q ? t.z : t.x, sx = q ? t.w : t.y;
                    const float pv = __shfl_xor(v[jj], 1);
                    const float rv = second ? v[jj] * cx + pv * sx : v[jj] * cx - pv * sx; const float o = smp ? rv : v[jj];
                    const float po = __shfl_xor(o, 1);
                    wd[jj] = second ? pk2(po, o) : pk2(o, po); } }
            if (krl) *(u32x4*)(KR + (size_t)krow * 32 + 16 * blk + (second ? 8 : 0)) = second ? (u32x4){wd[4], wd[5], wd[6], wd[7]} : (u32x4){wd[0], wd[1], wd[2], wd[3]};
        }
        __syncthreads();
        if (tid < 128) {
            const int rb = rb0 + 256 * i, kb = rb >= TP ? TP + ((rb - TP) >> 11) * KSEQ + PAST + ((rb - TP) & 2047) : rb;
            const LAS bf16* vp = vbuf + (i & 1) * 1024 + tid; u32x4 w;
            w.x = (unsigned)vp[0] | ((unsigned)vp[128] << 16); w.y = (unsigned)vp[256] | ((unsigned)vp[384] << 16); w.z = (unsigned)vp[512] | ((unsigned)vp[640] << 16); w.w = (unsigned)vp[768] | ((unsigned)vp[896] << 16);
            *(u32x4*)(VtC + (size_t)tid * TK + kb) = w; }
        ckv_ = nkv; cqa = nqa;
    }
#undef AR_LOAD
    {   const int cr = gw, krow = TP + (cr >> 8) * KSEQ + (cr & 255);
        __syncthreads();
        if (lane < 32) { *(u32x2*)(KC + (size_t)krow * 128 + 4 * lane) = (u32x2){pk2(ck4.x, ck4.y), pk2(ck4.z, ck4.w)};
            *(LAS u32x2*)(vbuf + wave * 128 + 4 * lane) = (u32x2){pk2(cv4.x, cv4.y), pk2(cv4.z, cv4.w)};
            const int e = lane, blk = e >> 4, loc = e & 15; KR[(size_t)krow * 32 + 16 * blk + 2 * (loc & 7) + (loc >> 3)] = f2bf(ckr1); }
        *(u32x2*)(CKV + (size_t)krow * KVL + 4 * lane) = (u32x2){pk2(cc4.x, cc4.y), pk2(cc4.z, cc4.w)};
        __syncthreads();
        if (tid < 128) { const int cb = pb * NWAVES, kb = TP + (cb >> 8) * KSEQ + (cb & 255);
            const LAS bf16* vp = vbuf + tid; u32x4 w;
            w.x = (unsigned)vp[0] | ((unsigned)vp[128] << 16); w.y = (unsigned)vp[256] | ((unsigned)vp[384] << 16); w.z = (unsigned)vp[512] | ((unsigned)vp[640] << 16); w.w = (unsigned)vp[768] | ((unsigned)vp[896] << 16);
            *(u32x4*)(VtC + (size_t)tid * TK + kb) = w; }
        __syncthreads();
    }
}

#define MFMA32(a, b, c) __builtin_amdgcn_mfma_f32_32x32x16_bf16((a), (b), (c), 0, 0, 0)
template <bool MLA, int ABL>
__device__ __forceinline__ void attn_tile(const LAS unsigned char* kb, const LAS unsigned char* rb, const LAS unsigned char* vb, const bf16x8 (&qf)[MLA ? 6 : 4],
                                          f32x16& o0, f32x16& o1, float& m, float& l, float c, int r, int h) {
    constexpr int NQ = MLA ? 6 : 4;
    f32x16 p0, p1;
#pragma unroll
    for (int i = 0; i < 16; ++i) { p0[i] = 0.f; p1[i] = 0.f; }
#pragma unroll
    for (int ks = 0; ks < 4; ++ks) { const bf16x8 a0 = *(const LAS bf16x8*)(kb + r * 144 + ks * 32 + h * 16), a1 = *(const LAS bf16x8*)(kb + (32 + r) * 144 + ks * 32 + h * 16);
        p0 = MFMA32(a0, qf[ks], p0); p1 = MFMA32(a1, qf[ks], p1); }
    if (MLA) {
#pragma unroll
        for (int ks = 0; ks < 2; ++ks) { const bf16x8 a0 = *(const LAS bf16x8*)(rb + r * 80 + ks * 32 + h * 16), a1 = *(const LAS bf16x8*)(rb + (32 + r) * 80 + ks * 32 + h * 16);
            p0 = MFMA32(a0, qf[NQ - 2 + ks], p0); p1 = MFMA32(a1, qf[NQ - 2 + ks], p1); } }
    bf16x8 vf[2][2][2];
#pragma unroll
    for (int t = 0; t < 2; ++t)
#pragma unroll
        for (int s = 0; s < 2; ++s)
#pragma unroll
            for (int dh = 0; dh < 2; ++dh) vf[t][s][dh] = *(const LAS bf16x8*)(vb + (32 * dh + r) * 144 + 64 * t + 32 * s + 16 * h);
    __builtin_amdgcn_sched_barrier(0);
    if (ABL != 1 && ABL != 3) {
    float mx = p0[0];
#pragma unroll
    for (int i = 1; i < 16; ++i) mx = fmaxf(mx, p0[i]);
#pragma unroll
    for (int i = 0; i < 16; ++i) mx = fmaxf(mx, p1[i]);
    mx = fmaxf(mx, __shfl_xor(mx, 32));
    if (!__all((mx - m) * c <= 8.f)) {
        const float mn = fmaxf(m, mx), alpha = __builtin_amdgcn_exp2f((m - mn) * c); m = mn; l *= alpha;
#pragma unroll
        for (int i = 0; i < 16; ++i) { o0[i] *= alpha; o1[i] *= alpha; }
    }
    const float mc = -m * c;
    float ps = 0.f;
#pragma unroll
    for (int i = 0; i < 16; ++i) { p0[i] = __builtin_amdgcn_exp2f(fmaf(p0[i], c, mc)); ps += p0[i]; }
#pragma unroll
    for (int i = 0; i < 16; ++i) { p1[i] = __builtin_amdgcn_exp2f(fmaf(p1[i], c, mc)); ps += p1[i]; }
    l += ps;
    }
    bf16x8 pb[2][2];
#pragma unroll
    for (int s = 0; s < 2; ++s) {
        u32x4 w0; w0.x = pk2(p0[8 * s + 0], p0[8 * s + 1]); w0.y = pk2(p0[8 * s + 2], p0[8 * s + 3]); w0.z = pk2(p0[8 * s + 4], p0[8 * s + 5]); w0.w = pk2(p0[8 * s + 6], p0[8 * s + 7]);
        u32x4 w1; w1.x = pk2(p1[8 * s + 0], p1[8 * s + 1]); w1.y = pk2(p1[8 * s + 2], p1[8 * s + 3]); w1.z = pk2(p1[8 * s + 4], p1[8 * s + 5]); w1.w = pk2(p1[8 * s + 6], p1[8 * s + 7]);
        pb[0][s] = __builtin_bit_cast(bf16x8, w0); pb[1][s] = __builtin_bit_cast(bf16x8, w1); }
    __builtin_amdgcn_sched_barrier(0);
#pragma unroll
    for (int t = 0; t < 2; ++t)
#pragma unroll
        for (int s = 0; s < 2; ++s) {
            o0 = MFMA32(vf[t][s][0], pb[t][s], o0);
            o1 = MFMA32(vf[t][s][1], pb[t][s], o1); }
    __builtin_amdgcn_sched_barrier(0);
}
constexpr int ATT_TAB_OFF = 100 * 1024;
struct AttnNext { const bf16* Q; const bf16* K; const bf16* V; const bf16* KR; int ldq, ldk; };
template <bool MLA, int ABL = 0>
__device__ __forceinline__ void attn_unit(LAS unsigned char* lds, const bf16* Q, int ldq, const bf16* K, int ldk, const bf16* KRp, const bf16* Vt, int nkeys, bf16* O, float c,
                                          const f32x2* tabm, int qpos0, int tid, int wave, int lane, const AttnNext& nx) {
    constexpr int NQ = MLA ? 6 : 4;
    constexpr int KB_SZ = 64 * 144, KR_OFF = 4 * KB_SZ, KR_SZ = 64 * 80, VT_OFF = KR_OFF + 4 * KR_SZ, VT_SZ = 64 * 144;
    const int r = lane & 31, h = lane >> 5;
    const int skey = tid >> 3, sch = tid & 7;
    const bf16* kg = K + (size_t)skey * ldk + 8 * sch;
    const bf16* vg = Vt + (size_t)skey * TK + 8 * sch;
    const bf16* rg = KRp + (size_t)(tid >> 2) * 32 + 8 * (tid & 3);
    const int kw = skey * 144 + sch * 16, vw = skey * 144 + (sch >> 1) * 32 + (sch & 1) * 8, rw = (tid >> 2) * 80 + (tid & 3) * 16;
    const int np = nkeys >> 7;
    u32x4 kreg[2], vreg[2], rreg[2];
#define AT_LOAD(pp) do { _Pragma("unroll") for (int q_ = 0; q_ < 2; ++q_) { const int tt_ = 2 * (pp) + q_; kreg[q_] = *(const u32x4*)(kg + (size_t)tt_ * 64 * ldk); vreg[q_] = *(const u32x4*)(vg + tt_ * 64); \
        if (MLA && tid < 256) rreg[q_] = *(const u32x4*)(rg + (size_t)tt_ * 64 * 32); } } while (0)
#define AT_WRITE(pr) do { _Pragma("unroll") for (int q_ = 0; q_ < 2; ++q_) { const int sl_ = 2 * (pr) + q_; *(LAS u32x4*)(lds + sl_ * KB_SZ + kw) = kreg[q_]; \
        *(LAS u32x2*)(lds + VT_OFF + sl_ * VT_SZ + vw) = (u32x2){vreg[q_].x, vreg[q_].y}; *(LAS u32x2*)(lds + VT_OFF + sl_ * VT_SZ + vw + 16) = (u32x2){vreg[q_].z, vreg[q_].w}; \
        if (MLA && tid < 256) *(LAS u32x4*)(lds + KR_OFF + sl_ * KR_SZ + rw) = rreg[q_]; } } while (0)
    AT_LOAD(0);
    bf16x8 qf[NQ];
    { const bf16* qrow = Q + (size_t)(32 * wave + r) * ldq + 8 * h;
#pragma unroll
      for (int ks = 0; ks < NQ; ++ks) qf[ks] = *(const bf16x8*)(qrow + 16 * ks); }
    if (MLA && qpos0 >= 0) {
        const int ts = qpos0 + 32 * wave + r, prow = ts >> 6, pcol = ts & 63;
#pragma unroll
        for (int blk = 0; blk < 2; ++blk) { const u32x4 w = __builtin_bit_cast(u32x4, qf[NQ - 2 + blk]); float v[8]; unpack8(w, v); const int pos = blk ? pcol : prow;
#pragma unroll
            for (int jj = 0; jj < 4; ++jj) { const f32x2 cs = ((const LAS f32x2*)(lds + ATT_TAB_OFF + 8448))[pos * 8 + 4 * h + jj]; const float x1 = v[2 * jj], x2 = v[2 * jj + 1]; v[2 * jj] = x1 * cs.x - x2 * cs.y; v[2 * jj + 1] = x2 * cs.x + x1 * cs.y; }
            qf[NQ - 2 + blk] = __builtin_bit_cast(bf16x8, pack8(v)); }
    }
    const LAS f32x2* ltg = (const LAS f32x2*)(lds + ATT_TAB_OFF); const LAS float* lqn = (const LAS float*)(lds + ATT_TAB_OFF + 8192);
    if (!MLA) {
        float v[4][8];
#pragma unroll
        for (int ks = 0; ks < 4; ++ks) unpack8(__builtin_bit_cast(u32x4, qf[ks]), v[ks]);
        float ss = 0.f;
#pragma unroll
        for (int ks = 0; ks < 4; ++ks)
#pragma unroll
            for (int j = 0; j < 8; ++j) ss += v[ks][j] * v[ks][j];
        ss += __shfl_xor(ss, 32);
        const float rstd = rsqrtf(ss * (1.f / 64.f) + EPS);
#pragma unroll
        for (int ks = 0; ks < 4; ++ks) { const f32x4 g0 = *(const LAS f32x4*)(lqn + 16 * ks + 8 * h), g1 = *(const LAS f32x4*)(lqn + 16 * ks + 8 * h + 4);
            v[ks][0] *= rstd * g0.x; v[ks][1] *= rstd * g0.y; v[ks][2] *= rstd * g0.z; v[ks][3] *= rstd * g0.w; v[ks][4] *= rstd * g1.x; v[ks][5] *= rstd * g1.y; v[ks][6] *= rstd * g1.z; v[ks][7] *= rstd * g1.w; }
        if (qpos0 >= 0) {
            const int ts = qpos0 + 32 * wave + r, prow = ts >> 6, pcol = ts & 63;
#pragma unroll
            for (int hf = 0; hf < 2; ++hf) { const LAS f32x2* tg = ltg + (hf ? pcol : prow) * 16 + 8 * h;
#pragma unroll
                for (int j = 0; j < 8; ++j) { const f32x2 cs = tg[j]; const float x1 = v[2 * hf][j], x2 = v[2 * hf + 1][j]; v[2 * hf][j] = x1 * cs.x - x2 * cs.y; v[2 * hf + 1][j] = x2 * cs.x + x1 * cs.y; } }
        }
#pragma unroll
        for (int ks = 0; ks < 4; ++ks) qf[ks] = __builtin_bit_cast(bf16x8, pack8(v[ks]));
    }
    f32x16 o0, o1;
#pragma unroll
    for (int i = 0; i < 16; ++i) { o0[i] = 0.f; o1[i] = 0.f; }
    float m = -1e30f, l = 0.f; unsigned pf = 0u;
    AT_WRITE(0);
    __syncthreads();
    for (int j = 0; j < np; ++j) {
        const int cur = j & 1; const bool more = j + 1 < np;
        if (ABL != 3) { if (more) AT_LOAD(j + 1); }
        if (!more) {
            const unsigned* pa = (const unsigned*)(nx.Q + (size_t)(tid >> 1) * nx.ldq + (tid & 1) * 64);
            const unsigned* pb = tid < 128 ? (const unsigned*)(nx.K + (size_t)tid * nx.ldk)
                               : tid < 256 ? (const unsigned*)(nx.V + (size_t)((tid - 128) >> 1) * TK + (tid & 1) * 64)
                               : tid < 320 ? (const unsigned*)(nx.KR + (size_t)(2 * (tid - 256)) * 32) : pa;
            pf = *pa ^ *pb; }
#pragma unroll
        for (int q = 0; q < 2; ++q) { const int sl = 2 * cur + q;
            attn_tile<MLA, ABL>(lds + sl * KB_SZ, lds + KR_OFF + sl * KR_SZ, lds + VT_OFF + sl * VT_SZ, qf, o0, o1, m, l, c, r, h); }
        if (ABL != 3) { if (more) AT_WRITE(cur ^ 1);
        __syncthreads(); }
    }
#undef AT_LOAD
#undef AT_WRITE
    *(LAS unsigned*)(lds + 96 * 1024 + 4 * tid) = pf;
    l += __shfl_xor(l, 32);
    const float inv = 1.f / l;
    bf16* orow = O + (size_t)(32 * wave + r) * DM;
#pragma unroll
    for (int g = 0; g < 4; ++g) {
        *(u32x2*)(orow + 8 * g + 4 * h) = (u32x2){pk2(o0[4 * g] * inv, o0[4 * g + 1] * inv), pk2(o0[4 * g + 2] * inv, o0[4 * g + 3] * inv)};
        *(u32x2*)(orow + 32 + 8 * g + 4 * h) = (u32x2){pk2(o1[4 * g] * inv, o1[4 * g + 1] * inv), pk2(o1[4 * g + 2] * inv, o1[4 * g + 3] * inv)}; }
}
__device__ __forceinline__ void phase_attention(unsigned char* ws, LAS unsigned char* lds, const f32x2* tabg, const f32x2* tabm, const float* qn, int tid, int wave, int lane, int G) {
    const bf16* QC = (const bf16*)(ws + WS_C + C_QC); const bf16* MQ = (const bf16*)(ws + WS_C + C_MQ); const bf16* KN = (const bf16*)(ws + WS_C + C_KN);
    const bf16* VTM = (const bf16*)(ws + WS_C + C_VTM); const bf16* KC = (const bf16*)(ws + WS_A + A_KC); const bf16* VTC = (const bf16*)(ws + WS_A + A_VTC);
    const bf16* KR = (const bf16*)(ws + WS_A + A_KR); bf16* ATT = (bf16*)(ws + WS_B);
    constexpr float C_G = 0.125f * 1.4426950408889634f, C_M = 0.10206207261596577f * 1.4426950408889634f;
    {   ((LAS u32x4*)(lds + ATT_TAB_OFF))[tid] = ((const u32x4*)tabg)[tid];
        if (tid < 16) ((LAS f32x4*)(lds + ATT_TAB_OFF + 8192))[tid] = ((const f32x4*)qn)[tid];
        if (tid < 256) ((LAS u32x4*)(lds + ATT_TAB_OFF + 8448))[tid] = ((const u32x4*)tabm)[tid];
        __syncthreads(); }
    if (wave >= 4) __builtin_amdgcn_s_setprio(1);
    for (int i = blockIdx.x; i < 1280; i += G) {
        bool mla; int row0, key0, nkeys, hh, qpos0;
        if (i < 1024) { mla = i < 512; const int ii = i & 511, j = ii >> 3, b = j >> 3, qb = j & 7; hh = ii & 7;
            row0 = TP + b * SEQS + qb * 256; key0 = TP + b * KSEQ; nkeys = KSEQ; qpos0 = qb * 256; }
        else { mla = i < 1152; const int ii = (i - 1024) & 127, b = ii >> 3; hh = ii & 7; row0 = b * 256; key0 = row0; nkeys = 256; qpos0 = -1; }
        AttnNext nx;
        {   const int n = i + G < 1280 ? i + G : i; bool nm; int nr, nk, nh;
            if (n < 1024) { nm = n < 512; const int ii = n & 511, j = ii >> 3, b = j >> 3, qb = j & 7; nh = ii & 7; nr = TP + b * SEQS + qb * 256; nk = TP + b * KSEQ; }
            else { nm = n < 1152; const int ii = (n - 1024) & 127, b = ii >> 3; nh = ii & 7; nr = b * 256; nk = nr; }
            if (nm) { nx.Q = MQ + (size_t)nr * MQD + nh * 96; nx.ldq = MQD; nx.K = KN + (size_t)nk * 512 + nh * 64; nx.ldk = 512; nx.V = VTM + (size_t)(nh * 64) * TK + nk; nx.KR = KR + (size_t)nk * 32; }
            else { nx.Q = QC + (size_t)nr * 512 + nh * 64; nx.ldq = 512; nx.K = KC + (size_t)nk * 128 + (nh >> 2) * 64; nx.ldk = 128; nx.V = VTC + (size_t)((nh >> 2) * 64) * TK + nk; nx.KR = KR + (size_t)nk * 32; } }
        if (mla) attn_unit<true>(lds, MQ + (size_t)row0 * MQD + hh * 96, MQD, KN + (size_t)key0 * 512 + hh * 64, 512, KR + (size_t)key0 * 32, VTM + (size_t)(hh * 64) * TK + key0, nkeys,
                                 ATT + (size_t)row0 * DM + 512 + hh * 64, C_M, tabm, qpos0, tid, wave, lane, nx);
        else attn_unit<false>(lds, QC + (size_t)row0 * 512 + hh * 64, 512, KC + (size_t)key0 * 128 + (hh >> 2) * 64, 128, KR, VTC + (size_t)((hh >> 2) * 64) * TK + key0, nkeys,
                              ATT + (size_t)row0 * DM + hh * 64, C_G, tabm, qpos0, tid, wave, lane, nx);
    }
    if (wave >= 4) __builtin_amdgcn_s_setprio(0);
}

#define XB_TMO      128
#define XB_XCNT(j)  (256  + 64 * (j))
#define XB_XSUB(j)  (1280 + 64 * (j))
#define XB_XGEN(j)  (2304 + 64 * (j))
#define XB_TOP      3328
#define XB_TOPGEN   3392
#define XCD_BAR_WORDS 3456
#define XB_SPIN_CAP (1u << 18)

__device__ __forceinline__ unsigned xb_ld(unsigned* p)              { return __hip_atomic_load(p, __ATOMIC_RELAXED, __HIP_MEMORY_SCOPE_AGENT); }
__device__ __forceinline__ unsigned xb_add(unsigned* p, unsigned v) { return __hip_atomic_fetch_add(p, v, __ATOMIC_RELAXED, __HIP_MEMORY_SCOPE_AGENT); }
__device__ __forceinline__ unsigned xb_xcc_id() { return (unsigned)__builtin_amdgcn_s_getreg((3 << 11) | 20) & 0xFu; }
#define XB_SPIN(cond, bar) do { unsigned _sp = 0; while (cond) { __builtin_amdgcn_s_sleep(1); \
    if ((++_sp & 255u) == 0u) { if (xb_ld(&(bar)[XB_TMO])) break; if (_sp > XB_SPIN_CAP) { atomicAdd(&(bar)[XB_TMO], 1u); break; } } } } while (0)

struct XcdBarrier {
    unsigned* bar; unsigned x;
    volatile LAS unsigned* st;
};

__device__ __forceinline__ XcdBarrier xcd_barrier_post(unsigned* bar, volatile LAS unsigned* st) {
    XcdBarrier b; b.bar = bar; b.x = xb_xcc_id(); b.st = st;
    if (threadIdx.x == 0) (void)xb_add(&bar[XB_XCNT(b.x)], 1u);
    return b;
}
__device__ __forceinline__ void xcd_barrier_complete(unsigned* bar, unsigned x, unsigned& nloc, unsigned& nx) {
    const unsigned G = gridDim.x * gridDim.y * gridDim.z;
    unsigned sum, cnt, mine, sp = 0u;
    for (;;) {
        sum = 0u; cnt = 0u; mine = 0u;
#pragma unroll
        for (unsigned j = 0; j < 16; ++j) { const unsigned c = xb_ld(&bar[XB_XCNT(j)]); sum += c; cnt += (c > 0u) ? 1u : 0u; mine = (j == x) ? c : mine; }
        if (sum == G) break;
        __builtin_amdgcn_s_sleep(1);
        if ((++sp & 255u) == 0u) { if (xb_ld(&bar[XB_TMO])) break; if (sp > XB_SPIN_CAP) { atomicAdd(&bar[XB_TMO], 1u); break; } }
    }
    nloc = mine > 0u ? mine : 1u; nx = cnt > 0u ? cnt : 1u;
}

__device__ __forceinline__ void xcd_barrier(const XcdBarrier& b) {
    asm volatile("s_waitcnt vmcnt(0)" ::: "memory");
    __syncthreads();
    if (threadIdx.x == 64) {
        __builtin_amdgcn_fence(__ATOMIC_ACQUIRE, "agent");
        asm volatile("s_waitcnt vmcnt(0)" ::: "memory");
    }
    if (threadIdx.x == 0) {
        unsigned* bar = b.bar;
        __builtin_amdgcn_s_waitcnt(0);
        unsigned nloc = b.st[0], nx = b.st[1];
        const unsigned gen = b.st[2];
        if (nloc == 0u) { xcd_barrier_complete(bar, b.x, nloc, nx); b.st[0] = nloc; b.st[1] = nx; }
        b.st[2] = gen + 1u;
        const unsigned old = xb_add(&bar[XB_XSUB(b.x)], 1u);
        if (old + 1u == (gen + 1u) * nloc) {
            __builtin_amdgcn_fence(__ATOMIC_RELEASE, "agent");
            asm volatile("s_waitcnt vmcnt(0)" ::: "memory");
            (void)xb_add(&bar[XB_TOP], 1u);
        }
        const unsigned target = (gen + 1u) * nx;
        XB_SPIN(xb_ld(&bar[XB_TOP]) < target, bar);
        asm volatile("s_waitcnt vmcnt(0)" ::: "memory");
    }
    __syncthreads();
}

struct Args { const float* in[32]; float* out; unsigned char* ws; int ph_lo, ph_hi; };
constexpr int NPHASE = 18;

#ifndef PG8_SP2
#define PG8_SP2 true
#endif
#ifndef PG8_ALIGN
#define PG8_ALIGN true
#endif
struct FullOrder {
    pg8::StaticOrder S; int nt;
    __device__ __forceinline__ void init(int M, int N, int K, int G, int c) { S.init(M, N, G, c); nt = K / 64; }
    __device__ __forceinline__ bool next(int i, pg8::Unit& u) const { if (!S.next(i, u)) return false; u.koff = 0; u.nt = nt; u.part = 0; return true; }
    __device__ __forceinline__ void a_ready(const pg8::Unit&) const {}
    __device__ __forceinline__ void done(const pg8::Unit&) const {}
};
struct SplitTailOrder {
    int c, K;
    __device__ __forceinline__ bool next(int i, pg8::Unit& u) const {
        const int x = c & 7, slot = c >> 3;
        if (i == 0) { u.pm = 10 * x + (slot >> 2); u.pn = slot & 3; u.koff = 0; u.nt = K / 64; u.part = 0; return true; }
        if (i == 1) { u.pm = 10 * x + 8 + (slot >> 4); u.pn = (slot >> 2) & 3; u.part = slot & 3;
            if (K == 1024) { u.koff = 256 * u.part; u.nt = 4; } else { u.koff = 64 * (u.part < 2 ? 12 * u.part : 24 + 10 * (u.part - 2)); u.nt = u.part < 2 ? 12 : 10; }
            return true; }
        return false;
    }
    __device__ __forceinline__ void a_ready(const pg8::Unit&) const {}
    __device__ __forceinline__ void done(const pg8::Unit&) const {}
};
template <class Epi>
__device__ __forceinline__ void run_gemm(LAS unsigned char* lds, const bf16* A, const bf16* Bt, int M, int N, int K, int G, int cid, const Epi& E) {
    pg8::Gemm g{A, Bt, M, N, K}; FullOrder S; S.init(M, N, K, G, cid);
    pg8::gemm_phase<Epi, FullOrder, PG8_ALIGN, PG8_SP2>(lds, g, S, E);
}
template <class Epi>
__device__ __forceinline__ void run_gemm_split(LAS unsigned char* lds, const bf16* A, const bf16* Bt, int K, int cid, const Epi& E) {
    pg8::Gemm g{A, Bt, T, 1024, K}; SplitTailOrder S{cid, K};
    pg8::gemm_phase<Epi, SplitTailOrder, PG8_ALIGN, PG8_SP2>(lds, g, S, E);
}

__global__ void __launch_bounds__(NTHR, 2) fwd_kernel(Args args) {
    extern __shared__ __attribute__((aligned(16))) unsigned char lds_raw[];
    LAS unsigned char* lds = (LAS unsigned char*)lds_raw;
#if MK_CG_SYNC
    cg::grid_group grid = cg::this_grid();
#endif
    const int tid = threadIdx.x, lane = tid & 63, wave = __builtin_amdgcn_readfirstlane(tid >> 6);
    const int G = gridDim.x, bid = blockIdx.x, gw = bid * NWAVES + wave, ngw = G * NWAVES;
    unsigned char* ws = args.ws; const float* const* in = args.in; float* out = args.out;
    const int lo = args.ph_lo, hi = args.ph_hi;
#ifndef REP_PHASE
#define REP_PHASE (-1)
#define REP_N 1
#endif
#define PH(k) if (IN(k)) for (int rp_ = 0; rp_ < ((k) == REP_PHASE ? REP_N : 1); ++rp_)
#ifndef PH_MASK
#define PH_MASK 0x3ffff
#endif
#define IN(k) (((PH_MASK >> (k)) & 1) && lo <= (k) && (k) < hi)
#if MK_CG_SYNC
#define SEAM(k) do { if (IN(k) && IN((k) + 1)) grid.sync(); } while (0)
#else
    if (tid < 3) ((volatile LAS unsigned*)(lds + 131072))[tid] = 0u;
    __syncthreads();
    const XcdBarrier bar = xcd_barrier_post((unsigned*)(args.ws + WS_CTL), (volatile LAS unsigned*)(lds + 131072));
#ifdef PROBE_TS
    volatile LAS unsigned long long* tsl = (volatile LAS unsigned long long*)(lds + 131072 + 256);
    if (bid == 0 && tid == 0) tsl[0] = __builtin_amdgcn_s_memrealtime();
#ifndef PROBE_XBAR
#define PROBE_XBAR 0
#endif
#ifndef PROBE_SUB
#define PROBE_SUB 0.f
#endif
#define SEAM(k) do { if (IN(k) && IN((k) + 1)) { xcd_barrier(bar); for (int xb_ = 0; xb_ < PROBE_XBAR; ++xb_) xcd_barrier(bar); if (bid == 0 && tid == 0) tsl[(k) + 1] = __builtin_amdgcn_s_memrealtime(); } } while (0)
#else
#define SEAM(k) do { if (IN(k) && IN((k) + 1)) xcd_barrier(bar); } while (0)
#endif
#endif
    bf16* H = (bf16*)(ws + WS_A); bf16* OB = (bf16*)(ws + WS_A); bf16* MIX = (bf16*)(ws + WS_B); bf16* ATT = (bf16*)(ws + WS_B);
    bf16* U = (bf16*)(ws + WS_C); bf16* ACT = (bf16*)(ws + WS_C);
    bf16* SLABB = (bf16*)(ws + WS_B); bf16* SLABC = (bf16*)(ws + WS_C);
    const float* MOD0 = (const float*)(ws + WS_MOD); const float* MOD1 = MOD0 + 9 * 6144;
    const f32x2* tabg = (const f32x2*)(ws + WS_TABG); const f32x2* tabm = (const f32x2*)(ws + WS_TABM);
    float* Y = out + OUT_Y;

    PH(0) {
        if (G != 256 || bid < 128) p0_adaln(in, ws, lds, tid, wave, lane, bid, G == 256 ? 128 : G, 0, 128);
        if (bid == G - 1) p0_tables(in, ws, tid);
        if (G == 256) { if (bid >= 128) p0_weights(in, ws, (LAS float*)(lds + 57344 + wave * 8448), (bid - 128) * NWAVES + wave, 128 * NWAVES, lane, 0, P0_ITEMS_L0); }
        else p0_weights(in, ws, (LAS float*)(lds + 57344 + wave * 8448), gw, ngw, lane, 0, P0_ITEMS_L0);
    }
    SEAM(0);
    PH(1) phase_norm_in(in[0], in[1], in[10] + 0 * DM, MOD0, 0, H, row0_of(bid, wave), lane);
    SEAM(1);
    PH(2) run_gemm(lds, H, (const bf16*)(ws + WS_WCIN), T, CIN, 1024, G, bid, EpiConvIn{U, (const float*)(ws + WS_BCIN)});
    PH(2) { if (bid >= 32) p0_weights(in, ws, (LAS float*)(lds + wave * 8448), (bid - 32) * NWAVES + wave, (G - 32) * NWAVES, lane, P0_ITEMS_L0, P0_ITEMS_ALL);
            if (bid >= 128) { __syncthreads(); p0_adaln(in, ws, lds, tid, wave, lane, bid - 128, G - 128, 128, 256); } }
    SEAM(2);
    PH(3) phase_conv(U, MIX, in[13], in[15], in[16], in[17], in[18], lds, tid, wave, lane, G);
    SEAM(3);
    PH(4) run_gemm_split(lds, MIX, (const bf16*)(ws + WS_WCOUT), 1024, bid, EpiStore{OB, DM, in[20], SLABC});
    SEAM(4);
    PH(5) phase_post<true, false, true, true>(OB, SLABC, in[0], in[1], Y, in[11] + 0 * DM, MOD0, 2, in[10] + 1 * DM, MOD0, 3, H, row0_of(bid, wave), slab_off_of(bid), lane);
    SEAM(5);
    PH(6) run_gemm(lds, H, (const bf16*)(ws + WS_WGU0), T, 2 * FFN, 1024, G, bid, EpiSwiGLU{ACT});
    SEAM(6);
    PH(7) run_gemm_split(lds, ACT, (const bf16*)(ws + WS_WD0), FFN, bid, EpiStore{OB, DM, nullptr, SLABB});
    SEAM(7);
    PH(8) phase_post<true, true, true, true>(OB, SLABB, Y, Y + (size_t)TP * DM, Y, in[11] + 1 * DM, MOD0, 5, in[10] + 2 * DM, MOD1, 0, H, row0_of(bid, wave), slab_off_of(bid), lane);
    SEAM(8);
    PH(9) run_gemm(lds, H, (const bf16*)(ws + WS_WAIN), T, AINP, 1024, G, bid, EpiAttnIn{(bf16*)(ws + WS_C + C_QC), (bf16*)(ws + WS_C + C_U1)});
    SEAM(9);
    PH(10) phase_attn_rows((const bf16*)(ws + WS_C + C_U1), in[22], in[23], in[24], in[26], tabg, tabm,
                                (bf16*)(ws + WS_C + C_QC), (bf16*)(ws + WS_A + A_KC), (bf16*)(ws + WS_A + A_VTC), (bf16*)(ws + WS_A + A_QA), (bf16*)(ws + WS_A + A_CKV), (bf16*)(ws + WS_A + A_KR),
                                out + OUT_K, out + OUT_V, out + OUT_CKV, out + OUT_KR, in[2], in[3], in[4], in[5], lds, bid, tid, wave, lane);
    SEAM(10);
    PH(11) {
        run_gemm(lds, (const bf16*)(ws + WS_A + A_QA), (const bf16*)(ws + WS_WQB), T, MQD, QL, G, bid, EpiStore{(bf16*)(ws + WS_C + C_MQ), MQD, nullptr, nullptr});
        run_gemm(lds, (const bf16*)(ws + WS_A + A_CKV), (const bf16*)(ws + WS_WKN), TK, 512, KVL, G, (bid + 240) % G, EpiStore{(bf16*)(ws + WS_C + C_KN), 512, nullptr, nullptr});
        run_gemm(lds, (const bf16*)(ws + WS_WVT), (const bf16*)(ws + WS_A + A_CKV), 512, TK, KVL, G, (bid + 160) % G, EpiStore{(bf16*)(ws + WS_C + C_VTM), TK, nullptr, nullptr});
    }
    SEAM(11);
    PH(12) phase_attention(ws, lds, tabg, tabm, in[22], tid, wave, lane, G);
    SEAM(12);
    PH(13) run_gemm(lds, ATT, (const bf16*)(ws + WS_WAOUT), T, 1024, 1024, G, bid, EpiStore{OB, DM, nullptr, nullptr});
    SEAM(13);
    PH(14) phase_post<true, true, true, false>(OB, nullptr, Y, Y + (size_t)TP * DM, Y, in[11] + 2 * DM, MOD1, 2, in[10] + 3 * DM, MOD1, 3, H, row0_of(bid, wave), slab_off_of(bid), lane);
    SEAM(14);
    PH(15) run_gemm(lds, H, (const bf16*)(ws + WS_WGU1), T, 2 * FFN, 1024, G, bid, EpiSwiGLU{ACT});
    SEAM(15);
    PH(16) run_gemm_split(lds, ACT, (const bf16*)(ws + WS_WD1), FFN, bid, EpiStore{OB, DM, nullptr, SLABB});
    SEAM(16);
    PH(17) phase_post<false, true, false, true>(OB, SLABB, Y, Y + (size_t)TP * DM, Y, in[11] + 3 * DM, MOD1, 5, nullptr, nullptr, 0, nullptr, row0_of(bid, wave), slab_off_of(bid), lane);
#ifdef PROBE_TS
    xcd_barrier(bar);
    if (bid == 0) {
        if (tid == 0) tsl[18] = __builtin_amdgcn_s_memrealtime();
        __syncthreads();
        const unsigned long long t1 = tsl[PROBE_TS >= 18 ? 18 : PROBE_TS + 1], t0 = tsl[PROBE_TS >= 18 ? 0 : PROBE_TS];
        const float us = (float)(t1 - t0) * 0.01f - PROBE_SUB, eps = sqrtf(us * 1e-4f);
        float* okr = out + OUT_KR;
        for (int i = tid; i < TP * 32; i += NTHR) okr[i] *= (1.f + eps);
    }
#endif
#undef IN
#undef SEAM
}

#ifndef MK_ONE_LAUNCH
#define MK_ONE_LAUNCH 1
#endif
extern "C" void kernel_launch(void* const* d_in, const int* in_sizes, int n_in, void* d_out, int out_size, void* d_ws, size_t ws_size, hipStream_t stream) {
    static int grid = 0;
    if (grid == 0) {
        if (n_in != 32 || ws_size < WS_END) { fprintf(stderr, "kernel_launch: unexpected inputs (n_in %d, ws %zu)\n", n_in, ws_size); grid = -1; return; }
        int dev = 0, cus = 0, per_cu = 0;
        (void)hipGetDevice(&dev); (void)hipDeviceGetAttribute(&cus, hipDeviceAttributeMultiprocessorCount, dev);
        if (hipFuncSetAttribute((const void*)fwd_kernel, hipFuncAttributeMaxDynamicSharedMemorySize, LDS_BYTES) != hipSuccess) { fprintf(stderr, "kernel_launch: hipFuncSetAttribute failed\n"); grid = -1; return; }
        if (hipOccupancyMaxActiveBlocksPerMultiprocessor(&per_cu, (const void*)fwd_kernel, NTHR, LDS_BYTES) != hipSuccess || per_cu < 1) { fprintf(stderr, "kernel_launch: occupancy query says %d\n", per_cu); per_cu = 1; }
        (void)hipGetLastError();
        if (cus != 256) { fprintf(stderr, "kernel_launch: built for a 256-CU device (one workgroup per CU), found %d CUs; nothing launched\n", cus); grid = -1; return; }
        grid = cus;
    }
    if (grid < 0) return;
    Args a{};
    for (int i = 0; i < 32; ++i) a.in[i] = (const float*)d_in[i];
    a.out = (float*)d_out; a.ws = (unsigned char*)d_ws;
#if MK_ONE_LAUNCH && MK_CG_SYNC
    a.ph_lo = 0; a.ph_hi = NPHASE;
    void* kargs[] = {&a};
    hipError_t e = hipLaunchCooperativeKernel((const void*)fwd_kernel, dim3(grid), dim3(NTHR), kargs, LDS_BYTES, stream);
    if (e != hipSuccess) fprintf(stderr, "kernel_launch: cooperative launch failed: %s (grid %d)\n", hipGetErrorString(e), grid);
#elif MK_ONE_LAUNCH
    if (hipMemsetAsync((char*)d_ws + WS_CTL, 0, 16384, stream) != hipSuccess) { fprintf(stderr, "kernel_launch: memset failed\n"); return; }
    a.ph_lo = 0; a.ph_hi = NPHASE;
    hipLaunchKernelGGL(fwd_kernel, dim3(grid), dim3(NTHR), LDS_BYTES, stream, a);
#else
    for (int p = 0; p < NPHASE; ++p) { a.ph_lo = p; a.ph_hi = p + 1; hipLaunchKernelGGL(fwd_kernel, dim3(grid), dim3(NTHR), LDS_BYTES, stream, a); }
#endif
}
```

```cpp
#include <hip/hip_runtime.h>
#include <hip/hip_cooperative_groups.h>
#include <cstdio>
#include <cstdint>
namespace cg = cooperative_groups;
#ifndef MK_CG_SYNC
#define MK_CG_SYNC 0
#endif
namespace pg8 {
#define PG8_LAS __attribute__((address_space(3)))
typedef unsigned short bf16_t;
typedef short bf16x8 __attribute__((ext_vector_type(8)));
typedef float f32x4 __attribute__((ext_vector_type(4)));
typedef unsigned u32x4 __attribute__((ext_vector_type(4)));
constexpr int BM = 256, BK = 64, HALF = 128, HTB = HALF * BK * 2  , STAGE_BYTES = 8 * HTB, NXCD = 8, WGM = 4;

__host__ __device__ __forceinline__ int lds_byte(int r, int c) { const int st = (r >> 4) * 2 + (c >> 5), rr = r & 15, cc = c & 31, ob = rr * 64 + cc * 2; return st * 1024 + (ob ^ (((ob >> 9) & 1) << 5)); }
__host__ __device__ __forceinline__ void stage_rc(int b, int& R, int& C) { const int st = b / 1024, sb = b % 1024, swz = sb ^ (((sb >> 9) & 1) << 5); R = (st >> 1) * 16 + swz / 64; C = (st & 1) * 32 + (swz % 64) / 2; }
__host__ __device__ __forceinline__ int perm32(int rho) { const int n = rho >> 4, i = rho & 15; return 8 * (i >> 2) + 4 * n + (i & 3); }

struct Unit { int pm, pn, koff, nt, part; };
struct Gemm { const bf16_t* A; const bf16_t* Bt; int M, N, K; };

struct StaticOrder {
    int nM, nN, nwg, G, c;
    __host__ __device__ void init(int M, int N, int G_, int c_) { nM = M / BM; nN = N / BM; nwg = nM * nN; G = G_; c = c_; }
    __host__ __device__ bool next(int i, Unit& u) const {
        const long L = (long)i * G + c; if (L >= nwg) return false;
        int wgid = (int)L; { const int q = nwg / NXCD, r = nwg % NXCD, xcd = wgid % NXCD, off = wgid / NXCD; wgid = (xcd < r ? xcd * (q + 1) : r * (q + 1) + (xcd - r) * q) + off; }
        const int nig = WGM * nN, gid = wgid / nig, fm = gid * WGM, gsz = (nM - fm) < WGM ? (nM - fm) : WGM;
        u.pm = fm + ((wgid % nig) % gsz); u.pn = (wgid % nig) / gsz; return true;
    }
    __device__ __forceinline__ void a_ready(const Unit&) const {}
    __device__ __forceinline__ void done(const Unit&) const {}
};

__device__ __forceinline__ unsigned cvt_pk_bf16(float lo, float hi) { unsigned r; asm volatile("v_cvt_pk_bf16_f32 %0, %1, %2" : "=v"(r) : "v"(lo), "v"(hi)); return r; }
template <class Epi, class Sched, bool ALIGN_EPI = false, bool SP2 = false>
__device__ __forceinline__ void gemm_phase(PG8_LAS unsigned char* lds, const Gemm g, const Sched& S, const Epi& E) {
    const int tid = threadIdx.x, wid = __builtin_amdgcn_readfirstlane(tid >> 6), lane = tid & 63, wr = wid >> 2, wc = wid & 3, fr = lane & 15, fq = lane >> 4;
    const int K = g.K;
    unsigned voffA[2], voffB[2];
#pragma unroll
    for (int i = 0; i < 2; ++i) { int R, C; stage_rc(tid * 16 + i * 8192, R, C); const int Rb = Epi::PERM ? ((R & ~31) + perm32(R & 31)) : R;
        voffA[i] = (unsigned)(R * K + C) * 2u; voffB[i] = (unsigned)(Rb * K + C) * 2u; }
    const size_t kstep = (size_t)(BK * 2);
    const size_t hstep = (size_t)HALF * K * 2;
    const size_t tstep = 2 * hstep;
    const unsigned ldsw = (unsigned)wid * 1024u;
    const int aoff = lds_byte(wr * 64 + fr, fq * 8), boff = lds_byte(wc * 32 + fr, fq * 8);
#define PG8_SA(b, h) (((b) * 2 + (h)) * HTB)
#define PG8_SB(b, h) ((4 + (b) * 2 + (h)) * HTB)
#define PG8_STAGE(bufoff, gbase, voff) do { _Pragma("unroll") for (int _i = 0; _i < 2; ++_i) \
        __builtin_amdgcn_global_load_lds((const unsigned*)((const char*)(gbase) + (voff)[_i]), (PG8_LAS unsigned*)(lds + (bufoff) + ldsw + _i * 8192), 16, 0, 0); } while (0)
#define PG8_LDA(dst, b, h) do { _Pragma("unroll") for (int m = 0; m < 4; ++m) _Pragma("unroll") for (int k = 0; k < 2; ++k) dst[m][k] = *(const PG8_LAS bf16x8*)(lds + PG8_SA(b, h) + aoff + m * 2048 + k * 1024); } while (0)
#define PG8_LDB(dst, b, h) do { _Pragma("unroll") for (int n = 0; n < 2; ++n) _Pragma("unroll") for (int k = 0; k < 2; ++k) dst[n][k] = *(const PG8_LAS bf16x8*)(lds + PG8_SB(b, h) + boff + n * 2048 + k * 1024); } while (0)
#define PG8_MMA(ai, bj, At, Bt) do { __builtin_amdgcn_s_setprio(1); _Pragma("unroll") for (int m = 0; m < 4; ++m) _Pragma("unroll") for (int n = 0; n < 2; ++n) _Pragma("unroll") for (int k = 0; k < 2; ++k) \
        acc[ai][bj][m][n] = __builtin_amdgcn_mfma_f32_16x16x32_bf16(Bt[n][k], At[m][k], acc[ai][bj][m][n], 0, 0, 0); __builtin_amdgcn_s_setprio(0); } while (0)
#define PG8_WAIT_V(n) asm volatile("s_waitcnt vmcnt(" #n ")" ::: "memory")
#define PG8_WAIT_L(n) asm volatile("s_waitcnt lgkmcnt(" #n ")" ::: "memory")
#define PG8_BAR __builtin_amdgcn_s_barrier()
#define PG8_SCHED __builtin_amdgcn_sched_barrier(0)
    Unit cur, nxt; int ui = 0;
    if (!S.next(0, cur)) return;
    int nt = cur.nt;
    f32x4 acc[2][2][4][2];
#pragma unroll
    for (int a = 0; a < 2; ++a)
#pragma unroll
        for (int b = 0; b < 2; ++b)
#pragma unroll
            for (int m = 0; m < 4; ++m)
#pragma unroll
                for (int n = 0; n < 2; ++n) acc[a][b][m][n] = (f32x4){0.f, 0.f, 0.f, 0.f};
    bf16x8 At[4][2], B0[2][2], B1[2][2];
    const char* cA = (const char*)g.A + (size_t)cur.pm * tstep + (size_t)cur.koff * 2; const char* cB = (const char*)g.Bt + (size_t)cur.pn * tstep + (size_t)cur.koff * 2;
    S.a_ready(cur);
    if constexpr (SP2) {
        PG8_STAGE(PG8_SB(0, 0), cB, voffB); PG8_STAGE(PG8_SB(0, 1), cB + hstep, voffB); PG8_STAGE(PG8_SA(0, 0), cA, voffA); PG8_STAGE(PG8_SA(0, 1), cA + hstep, voffA);
        if (wr == 1) PG8_BAR;
        PG8_WAIT_V(2); PG8_BAR;
        PG8_STAGE(PG8_SB(1, 0), cB + kstep, voffB); PG8_STAGE(PG8_SA(1, 0), cA + kstep, voffA); PG8_STAGE(PG8_SB(1, 1), cB + hstep + kstep, voffB);
        PG8_WAIT_V(6); PG8_BAR;
    } else {
        PG8_STAGE(PG8_SB(0, 0), cB, voffB); PG8_STAGE(PG8_SA(0, 0), cA, voffA); PG8_STAGE(PG8_SB(0, 1), cB + hstep, voffB); PG8_STAGE(PG8_SA(0, 1), cA + hstep, voffA);
        if (wr == 1) PG8_BAR;
        PG8_WAIT_V(4); PG8_BAR;
        PG8_STAGE(PG8_SB(1, 0), cB + kstep, voffB); PG8_STAGE(PG8_SA(1, 0), cA + kstep, voffA); PG8_STAGE(PG8_SB(1, 1), cB + hstep + kstep, voffB);
        PG8_WAIT_V(6); PG8_BAR;
    }
    for (;;) {
        const bool has_next = S.next(ui + 1, nxt);
        const char* nA = has_next ? (const char*)g.A + (size_t)nxt.pm * tstep + (size_t)nxt.koff * 2 : cA; const char* nB = has_next ? (const char*)g.Bt + (size_t)nxt.pn * tstep + (size_t)nxt.koff * 2 : cB;
        for (int t = 0; t < nt; t += 2) {
            const bool last = (t == nt - 2);
            const char* a1 = cA + (size_t)(t + 1) * kstep;
            const char* a2 = last ? nA : cA + (size_t)(t + 2) * kstep; const char* b2 = last ? nB : cB + (size_t)(t + 2) * kstep;
            const char* a3 = a2 + kstep; const char* b3 = b2 + kstep;
            if (last && has_next) S.a_ready(nxt);
            if constexpr (SP2) {
            PG8_LDB(B0, 0, 0); PG8_LDB(B1, 0, 1); PG8_SCHED; PG8_LDA(At, 0, 0); PG8_STAGE(PG8_SA(1, 1), a1 + hstep, voffA);
            PG8_WAIT_V(8); PG8_WAIT_L(0); PG8_BAR; PG8_MMA(0, 0, At, B0); PG8_MMA(0, 1, At, B1); PG8_BAR; PG8_SCHED;
            PG8_LDA(At, 0, 1); PG8_STAGE(PG8_SB(0, 0), b2, voffB); PG8_STAGE(PG8_SB(0, 1), b2 + hstep, voffB); PG8_STAGE(PG8_SA(0, 0), a2, voffA);
            PG8_WAIT_V(8); PG8_WAIT_L(0); PG8_BAR; PG8_MMA(1, 0, At, B0); PG8_MMA(1, 1, At, B1); PG8_BAR; PG8_SCHED;
            PG8_LDB(B0, 1, 0); PG8_LDB(B1, 1, 1); PG8_SCHED; PG8_LDA(At, 1, 0); PG8_STAGE(PG8_SA(0, 1), a2 + hstep, voffA);
            PG8_WAIT_V(8); PG8_WAIT_L(0); PG8_BAR; PG8_MMA(0, 0, At, B0); PG8_MMA(0, 1, At, B1); PG8_BAR; PG8_SCHED;
            PG8_LDA(At, 1, 1); PG8_STAGE(PG8_SB(1, 0), b3, voffB); PG8_STAGE(PG8_SB(1, 1), b3 + hstep, voffB); PG8_STAGE(PG8_SA(1, 0), a3, voffA);
            PG8_WAIT_V(8); PG8_WAIT_L(0); PG8_BAR; PG8_MMA(1, 0, At, B0); PG8_MMA(1, 1, At, B1); PG8_BAR; PG8_SCHED;
            } else {
            PG8_LDB(B0, 0, 0); PG8_SCHED; PG8_LDA(At, 0, 0); PG8_STAGE(PG8_SA(1, 1), a1 + hstep, voffA);
            PG8_WAIT_L(8); PG8_BAR; PG8_WAIT_L(0); PG8_MMA(0, 0, At, B0); PG8_BAR; PG8_SCHED;
            PG8_LDB(B1, 0, 1); PG8_STAGE(PG8_SB(0, 0), b2, voffB);
            PG8_BAR; PG8_WAIT_L(0); PG8_MMA(0, 1, At, B1); PG8_BAR;
            PG8_LDA(At, 0, 1); PG8_STAGE(PG8_SA(0, 0), a2, voffA);
            PG8_BAR; PG8_WAIT_L(0); PG8_MMA(1, 0, At, B0); PG8_BAR; PG8_SCHED;
            PG8_STAGE(PG8_SB(0, 1), b2 + hstep, voffB);
            PG8_WAIT_V(6); PG8_BAR; PG8_MMA(1, 1, At, B1); PG8_BAR;
            PG8_LDB(B0, 1, 0); PG8_SCHED; PG8_LDA(At, 1, 0); PG8_STAGE(PG8_SA(0, 1), a2 + hstep, voffA);
            PG8_WAIT_L(8); PG8_BAR; PG8_WAIT_L(0); PG8_MMA(0, 0, At, B0); PG8_BAR; PG8_SCHED;
            PG8_LDB(B1, 1, 1); PG8_STAGE(PG8_SB(1, 0), b3, voffB);
            PG8_BAR; PG8_WAIT_L(0); PG8_MMA(0, 1, At, B1); PG8_BAR;
            PG8_LDA(At, 1, 1); PG8_STAGE(PG8_SA(1, 0), a3, voffA);
            PG8_BAR; PG8_WAIT_L(0); PG8_MMA(1, 0, At, B0); PG8_BAR; PG8_SCHED;
            PG8_STAGE(PG8_SB(1, 1), b3 + hstep, voffB);
            PG8_WAIT_V(6); PG8_BAR; PG8_MMA(1, 1, At, B1); PG8_BAR;
            }
        }
        if constexpr (ALIGN_EPI) { if (wr == 0) PG8_BAR; }
        if constexpr (!Epi::AFTER_DRAIN) { E(acc, cur, wr, wc, fr, fq); S.done(cur); }
        if (!has_next) break;
#pragma unroll
        for (int a = 0; a < 2; ++a)
#pragma unroll
            for (int b = 0; b < 2; ++b)
#pragma unroll
                for (int m = 0; m < 4; ++m)
#pragma unroll
                    for (int n = 0; n < 2; ++n) acc[a][b][m][n] = (f32x4){0.f, 0.f, 0.f, 0.f};
        cur = nxt; cA = nA; cB = nB; nt = cur.nt; ++ui;
        if constexpr (ALIGN_EPI) { if (wr == 1) PG8_BAR; }
    }
    PG8_WAIT_V(0);
    if constexpr (!ALIGN_EPI) { if (wr == 0) PG8_BAR; }
    PG8_BAR;
    if constexpr (Epi::AFTER_DRAIN) { E.fused(acc, cur, wr, wc, fr, fq, lds, wid, lane); S.done(cur); }
#undef PG8_SA
#undef PG8_SB
#undef PG8_STAGE
#undef PG8_LDA
#undef PG8_LDB
#undef PG8_MMA
#undef PG8_WAIT_V
#undef PG8_WAIT_L
#undef PG8_BAR
#undef PG8_SCHED
}
}

#define LAS __attribute__((address_space(3)))
typedef unsigned short bf16;
typedef float f32x4 __attribute__((ext_vector_type(4)));
typedef float f32x2 __attribute__((ext_vector_type(2)));
typedef float f32x16 __attribute__((ext_vector_type(16)));
typedef short bf16x8 __attribute__((ext_vector_type(8)));
typedef unsigned u32x4 __attribute__((ext_vector_type(4)));
typedef unsigned u32x2 __attribute__((ext_vector_type(2)));

constexpr int DM = 1024, TP = 4096, TS = 16384, T = TP + TS, SEQS = 2048, NBS = 8, PAST = 256;
constexpr int KSEQ = PAST + SEQS;
constexpr int TK = TP + NBS * KSEQ;
constexpr int FFN = 2816, CIN = 2560, CU2 = 1536, AIN = 1440, AINP = 1536, QL = 384, KVL = 256, MQD = 768;
constexpr float EPS = 1e-6f;
constexpr int NWAVES = 8, NTHR = 512;
constexpr int LDS_BYTES = 147456;
constexpr int SPLIT_ROW0 = 16384;
constexpr size_t SLAB_ELEMS = (size_t)(T - SPLIT_ROW0) * DM;

constexpr size_t MiB = (size_t)1 << 20;
constexpr size_t al256(size_t x) { return (x + 255) & ~(size_t)255; }
constexpr size_t WS_CTL = 0;
constexpr size_t WS_MOD = 1 * MiB;
constexpr size_t WS_TABG = WS_MOD + al256((size_t)2 * 9 * 6144 * 4);
constexpr size_t WS_TABM = WS_TABG + al256(64 * 16 * 8);
constexpr size_t WS_BCIN = WS_TABM + al256(64 * 8 * 8);
constexpr size_t WS_WCIN = 2 * MiB;
constexpr size_t WS_WCOUT = WS_WCIN + (size_t)2560 * 1024 * 2;
constexpr size_t WS_WGU0 = WS_WCOUT + (size_t)1024 * 1024 * 2;
constexpr size_t WS_WD0 = WS_WGU0 + (size_t)5632 * 1024 * 2;
constexpr size_t WS_WGU1 = WS_WD0 + (size_t)1024 * 2816 * 2;
constexpr size_t WS_WD1 = WS_WGU1 + (size_t)5632 * 1024 * 2;
constexpr size_t WS_WAIN = WS_WD1 + (size_t)1024 * 2816 * 2;
constexpr size_t WS_WQB = WS_WAIN + (size_t)1536 * 1024 * 2;
constexpr size_t WS_WKN = WS_WQB + (size_t)768 * 384 * 2;
constexpr size_t WS_WVT = WS_WKN + (size_t)512 * 256 * 2;
constexpr size_t WS_WAOUT = WS_WVT + (size_t)512 * 256 * 2;
constexpr size_t WS_WEND = WS_WAOUT + (size_t)1024 * 1024 * 2;
constexpr size_t WS_A = 50 * MiB;
constexpr size_t WS_B = 90 * MiB;
constexpr size_t WS_C = 130 * MiB;
constexpr size_t WS_END = 240 * MiB;
static_assert(WS_BCIN + 2560 * 4 <= WS_WCIN && WS_WEND <= WS_A, "ws map");
constexpr size_t A_QA = 0;
constexpr size_t A_CKV = A_QA + (size_t)T * QL * 2;
constexpr size_t A_KR = A_CKV + (size_t)TK * KVL * 2;
constexpr size_t A_KC = A_KR + (size_t)TK * 32 * 2;
constexpr size_t A_VTC = A_KC + (size_t)TK * 128 * 2;
static_assert(A_VTC + (size_t)128 * TK * 2 <= 40 * MiB, "region A");
constexpr int U1W = AINP - 512;
constexpr size_t C_U1 = 0;
constexpr size_t C_QC = (size_t)T * U1W * 2;
constexpr size_t C_VTM = C_QC + (size_t)T * 512 * 2;
constexpr size_t C_MQ = 0;
constexpr size_t C_KN = C_VTM + (size_t)512 * TK * 2;
static_assert((size_t)T * MQD * 2 <= C_QC && C_KN + (size_t)TK * 512 * 2 <= 110 * MiB, "region C");
constexpr size_t OUT_Y = 0, OUT_K = (size_t)T * DM, OUT_V = OUT_K + (size_t)TP * 128, OUT_CKV = OUT_V + (size_t)TP * 128, OUT_KR = OUT_CKV + (size_t)TP * 256;

typedef __bf16 bf16x2_t __attribute__((ext_vector_type(2)));
__device__ __forceinline__ unsigned pk2(float lo, float hi) { bf16x2_t v = {(__bf16)lo, (__bf16)hi}; return __builtin_bit_cast(unsigned, v); }
__device__ __forceinline__ bf16 f2bf(float x) { return (bf16)(pk2(x, 0.f) & 0xffffu); }
__device__ __forceinline__ float bf2f(bf16 b) { return __uint_as_float((unsigned)b << 16); }
__device__ __forceinline__ float bflo(unsigned w) { return __uint_as_float(w << 16); }
__device__ __forceinline__ float bfhi(unsigned w) { return __uint_as_float(w & 0xffff0000u); }
__device__ __forceinline__ float wave_sum(float v) {
#pragma unroll
    for (int o = 1; o < 64; o <<= 1) v += __shfl_xor(v, o);
    return v;
}
__device__ __forceinline__ float fsigmoid(float x) { return __builtin_amdgcn_rcpf(1.f + __builtin_amdgcn_exp2f(-1.4426950408889634f * x)); }
__device__ __forceinline__ float fsilu(float x) { return x * fsigmoid(x); }
__device__ __forceinline__ const float* xrow_in(const float* xp, const float* xs, int r) { return r < TP ? xp + (size_t)r * DM : xs + (size_t)(r - TP) * DM; }
__device__ __forceinline__ int cond_of(int r) { return r < TP ? 0 : 1 + ((r - TP) >> 11); }
__device__ __forceinline__ void unpack8(u32x4 w, float (&v)[8]) {
    v[0] = bflo(w.x); v[1] = bfhi(w.x); v[2] = bflo(w.y); v[3] = bfhi(w.y); v[4] = bflo(w.z); v[5] = bfhi(w.z); v[6] = bflo(w.w); v[7] = bfhi(w.w);
}
__device__ __forceinline__ u32x4 pack8(const float (&v)[8]) { u32x4 w; w.x = pk2(v[0], v[1]); w.y = pk2(v[2], v[3]); w.z = pk2(v[4], v[5]); w.w = pk2(v[6], v[7]); return w; }

struct EpiAttnIn {
    static constexpr bool PERM = true, AFTER_DRAIN = false;
    bf16* Q; bf16* U;
    __device__ __forceinline__ void operator()(const f32x4 (&acc)[2][2][4][2], const pg8::Unit& u, int wr, int wc, int fr, int fq) const {
        const bool isq = u.pn < 2; const int ldc = isq ? 512 : U1W;
        const int row0 = u.pm * 256 + wr * 64 + fr, col0 = (isq ? u.pn : u.pn - 2) * 256 + wc * 32 + 8 * fq;
        bf16* base = isq ? Q : U;
#pragma unroll
        for (int ai = 0; ai < 2; ++ai)
#pragma unroll
            for (int m = 0; m < 4; ++m) { bf16* rowp = base + (size_t)(row0 + ai * 128 + m * 16) * ldc + col0;
#pragma unroll
                for (int bj = 0; bj < 2; ++bj) { const f32x4 v0 = acc[ai][bj][m][0], v1 = acc[ai][bj][m][1];
                    u32x4 w; w.x = pk2(v0[0], v0[1]); w.y = pk2(v0[2], v0[3]); w.z = pk2(v1[0], v1[1]); w.w = pk2(v1[2], v1[3]);
                    *(u32x4*)(rowp + bj * 128) = w; } }
    }
};
struct EpiStore {
    static constexpr bool PERM = true, AFTER_DRAIN = false;
    bf16* O; int ldc; const float* bias; bf16* slab;
    __device__ __forceinline__ void operator()(const f32x4 (&acc)[2][2][4][2], const pg8::Unit& u, int wr, int wc, int fr, int fq) const {
        const int row0 = u.pm * 256 + wr * 64 + fr, col0 = u.pn * 256 + wc * 32 + 8 * fq;
        bf16* base = u.part == 0 ? O : slab + (size_t)(u.part - 1) * SLAB_ELEMS - (size_t)(2048 + 2048 * (u.pm / 10)) * DM;
        const bool hb = bias != nullptr && u.part == 0;
        f32x4 bv[2][2];
#pragma unroll
        for (int bj = 0; bj < 2; ++bj)
#pragma unroll
            for (int n = 0; n < 2; ++n) bv[bj][n] = hb ? *(const f32x4*)(bias + col0 + bj * 128 + 4 * n) : (f32x4){0.f, 0.f, 0.f, 0.f};
#pragma unroll
        for (int ai = 0; ai < 2; ++ai)
#pragma unroll
            for (int m = 0; m < 4; ++m) { bf16* rowp = base + (size_t)(row0 + ai * 128 + m * 16) * ldc + col0;
#pragma unroll
                for (int bj = 0; bj < 2; ++bj) { const f32x4 v0 = acc[ai][bj][m][0] + bv[bj][0], v1 = acc[ai][bj][m][1] + bv[bj][1];
                    u32x4 w; w.x = pk2(v0[0], v0[1]); w.y = pk2(v0[2], v0[3]); w.z = pk2(v1[0], v1[1]); w.w = pk2(v1[2], v1[3]);
                    *(u32x4*)(rowp + bj * 128) = w; } }
    }
};
struct EpiConvIn {
    static constexpr bool PERM = true, AFTER_DRAIN = false;
    bf16* O; const float* bias;
    __device__ __forceinline__ void operator()(const f32x4 (&acc)[2][2][4][2], const pg8::Unit& u, int wr, int wc, int fr, int fq) const {
        const int row0 = u.pm * 256 + wr * 64 + fr, cin = u.pn * 256 + wc * 32 + 8 * fq;
        if (u.pn < 2) {
#pragma unroll
            for (int ai = 0; ai < 2; ++ai)
#pragma unroll
                for (int m = 0; m < 4; ++m) { bf16* rowp = O + (size_t)(row0 + ai * 128 + m * 16) * CU2 + cin;
#pragma unroll
                    for (int bj = 0; bj < 2; ++bj) { const f32x4 v0 = acc[ai][bj][m][0], v1 = acc[ai][bj][m][1];
                        u32x4 w; w.x = pk2(v0[0], v0[1]); w.y = pk2(v0[2], v0[3]); w.z = pk2(v1[0], v1[1]); w.w = pk2(v1[2], v1[3]);
                        *(u32x4*)(rowp + bj * 128) = w; } }
        } else {
            const bool glu = u.pn >= 6; const int col0 = 512 + (u.pn - 2) * 128 + wc * 32 + 8 * fq;
            f32x4 ba[2], bg[2];
#pragma unroll
            for (int n = 0; n < 2; ++n) { ba[n] = glu ? *(const f32x4*)(bias + cin + 4 * n) : (f32x4){0.f, 0.f, 0.f, 0.f}; bg[n] = glu ? *(const f32x4*)(bias + cin + 128 + 4 * n) : (f32x4){0.f, 0.f, 0.f, 0.f}; }
#pragma unroll
            for (int ai = 0; ai < 2; ++ai)
#pragma unroll
                for (int m = 0; m < 4; ++m) { bf16* rowp = O + (size_t)(row0 + ai * 128 + m * 16) * CU2 + col0;
                    f32x4 o[2];
#pragma unroll
                    for (int n = 0; n < 2; ++n) { const f32x4 a = acc[ai][0][m][n] + ba[n], g = acc[ai][1][m][n] + bg[n];
                        o[n] = glu ? (f32x4){a[0] * fsigmoid(g[0]), a[1] * fsigmoid(g[1]), a[2] * fsigmoid(g[2]), a[3] * fsigmoid(g[3])} : a * g; }
                    u32x4 w; w.x = pk2(o[0][0], o[0][1]); w.y = pk2(o[0][2], o[0][3]); w.z = pk2(o[1][0], o[1][1]); w.w = pk2(o[1][2], o[1][3]);
                    *(u32x4*)rowp = w; }
        }
    }
};
struct EpiSwiGLU {
    static constexpr bool PERM = true, AFTER_DRAIN = false;
    bf16* O;
    __device__ __forceinline__ void operator()(const f32x4 (&acc)[2][2][4][2], const pg8::Unit& u, int wr, int wc, int fr, int fq) const {
        const int row0 = u.pm * 256 + wr * 64 + fr, col0 = u.pn * 128 + wc * 32 + 8 * fq;
#pragma unroll
        for (int ai = 0; ai < 2; ++ai)
#pragma unroll
            for (int m = 0; m < 4; ++m) { bf16* rowp = O + (size_t)(row0 + ai * 128 + m * 16) * FFN + col0;
                const f32x4 g0 = acc[ai][0][m][0], g1 = acc[ai][0][m][1], u0 = acc[ai][1][m][0], u1 = acc[ai][1][m][1];
                u32x4 w; w.x = pk2(fsilu(g0[0]) * u0[0], fsilu(g0[1]) * u0[1]); w.y = pk2(fsilu(g0[2]) * u0[2], fsilu(g0[3]) * u0[3]);
                w.z = pk2(fsilu(g1[0]) * u1[0], fsilu(g1[1]) * u1[1]); w.w = pk2(fsilu(g1[2]) * u1[2], fsilu(g1[3]) * u1[3]);
                *(u32x4*)rowp = w; }
    }
};
__device__ __forceinline__ int cin_src_col(int n) {
    if (n < 512) return n;
    const int q = n - 512, grp = q >> 10, t4 = (q >> 8) & 3, w = q & 255;
    return 512 + grp * 1024 + (w >> 7) * 512 + 128 * t4 + (w & 127);
}
struct TrItem { const float* src; int ldw; bf16* WT; int K, k0, drow0; };
__device__ __forceinline__ void tr_load(const TrItem& t, float (&tv)[32], int lane) {
#pragma unroll
    for (int i = 0; i < 32; ++i) { const int kk = 2 * i + (lane >> 5); tv[i] = t.src ? t.src[(size_t)(t.k0 + kk) * t.ldw] : 0.f; }
}
__device__ __forceinline__ void tr_store(const TrItem& t, const float (&tv)[32], LAS float* scr, int lane) {
#pragma unroll
    for (int i = 0; i < 32; ++i) { const int kk = 2 * i + (lane >> 5); scr[kk * 33 + (lane & 31)] = tv[i]; }
    asm volatile("s_waitcnt lgkmcnt(0)" ::: "memory");
    const int c = lane & 7;
#pragma unroll
    for (int j = 0; j < 4; ++j) { const int n = (lane >> 3) + 8 * j; const LAS float* s = scr + (8 * c) * 33 + n;
        u32x4 o; o.x = pk2(s[0 * 33], s[1 * 33]); o.y = pk2(s[2 * 33], s[3 * 33]); o.z = pk2(s[4 * 33], s[5 * 33]); o.w = pk2(s[6 * 33], s[7 * 33]);
        *(u32x4*)(t.WT + (size_t)(t.drow0 + n) * t.K + t.k0 + 8 * c) = o; }
    asm volatile("s_waitcnt lgkmcnt(0)" ::: "memory");
}
constexpr int P0_ITEMS_L0 = 16 * 80 + 16 * 32 + 16 * 176 + 44 * 32, P0_ITEMS_ALL = P0_ITEMS_L0 + 16 * 176 + 44 * 32 + 16 * 48 + 6 * 24 + 2 * 4 * 16 + 16 * 32;
__device__ __forceinline__ TrItem p0_decode(const float* const* in, unsigned char* ws, int it, int ln) {
    constexpr int I_CIN = 16 * 80, I_COUT = 16 * 32, I_GU = 16 * 176, I_D = 44 * 32, I_AIN = 16 * 48, I_QB = 6 * 24, I_KN = 4 * 16, I_AOUT = 16 * 32;
    constexpr int NITEMS = I_CIN + I_COUT + 2 * I_GU + 2 * I_D + I_AIN + I_QB + 2 * I_KN + I_AOUT;
    static_assert(NITEMS == P0_ITEMS_ALL, "item count");

        int r = it;
        if (r < I_CIN) { const int nblk = 80, kb = r / nblk, nb = r % nblk, n = 32 * nb + ln;
            return TrItem{in[12] + cin_src_col(n), CIN, (bf16*)(ws + WS_WCIN), 1024, 64 * kb, 32 * nb}; } r -= I_CIN;
        if (r < I_COUT) { const int nblk = 32, kb = r / nblk, nb = r % nblk, n = 32 * nb + ln;
            return TrItem{in[19] + n, 1024, (bf16*)(ws + WS_WCOUT), 1024, 64 * kb, 32 * nb}; } r -= I_COUT;
        if (r < 2 * (I_GU + I_D)) { const int l = r >= (I_GU + I_D) ? 1 : 0; r -= l * (I_GU + I_D);
            if (r < I_GU) { const int nblk = 176, kb = r / nblk, nb = r % nblk, n = 32 * nb + ln, t = n >> 8, w = n & 255;
                const float* src = (w < 128 ? in[29] : in[30]) + (size_t)l * 1024 * FFN + 128 * t + (w & 127);
                return TrItem{src, FFN, (bf16*)(ws + (l ? WS_WGU1 : WS_WGU0)), 1024, 64 * kb, 32 * nb}; }
            else { r -= I_GU; const int nblk = 32, kb = r / nblk, nb = r % nblk, n = 32 * nb + ln;
                return TrItem{in[31] + (size_t)l * FFN * 1024 + n, 1024, (bf16*)(ws + (l ? WS_WD1 : WS_WD0)), FFN, 64 * kb, 32 * nb}; }
            } r -= 2 * (I_GU + I_D);
        if (r < I_AIN) { const int nblk = 48, kb = r / nblk, nb = r % nblk, n = 32 * nb + ln;
            return TrItem{n < AIN ? in[21] + n : nullptr, AIN, (bf16*)(ws + WS_WAIN), 1024, 64 * kb, 32 * nb}; } r -= I_AIN;
        if (r < I_QB) { const int nblk = 24, kb = r / nblk, nb = r % nblk, n = 32 * nb + ln, hh = n / 96, w = n % 96;
            int sc = n; if (w >= 64) { const int e = w - 64, blk = e >> 4, loc = e & 15; sc = hh * 96 + 64 + 16 * blk + 8 * (loc & 1) + (loc >> 1); }
            return TrItem{in[25] + sc, MQD, (bf16*)(ws + WS_WQB), QL, 64 * kb, 32 * nb}; } r -= I_QB;
        if (r < I_KN) { const int nblk = 16, kb = r / nblk, nb = r % nblk, n = 32 * nb + ln;
            return TrItem{in[27] + (n >> 6) * 128 + (n & 63), 1024, (bf16*)(ws + WS_WKN), KVL, 64 * kb, 32 * nb}; } r -= I_KN;
        if (r < I_KN) { const int nblk = 16, kb = r / nblk, nb = r % nblk, n = 32 * nb + ln;
            return TrItem{in[27] + (n >> 6) * 128 + 64 + (n & 63), 1024, (bf16*)(ws + WS_WVT), KVL, 64 * kb, 32 * nb}; } r -= I_KN;
        { const int nblk = 32, kb = r / nblk, nb = r % nblk, n = 32 * nb + ln;
            return TrItem{in[28] + n, 1024, (bf16*)(ws + WS_WAOUT), 1024, 64 * kb, 32 * nb}; }
}
__device__ __forceinline__ void p0_weights(const float* const* in, unsigned char* ws, LAS float* scr, int gw, int ngw, int lane, int item_lo, int item_hi) {
    const int ln = lane & 31;
    int it = item_lo + gw;
    if (it >= item_hi) return;
    TrItem a = p0_decode(in, ws, it, ln); float ta[32], tb[32];
    tr_load(a, ta, lane);
    for (;;) {
        const int nx = it + ngw; const bool more = nx < item_hi;
        TrItem b = a;
        if (more) { b = p0_decode(in, ws, nx, ln); tr_load(b, tb, lane); }
        tr_store(a, ta, scr, lane);
        if (!more) break;
        a = b; it = nx;
#pragma unroll
        for (int i = 0; i < 32; ++i) ta[i] = tb[i];
    }
}
__device__ __forceinline__ void p0_adaln(const float* const* in, unsigned char* ws, LAS unsigned char* lds, int tid, int wave, int lane, int b0, int nb, int item_lo, int item_hi) {
    LAS float* sS = (LAS float*)lds;
    LAS float* red = (LAS float*)(lds + 1024 * 12 * 4);
    float* MOD = (float*)(ws + WS_MOD);
    {   float xv[18];
#pragma unroll
        for (int q = 0; q < 18; ++q) { const int i = tid + NTHR * q, cnd = i >> 10, k = i & 1023; xv[q] = cnd == 0 ? in[7][k] : in[6][(cnd - 1) * 1024 + k]; }
#pragma unroll
        for (int q = 0; q < 18; ++q) { const int i = tid + NTHR * q, cnd = i >> 10, k = i & 1023; sS[k * 12 + cnd] = fsilu(xv[q]); } }
    __syncthreads();
    const int la = lane < 48 ? lane : 47, g = la / 12, cq = la - 12 * g;
    const int krow0 = 128 * wave + 32 * g;
    for (int it = item_lo + b0; it < item_hi; it += nb) {
        const int l = it >> 7, n0 = 48 * (it & 127);
        const float* wp = in[8] + (size_t)l * 1024 * 6144 + n0 + 4 * cq + (size_t)krow0 * 6144;
        f32x4 acc[9];
#pragma unroll
        for (int c = 0; c < 9; ++c) acc[c] = (f32x4){0.f, 0.f, 0.f, 0.f};
#pragma unroll 1
        for (int kk = 0; kk < 32; kk += 16) {
            f32x4 wv[16];
#pragma unroll
            for (int q = 0; q < 16; ++q) wv[q] = *(const f32x4*)(wp + (size_t)(kk + q) * 6144);
#pragma unroll
            for (int q = 0; q < 16; ++q) { const LAS f32x4* s4 = (const LAS f32x4*)(sS + (krow0 + kk + q) * 12); const f32x4 s0 = s4[0], s1 = s4[1], s2 = s4[2];
                acc[0] += s0.x * wv[q]; acc[1] += s0.y * wv[q]; acc[2] += s0.z * wv[q]; acc[3] += s0.w * wv[q];
                acc[4] += s1.x * wv[q]; acc[5] += s1.y * wv[q]; acc[6] += s1.z * wv[q]; acc[7] += s1.w * wv[q]; acc[8] += s2.x * wv[q]; }
        }
        if (lane < 48) {
#pragma unroll
            for (int c = 0; c < 9; ++c) *(LAS f32x4*)(red + ((wave * 4 + g) * 9 + c) * 48 + 4 * cq) = acc[c]; }
        __syncthreads();
        if (tid < 432) { const int c = tid / 48, col = tid - 48 * c; float sum = in[9][l * 6144 + n0 + col];
#pragma unroll
            for (int pp = 0; pp < 32; ++pp) sum += red[(pp * 9 + c) * 48 + col];
            MOD[(size_t)(l * 9 + c) * 6144 + n0 + col] = sum; }
        __syncthreads();
    }
}
__device__ __forceinline__ void p0_tables(const float* const* in, unsigned char* ws, int tid) {
    f32x2* tabg = (f32x2*)(ws + WS_TABG); f32x2* tabm = (f32x2*)(ws + WS_TABM); float* bcin = (float*)(ws + WS_BCIN);
    for (int i = tid; i < 64 * 16; i += NTHR) { const int pos = i >> 4, f = i & 15; const float inv = exp2f(-(float)f * (13.287712379549449f / 16.f)), a = (float)pos * inv; tabg[i] = (f32x2){__cosf(a), __sinf(a)}; }
    for (int i = tid; i < 64 * 8; i += NTHR) { const int pos = i >> 3, f = i & 7; const float inv = exp2f(-(float)f * (13.287712379549449f / 8.f)), a = (float)pos * inv; tabm[i] = (f32x2){__cosf(a), __sinf(a)}; }
    static_assert(CIN == 5 * NTHR, "bias permutation loop");
    {   float bv_[5];
#pragma unroll
        for (int q = 0; q < 5; ++q) { const int sc = cin_src_col(tid + NTHR * q); bv_[q] = sc < 1536 ? 0.f : in[14][sc - 1536]; }
#pragma unroll
        for (int q = 0; q < 5; ++q) bcin[tid + NTHR * q] = bv_[q]; }
}

constexpr int NIT = T / (256 * NWAVES);
static_assert(NIT * 256 * NWAVES == T && NIT == 10, "row phases assume a 256-workgroup grid");
__device__ __forceinline__ int row0_of(int bid, int wave) { return 2560 * (bid & 7) + 8 * (bid >> 3) + wave; }
__device__ __forceinline__ int slab_off_of(int bid) { return 2048 + 2048 * (bid & 7); }
__device__ __forceinline__ f32x4 bf4(u32x2 w) { return (f32x4){bflo(w.x), bfhi(w.x), bflo(w.y), bfhi(w.y)}; }
__device__ __forceinline__ float sq4(f32x4 v) { return (v.x * v.x + v.y * v.y) + (v.z * v.z + v.w * v.w); }
__device__ __forceinline__ void phase_norm_in(const float* xp, const float* xs, const float* gpre, const float* modl, int sidx, bf16* H, int gw, int lane) {
    f32x4 g[4];
#pragma unroll
    for (int j = 0; j < 4; ++j) g[j] = ((const f32x4*)gpre + lane)[64 * j];
    f32x4 cur[4], nxt[4];
    { const f32x4* x4 = (const f32x4*)xrow_in(xp, xs, gw) + lane;
#pragma unroll
      for (int j = 0; j < 4; ++j) cur[j] = x4[64 * j]; }
    f32x4 sh[4], sc[4]; int pcnd = -1;
#pragma unroll
    for (int i = 0; i < NIT; ++i) {
        const int r = gw + 256 * i, cnd = cond_of(r);
        if (cnd != pcnd) {
            pcnd = cnd; const float* mb = modl + (size_t)cnd * 6144;
#pragma unroll
            for (int j = 0; j < 4; ++j) { sh[j] = ((const f32x4*)(mb + sidx * DM) + lane)[64 * j]; sc[j] = ((const f32x4*)(mb + (sidx + 1) * DM) + lane)[64 * j]; }
        }
        if (i + 1 < NIT) { const f32x4* x4 = (const f32x4*)xrow_in(xp, xs, r + 256) + lane;
#pragma unroll
            for (int j = 0; j < 4; ++j) nxt[j] = x4[64 * j]; }
        float ss = 0.f;
#pragma unroll
        for (int j = 0; j < 4; ++j) ss += sq4(cur[j]);
        const float rstd = rsqrtf(wave_sum(ss) * (1.f / DM) + EPS);
        u32x2* h2 = (u32x2*)(H + (size_t)r * DM) + lane;
#pragma unroll
        for (int j = 0; j < 4; ++j) { const f32x4 o = cur[j] * rstd * g[j] * (1.f + sc[j]) + sh[j]; h2[64 * j] = (u32x2){pk2(o.x, o.y), pk2(o.z, o.w)}; }
#pragma unroll
        for (int j = 0; j < 4; ++j) cur[j] = nxt[j];
    }
}
template <bool NEXT, bool XIN16, bool XOUT16, bool SLAB>
__device__ __forceinline__ void phase_post(const bf16* O, const bf16* slab, const float* xp, const float* xs, float* Y, const float* gpost, const float* modl, int gidx,
                                           const float* gpre_n, const float* modn, int sidx_n, bf16* H, int gw, int slab_off, int lane) {
    f32x4 gp[4], gn[4];
#pragma unroll
    for (int j = 0; j < 4; ++j) { gp[j] = ((const f32x4*)gpost + lane)[64 * j]; if (NEXT) gn[j] = ((const f32x4*)gpre_n + lane)[64 * j]; }
    u32x2 co[4], no[4], cxb[4], nxb[4], cs[3][4], ns[3][4]; f32x4 cxf[4], nxf[4];
#define POST_LOAD(rr, it, po, pxb, pxf, ps) do { \
        const u32x2* o2_ = (const u32x2*)(O + (size_t)(rr) * DM) + lane; \
        _Pragma("unroll") for (int j = 0; j < 4; ++j) po[j] = o2_[64 * j]; \
        if (XIN16) { const u32x2* b2_ = (const u32x2*)(Y + (size_t)(rr) * DM) + lane; _Pragma("unroll") for (int j = 0; j < 4; ++j) pxb[j] = b2_[64 * j]; } \
        else { const f32x4* x4_ = (const f32x4*)xrow_in(xp, xs, (rr)) + lane; _Pragma("unroll") for (int j = 0; j < 4; ++j) pxf[j] = x4_[64 * j]; } \
        if (SLAB && (it) >= 8) { _Pragma("unroll") for (int p = 0; p < 3; ++p) { const u32x2* s2_ = (const u32x2*)(slab + (size_t)p * SLAB_ELEMS + (size_t)((rr) - slab_off) * DM) + lane; \
            _Pragma("unroll") for (int j = 0; j < 4; ++j) ps[p][j] = s2_[64 * j]; } } } while (0)
    POST_LOAD(gw, 0, co, cxb, cxf, cs);
    f32x4 gt[4], sh[4], sc[4]; int pcnd = -1;
#pragma unroll
    for (int i = 0; i < NIT; ++i) {
        const int r = gw + 256 * i, cnd = cond_of(r);
        if (cnd != pcnd) {
            pcnd = cnd;
#pragma unroll
            for (int j = 0; j < 4; ++j) { gt[j] = ((const f32x4*)(modl + (size_t)cnd * 6144 + gidx * DM) + lane)[64 * j];
                if (NEXT) { sh[j] = ((const f32x4*)(modn + (size_t)cnd * 6144 + sidx_n * DM) + lane)[64 * j]; sc[j] = ((const f32x4*)(modn + (size_t)cnd * 6144 + (sidx_n + 1) * DM) + lane)[64 * j]; } }
        }
        if (i + 1 < NIT) POST_LOAD(r + 256, i + 1, no, nxb, nxf, ns);
        f32x4 o[4], x[4]; float ss = 0.f;
#pragma unroll
        for (int j = 0; j < 4; ++j) { o[j] = bf4(co[j]); x[j] = XIN16 ? bf4(cxb[j]) : cxf[j]; }
        if (SLAB && i >= 8) {
#pragma unroll
            for (int p = 0; p < 3; ++p)
#pragma unroll
                for (int j = 0; j < 4; ++j) o[j] = o[j] + bf4(cs[p][j]); }
#pragma unroll
        for (int j = 0; j < 4; ++j) ss += sq4(o[j]);
        const float ro = rsqrtf(wave_sum(ss) * (1.f / DM) + EPS);
        f32x4* y4 = (f32x4*)(Y + (size_t)r * DM) + lane; u32x2* yb2 = (u32x2*)(Y + (size_t)r * DM) + lane; float s2 = 0.f;
#pragma unroll
        for (int j = 0; j < 4; ++j) { x[j] = x[j] + gt[j] * (o[j] * ro * gp[j]);
            if (XOUT16) yb2[64 * j] = (u32x2){pk2(x[j].x, x[j].y), pk2(x[j].z, x[j].w)}; else y4[64 * j] = x[j];
            s2 += sq4(x[j]); }
        if (NEXT) {
            const float rx = rsqrtf(wave_sum(s2) * (1.f / DM) + EPS);
            u32x2* h2 = (u32x2*)(H + (size_t)r * DM) + lane;
#pragma unroll
            for (int j = 0; j < 4; ++j) { const f32x4 h = x[j] * rx * gn[j] * (1.f + sc[j]) + sh[j]; h2[64 * j] = (u32x2){pk2(h.x, h.y), pk2(h.z, h.w)}; }
        }
#pragma unroll
        for (int j = 0; j < 4; ++j) { co[j] = no[j]; cxb[j] = nxb[j]; cxf[j] = nxf[j];
#pragma unroll
            for (int p = 0; p < 3; ++p) cs[p][j] = ns[p][j]; }
    }
#undef POST_LOAD
}

__device__ __forceinline__ void phase_conv(const bf16* U, bf16* MIX, const float* sc_w, const float* dw_w, const float* dw_b, const float* ln_g, const float* ln_b,
                                           LAS unsigned char* lds, int tid, int wave, int lane, int G) {
    LAS bf16* zsb = (LAS bf16*)lds;
    LAS bf16* pbuf = (LAS bf16*)(lds + 62 * 1024);
    LAS bf16* zbuf = (LAS bf16*)(lds + 96 * 1024);
    LAS float* part = (LAS float*)(lds + 129 * 1024);
    LAS float* stat = part + 512;
    const int c = tid, srow = tid >> 6, ch8 = tid & 63;
    float w[31];
#pragma unroll
    for (int j = 0; j < 31; ++j) w[j] = dw_w[j * 512 + c];
    const float bdw = dw_b[c], lg = ln_g[c], lb = ln_b[c];
    u32x4 bv[8], ac[5];
#define CONV_LOAD(chn) do { const int r0n_ = 32 * (chn); const bf16* ub_ = U + (size_t)(r0n_ - 15 + srow) * CU2 + 1024 + 8 * ch8; \
        _Pragma("unroll") for (int p = 0; p < 8; ++p) { const int row = srow + 8 * p; bv[p] = *(const u32x4*)(ub_ + (size_t)(row < 62 ? 8 * p : 0) * CU2); } } while (0)
#define CONV_LOAD_A(chn) do { const int r0n_ = 32 * (chn); const bf16* ua_ = U + (size_t)(r0n_ - 1 + srow) * CU2 + 512 + 8 * ch8; \
        _Pragma("unroll") for (int p = 0; p < 5; ++p) { const int row = srow + 8 * p; ac[p] = *(const u32x4*)(ua_ + (size_t)(row < 34 ? 8 * p : 0) * CU2); } } while (0)
    const int cx = 80 * ((int)blockIdx.x & 7), cs0 = (int)blockIdx.x >> 3;
    CONV_LOAD(cx + cs0); CONV_LOAD_A(cx + cs0);
    for (int cs = cs0; cs < 80; cs += 32) { const int ch = cx + cs;
        const int r0 = 32 * ch;
        const int sq0 = r0 < TP ? (r0 & ~255) : TP + ((r0 - TP) & ~2047), sq1 = sq0 + (r0 < TP ? 256 : 2048);
#pragma unroll
        for (int p = 0; p < 8; ++p) { const int row = srow + 8 * p, rr = r0 - 15 + row; const bool ok = rr >= sq0 && rr < sq1;
            if (row < 62) *(LAS u32x4*)(zsb + row * 512 + 8 * ch8) = ok ? bv[p] : (u32x4){0u, 0u, 0u, 0u}; }
#pragma unroll
        for (int p = 0; p < 5; ++p) { const int row = srow + 8 * p, rr = r0 - 1 + row; const bool ok = rr >= sq0 && rr < sq1;
            if (row < 34) *(LAS u32x4*)(pbuf + row * 512 + 8 * ch8) = ok ? ac[p] : (u32x4){0u, 0u, 0u, 0u}; }
        __syncthreads();
        float z1[32];
        {   float z0[62];
#pragma unroll
            for (int j = 0; j < 62; ++j) z0[j] = bf2f(zsb[j * 512 + c]);
#pragma unroll
            for (int t = 0; t < 32; ++t) z1[t] = bdw;
#pragma unroll
            for (int j = 0; j < 31; ++j)
#pragma unroll
                for (int t = 0; t < 32; ++t) z1[t] += w[j] * z0[t + j]; }
        __builtin_amdgcn_sched_barrier(0);
        u32x4 gb[4];
        {   const bf16* ug = U + (size_t)(r0 + srow) * CU2 + 8 * ch8;
#pragma unroll
            for (int p = 0; p < 4; ++p) gb[p] = *(const u32x4*)(ug + (size_t)(8 * p) * CU2); }
        if (cs + 32 < 80) CONV_LOAD(ch + 32);
        __builtin_amdgcn_sched_barrier(0);
#pragma unroll
        for (int pass = 0; pass < 2; ++pass) { float v1[32];
#pragma unroll
            for (int t = 0; t < 32; ++t) v1[t] = pass ? z1[t] * z1[t] : z1[t];
#pragma unroll
            for (int st = 0; st < 5; ++st) { const int B = 32 >> st, n = 16 >> st; const bool hi = (lane & B) != 0;
#pragma unroll
                for (int i = 0; i < 16; ++i) if (i < n) { const float s1 = hi ? v1[i] : v1[i + n], k1 = hi ? v1[i + n] : v1[i]; v1[i] = k1 + __shfl_xor(s1, B); } }
            v1[0] += __shfl_xor(v1[0], 1);
            if ((lane & 1) == 0) part[pass * 256 + wave * 32 + (lane >> 1)] = v1[0];
            __builtin_amdgcn_sched_barrier(0); }
        __syncthreads();
        if (tid < 32) { float a = 0.f, b = 0.f;
#pragma unroll
            for (int q = 0; q < 8; ++q) { a += part[q * 32 + tid]; b += part[256 + q * 32 + tid]; }
            const float mean = a * (1.f / 512.f), var = fmaxf(b * (1.f / 512.f) - mean * mean, 0.f);
            stat[2 * tid] = mean; stat[2 * tid + 1] = rsqrtf(var + EPS); }
        __syncthreads();
#pragma unroll
        for (int t = 0; t < 32; ++t) { const f32x2 ms = *(const LAS f32x2*)(stat + 2 * t); const float y = (z1[t] - ms.x) * ms.y * lg + lb; zbuf[t * 512 + c] = f2bf(fsilu(y)); }
        float scw[3][8];
#pragma unroll
        for (int j = 0; j < 3; ++j) { const f32x4 a = *(const f32x4*)(sc_w + j * 512 + 8 * ch8), b = *(const f32x4*)(sc_w + j * 512 + 8 * ch8 + 4);
            scw[j][0] = a.x; scw[j][1] = a.y; scw[j][2] = a.z; scw[j][3] = a.w; scw[j][4] = b.x; scw[j][5] = b.y; scw[j][6] = b.z; scw[j][7] = b.w; }
#pragma unroll
        for (int p = 0; p < 4; ++p) { const int t = srow + 8 * p;
            float g[8], p0[8], p1[8], p2[8]; unpack8(gb[p], g);
            unpack8(*(const LAS u32x4*)(pbuf + t * 512 + 8 * ch8), p0); unpack8(*(const LAS u32x4*)(pbuf + (t + 1) * 512 + 8 * ch8), p1); unpack8(*(const LAS u32x4*)(pbuf + (t + 2) * 512 + 8 * ch8), p2);
#pragma unroll
            for (int k = 0; k < 8; ++k) g[k] = g[k] * (scw[0][k] * p0[k] + scw[1][k] * p1[k] + scw[2][k] * p2[k]);
            *(u32x4*)(MIX + (size_t)(r0 + t) * DM + 8 * ch8) = pack8(g); }
        __builtin_amdgcn_sched_barrier(0);
        if (cs + 32 < 80) CONV_LOAD_A(ch + 32);
        __syncthreads();
#pragma unroll
        for (int p = 0; p < 4; ++p) { const int t = srow + 8 * p; *(u32x4*)(MIX + (size_t)(r0 + t) * DM + 512 + 8 * ch8) = *(const LAS u32x4*)(zbuf + t * 512 + 8 * ch8); }
    }
#undef CONV_LOAD
#undef CONV_LOAD_A
}

__device__ __forceinline__ void rope_head64(float (&v)[8], int lane, const f32x2 (&cs)[8]) {
    const bool second = (lane & 2) != 0;
#pragma unroll
    for (int j = 0; j < 8; ++j) { const float pv = __shfl_xor(v[j], 2);
        v[j] = second ? v[j] * cs[j].x + pv * cs[j].y : v[j] * cs[j].x - pv * cs[j].y; }
}
__device__ __forceinline__ void phase_attn_rows(const bf16* U1, const float* qn, const float* kn, const float* qan, const float* kvan, const f32x2* tabg, const f32x2* tabm,
                                                bf16* QC, bf16* KC, bf16* VtC, bf16* QA, bf16* CKV, bf16* KR, float* o_k, float* o_v, float* o_ckv, float* o_kr,
                                                const float* c_k, const float* c_v, const float* c_ckv, const float* c_kr, LAS unsigned char* lds, int bid, int tid, int wave, int lane) {
    LAS bf16* vbuf = (LAS bf16*)lds;
    LAS f32x2* ltg = (LAS f32x2*)(lds + 8192);
    LAS f32x2* ltm = ltg + 64 * 16;
    { const u32x4* src = (const u32x4*)tabg; LAS u32x4* dst = (LAS u32x4*)(lds + 8192); dst[tid] = src[tid]; if (tid < 256) dst[512 + tid] = src[512 + tid]; }
    const int pb = (bid & 7) * 32 + (bid >> 3);
    const int gw = pb * NWAVES + wave, rb0 = 2560 * (bid & 7) + 8 * (bid >> 3), r0 = rb0 + wave, l2 = lane & 31,
    l3 = lane < 48 ? lane : 0, l4 = lane & 3, d0 = 8 * (lane & 7);
    const bool hi32 = lane >= 32, krl = lane >= 48 && lane < 52;
    float knv[8], qav[8], kvv[8];
#pragma unroll
    for (int j = 0; j < 8; ++j) { knv[j] = kn[d0 + j]; qav[j] = qan[8 * l3 + j]; kvv[j] = kvan[8 * l2 + j]; }
    u32x4 ckv_, cqa, nkv, nqa;
    const int okv = hi32 ? 640 + 8 * l2 : 8 * l2, oqa = lane < 48 ? 256 + 8 * lane : 896 + 8 * l4;
#define AR_LOAD(rr, pkv, pqa) do { const bf16* u_ = U1 + (size_t)(rr) * U1W; pkv = *(const u32x4*)(u_ + okv); pqa = *(const u32x4*)(u_ + oqa); } while (0)
    AR_LOAD(r0, ckv_, cqa);
    const f32x4 ck4 = *(const f32x4*)(c_k + (size_t)gw * 128 + 4 * l2), cv4 = *(const f32x4*)(c_v + (size_t)gw * 128 + 4 * l2), cc4 = *(const f32x4*)(c_ckv + (size_t)gw * 256 + 4 * lane);
    const float ckr1 = c_kr[(size_t)gw * 32 + l2];
    __syncthreads();
#pragma unroll 1
    for (int i = 0; i < NIT; ++i) {
        const int r = r0 + 256 * i;
        if (i + 1 < NIT) AR_LOAD(r + 256, nkv, nqa);
        const bool smp = r >= TP; const int ts = (r - TP) & 2047, prow = ts >> 6, pcol = ts & 63;
        const int krow = smp ? TP + ((r - TP) >> 11) * KSEQ + PAST + ts : r;
        f32x2 csg[8];
        { const LAS f32x4* t4 = (const LAS f32x4*)(ltg + ((lane & 4) ? pcol : prow) * 16 + 8 * (lane & 1));
#pragma unroll
          for (int j = 0; j < 4; ++j) { const f32x4 t = t4[j]; csg[2 * j] = (f32x2){t.x, t.y}; csg[2 * j + 1] = (f32x2){t.z, t.w}; } }
        float ssc;
        {
            float v[8], raw[8]; unpack8(ckv_, v);
            float ss = 0.f;
#pragma unroll
            for (int j = 0; j < 8; ++j) { raw[j] = v[j]; ss += v[j] * v[j]; }
            ssc = ss;
            ss += __shfl_xor(ss, 1); ss += __shfl_xor(ss, 2); ss += __shfl_xor(ss, 4);
            const float rstd = rsqrtf(ss * (1.f / 64.f) + EPS);
#pragma unroll
            for (int j = 0; j < 8; ++j) v[j] = v[j] * rstd * knv[j];
            if (lane < 16 && !smp) { float* ok = o_k + (size_t)r * 128 + 8 * lane; *(f32x4*)ok = (f32x4){v[0], v[1], v[2], v[3]}; *(f32x4*)(ok + 4) = (f32x4){v[4], v[5], v[6], v[7]}; }
            float vr[8];
#pragma unroll
            for (int j = 0; j < 8; ++j) vr[j] = v[j];
            rope_head64(vr, lane, csg);
#pragma unroll
            for (int j = 0; j < 8; ++j) v[j] = smp ? vr[j] : v[j];
            if (lane < 16) *(u32x4*)(KC + (size_t)krow * 128 + 8 * lane) = pack8(v);
            else if (lane < 32) { const int cv = 8 * (lane - 16);
                *(LAS u32x4*)(vbuf + ((i & 1) * 8 + wave) * 128 + cv) = ckv_;
                if (!smp) { float* ov = o_v + (size_t)r * 128 + cv; *(f32x4*)ov = (f32x4){raw[0], raw[1], raw[2], raw[3]}; *(f32x4*)(ov + 4) = (f32x4){raw[4], raw[5], raw[6], raw[7]}; } }
            const float sc = wave_sum(hi32 ? ssc : 0.f);
            const float rc = rsqrtf(sc * (1.f / 256.f) + EPS);
            if (hi32) { float c[8];
#pragma unroll
                for (int j = 0; j < 8; ++j) c[j] = raw[j] * rc * kvv[j];
                *(u32x4*)(CKV + (size_t)krow * KVL + 8 * l2) = pack8(c);
                if (!smp) { float* oc = o_ckv + (size_t)r * 256 + 8 * l2; *(f32x4*)oc = (f32x4){c[0], c[1], c[2], c[3]}; *(f32x4*)(oc + 4) = (f32x4){c[4], c[5], c[6], c[7]}; } }
        }
        {
            float v[8]; unpack8(cqa, v);
            float ss = 0.f;
#pragma unroll
            for (int j = 0; j < 8; ++j) ss += v[j] * v[j];
            ss = wave_sum(lane < 48 ? ss : 0.f);
            const float rstd = rsqrtf(ss * (1.f / 384.f) + EPS);
            if (lane < 48) { float a[8];
#pragma unroll
                for (int j = 0; j < 8; ++j) a[j] = v[j] * rstd * qav[j];
                *(u32x4*)(QA + (size_t)r * QL + 8 * lane) = pack8(a); }
            const int blk = l4 >> 1, pos = blk ? pcol : prow; const bool second = (l4 & 1) != 0;
            if (krl && !smp) { float* okr = o_kr + (size_t)r * 32 + 8 * l4; *(f32x4*)okr = (f32x4){v[0], v[1], v[2], v[3]}; *(f32x4*)(okr + 4) = (f32x4){v[4], v[5], v[6], v[7]}; }
            const LAS f32x4* t4 = (const LAS f32x4*)(ltm + pos * 8);
            unsigned wd[8];
#pragma unroll
            for (int j = 0; j < 4; ++j) { const f32x4 t = t4[j];
#pragma unroll
                for (int q = 0; q < 2; ++q) { const int jj = 2 * j + q; const float cx = q ? t.z : t.x, sx = q ? t.w : t.y;
                    const float pv = __shfl_xor(v[jj], 1);
                    const float rv = second ? v[jj] * cx + pv * sx : v[jj] * cx - pv * sx; const float o = smp ? rv : v[jj];
                    const float po = __shfl_xor(o, 1);
                    wd[jj] = second ? pk2(po, o) : pk2(o, po); } }
            if (krl) *(u32x4*)(KR + (size_t)krow * 32 + 16 * blk + (second ? 8 : 0)) = second ? (u32x4){wd[4], wd[5], wd[6], wd[7]} : (u32x4){wd[0], wd[1], wd[2], wd[3]};
        }
        __syncthreads();
        if (tid < 128) {
            const int rb = rb0 + 256 * i, kb = rb >= TP ? TP + ((rb - TP) >> 11) * KSEQ + PAST + ((rb - TP) & 2047) : rb;
            const LAS bf16* vp = vbuf + (i & 1) * 1024 + tid; u32x4 w;
            w.x = (unsigned)vp[0] | ((unsigned)vp[128] << 16); w.y = (unsigned)vp[256] | ((unsigned)vp[384] << 16); w.z = (unsigned)vp[512] | ((unsigned)vp[640] << 16); w.w = (unsigned)vp[768] | ((unsigned)vp[896] << 16);
            *(u32x4*)(VtC + (size_t)tid * TK + kb) = w; }
        ckv_ = nkv; cqa = nqa;
    }
#undef AR_LOAD
    {   const int cr = gw, krow = TP + (cr >> 8) * KSEQ + (cr & 255);
        __syncthreads();
        if (lane < 32) { *(u32x2*)(KC + (size_t)krow * 128 + 4 * lane) = (u32x2){pk2(ck4.x, ck4.y), pk2(ck4.z, ck4.w)};
            *(LAS u32x2*)(vbuf + wave * 128 + 4 * lane) = (u32x2){pk2(cv4.x, cv4.y), pk2(cv4.z, cv4.w)};
            const int e = lane, blk = e >> 4, loc = e & 15; KR[(size_t)krow * 32 + 16 * blk + 2 * (loc & 7) + (loc >> 3)] = f2bf(ckr1); }
        *(u32x2*)(CKV + (size_t)krow * KVL + 4 * lane) = (u32x2){pk2(cc4.x, cc4.y), pk2(cc4.z, cc4.w)};
        __syncthreads();
        if (tid < 128) { const int cb = pb * NWAVES, kb = TP + (cb >> 8) * KSEQ + (cb & 255);
            const LAS bf16* vp = vbuf + tid; u32x4 w;
            w.x = (unsigned)vp[0] | ((unsigned)vp[128] << 16); w.y = (unsigned)vp[256] | ((unsigned)vp[384] << 16); w.z = (unsigned)vp[512] | ((unsigned)vp[640] << 16); w.w = (unsigned)vp[768] | ((unsigned)vp[896] << 16);
            *(u32x4*)(VtC + (size_t)tid * TK + kb) = w; }
        __syncthreads();
    }
}

#define MFMA32(a, b, c) __builtin_amdgcn_mfma_f32_32x32x16_bf16((a), (b), (c), 0, 0, 0)
template <bool MLA, int ABL>
__device__ __forceinline__ void attn_tile(const LAS unsigned char* kb, const LAS unsigned char* rb, const LAS unsigned char* vb, const bf16x8 (&qf)[MLA ? 6 : 4],
                                          f32x16& o0, f32x16& o1, float& m, float& l, float c, int r, int h) {
    constexpr int NQ = MLA ? 6 : 4;
    f32x16 p0, p1;
#pragma unroll
    for (int i = 0; i < 16; ++i) { p0[i] = 0.f; p1[i] = 0.f; }
#pragma unroll
    for (int ks = 0; ks < 4; ++ks) { const bf16x8 a0 = *(const LAS bf16x8*)(kb + r * 144 + ks * 32 + h * 16), a1 = *(const LAS bf16x8*)(kb + (32 + r) * 144 + ks * 32 + h * 16);
        p0 = MFMA32(a0, qf[ks], p0); p1 = MFMA32(a1, qf[ks], p1); }
    if (MLA) {
#pragma unroll
        for (int ks = 0; ks < 2; ++ks) { const bf16x8 a0 = *(const LAS bf16x8*)(rb + r * 80 + ks * 32 + h * 16), a1 = *(const LAS bf16x8*)(rb + (32 + r) * 80 + ks * 32 + h * 16);
            p0 = MFMA32(a0, qf[NQ - 2 + ks], p0); p1 = MFMA32(a1, qf[NQ - 2 + ks], p1); } }
    bf16x8 vf[2][2][2];
#pragma unroll
    for (int t = 0; t < 2; ++t)
#pragma unroll
        for (int s = 0; s < 2; ++s)
#pragma unroll
            for (int dh = 0; dh < 2; ++dh) vf[t][s][dh] = *(const LAS bf16x8*)(vb + (32 * dh + r) * 144 + 64 * t + 32 * s + 16 * h);
    __builtin_amdgcn_sched_barrier(0);
    if (ABL != 1 && ABL != 3) {
    float mx = p0[0];
#pragma unroll
    for (int i = 1; i < 16; ++i) mx = fmaxf(mx, p0[i]);
#pragma unroll
    for (int i = 0; i < 16; ++i) mx = fmaxf(mx, p1[i]);
    mx = fmaxf(mx, __shfl_xor(mx, 32));
    if (!__all((mx - m) * c <= 8.f)) {
        const float mn = fmaxf(m, mx), alpha = __builtin_amdgcn_exp2f((m - mn) * c); m = mn; l *= alpha;
#pragma unroll
        for (int i = 0; i < 16; ++i) { o0[i] *= alpha; o1[i] *= alpha; }
    }
    const float mc = -m * c;
    float ps = 0.f;
#pragma unroll
    for (int i = 0; i < 16; ++i) { p0[i] = __builtin_amdgcn_exp2f(fmaf(p0[i], c, mc)); ps += p0[i]; }
#pragma unroll
    for (int i = 0; i < 16; ++i) { p1[i] = __builtin_amdgcn_exp2f(fmaf(p1[i], c, mc)); ps += p1[i]; }
    l += ps;
    }
    bf16x8 pb[2][2];
#pragma unroll
    for (int s = 0; s < 2; ++s) {
        u32x4 w0; w0.x = pk2(p0[8 * s + 0], p0[8 * s + 1]); w0.y = pk2(p0[8 * s + 2], p0[8 * s + 3]); w0.z = pk2(p0[8 * s + 4], p0[8 * s + 5]); w0.w = pk2(p0[8 * s + 6], p0[8 * s + 7]);
        u32x4 w1; w1.x = pk2(p1[8 * s + 0], p1[8 * s + 1]); w1.y = pk2(p1[8 * s + 2], p1[8 * s + 3]); w1.z = pk2(p1[8 * s + 4], p1[8 * s + 5]); w1.w = pk2(p1[8 * s + 6], p1[8 * s + 7]);
        pb[0][s] = __builtin_bit_cast(bf16x8, w0); pb[1][s] = __builtin_bit_cast(bf16x8, w1); }
    __builtin_amdgcn_sched_barrier(0);
#pragma unroll
    for (int t = 0; t < 2; ++t)
#pragma unroll
        for (int s = 0; s < 2; ++s) {
            o0 = MFMA32(vf[t][s][0], pb[t][s], o0);
            o1 = MFMA32(vf[t][s][1], pb[t][s], o1); }
    __builtin_amdgcn_sched_barrier(0);
}
constexpr int ATT_TAB_OFF = 100 * 1024;
struct AttnNext { const bf16* Q; const bf16* K; const bf16* V; const bf16* KR; int ldq, ldk; };
template <bool MLA, int ABL = 0>
__device__ __forceinline__ void attn_unit(LAS unsigned char* lds, const bf16* Q, int ldq, const bf16* K, int ldk, const bf16* KRp, const bf16* Vt, int nkeys, bf16* O, float c,
                                          const f32x2* tabm, int qpos0, int tid, int wave, int lane, const AttnNext& nx) {
    constexpr int NQ = MLA ? 6 : 4;
    constexpr int KB_SZ = 64 * 144, KR_OFF = 4 * KB_SZ, KR_SZ = 64 * 80, VT_OFF = KR_OFF + 4 * KR_SZ, VT_SZ = 64 * 144;
    const int r = lane & 31, h = lane >> 5;
    const int skey = tid >> 3, sch = tid & 7;
    const bf16* kg = K + (size_t)skey * ldk + 8 * sch;
    const bf16* vg = Vt + (size_t)skey * TK + 8 * sch;
    const bf16* rg = KRp + (size_t)(tid >> 2) * 32 + 8 * (tid & 3);
    const int kw = skey * 144 + sch * 16, vw = skey * 144 + (sch >> 1) * 32 + (sch & 1) * 8, rw = (tid >> 2) * 80 + (tid & 3) * 16;
    const int np = nkeys >> 7;
    u32x4 kreg[2], vreg[2], rreg[2];
#define AT_LOAD(pp) do { _Pragma("unroll") for (int q_ = 0; q_ < 2; ++q_) { const int tt_ = 2 * (pp) + q_; kreg[q_] = *(const u32x4*)(kg + (size_t)tt_ * 64 * ldk); vreg[q_] = *(const u32x4*)(vg + tt_ * 64); \
        if (MLA && tid < 256) rreg[q_] = *(const u32x4*)(rg + (size_t)tt_ * 64 * 32); } } while (0)
#define AT_WRITE(pr) do { _Pragma("unroll") for (int q_ = 0; q_ < 2; ++q_) { const int sl_ = 2 * (pr) + q_; *(LAS u32x4*)(lds + sl_ * KB_SZ + kw) = kreg[q_]; \
        *(LAS u32x2*)(lds + VT_OFF + sl_ * VT_SZ + vw) = (u32x2){vreg[q_].x, vreg[q_].y}; *(LAS u32x2*)(lds + VT_OFF + sl_ * VT_SZ + vw + 16) = (u32x2){vreg[q_].z, vreg[q_].w}; \
        if (MLA && tid < 256) *(LAS u32x4*)(lds + KR_OFF + sl_ * KR_SZ + rw) = rreg[q_]; } } while (0)
    AT_LOAD(0);
    bf16x8 qf[NQ];
    { const bf16* qrow = Q + (size_t)(32 * wave + r) * ldq + 8 * h;
#pragma unroll
      for (int ks = 0; ks < NQ; ++ks) qf[ks] = *(const bf16x8*)(qrow + 16 * ks); }
    if (MLA && qpos0 >= 0) {
        const int ts = qpos0 + 32 * wave + r, prow = ts >> 6, pcol = ts & 63;
#pragma unroll
        for (int blk = 0; blk < 2; ++blk) { const u32x4 w = __builtin_bit_cast(u32x4, qf[NQ - 2 + blk]); float v[8]; unpack8(w, v); const int pos = blk ? pcol : prow;
#pragma unroll
            for (int jj = 0; jj < 4; ++jj) { const f32x2 cs = ((const LAS f32x2*)(lds + ATT_TAB_OFF + 8448))[pos * 8 + 4 * h + jj]; const float x1 = v[2 * jj], x2 = v[2 * jj + 1]; v[2 * jj] = x1 * cs.x - x2 * cs.y; v[2 * jj + 1] = x2 * cs.x + x1 * cs.y; }
            qf[NQ - 2 + blk] = __builtin_bit_cast(bf16x8, pack8(v)); }
    }
    const LAS f32x2* ltg = (const LAS f32x2*)(lds + ATT_TAB_OFF); const LAS float* lqn = (const LAS float*)(lds + ATT_TAB_OFF + 8192);
    if (!MLA) {
        float v[4][8];
#pragma unroll
        for (int ks = 0; ks < 4; ++ks) unpack8(__builtin_bit_cast(u32x4, qf[ks]), v[ks]);
        float ss = 0.f;
#pragma unroll
        for (int ks = 0; ks < 4; ++ks)
#pragma unroll
            for (int j = 0; j < 8; ++j) ss += v[ks][j] * v[ks][j];
        ss += __shfl_xor(ss, 32);
        const float rstd = rsqrtf(ss * (1.f / 64.f) + EPS);
#pragma unroll
        for (int ks = 0; ks < 4; ++ks) { const f32x4 g0 = *(const LAS f32x4*)(lqn + 16 * ks + 8 * h), g1 = *(const LAS f32x4*)(lqn + 16 * ks + 8 * h + 4);
            v[ks][0] *= rstd * g0.x; v[ks][1] *= rstd * g0.y; v[ks][2] *= rstd * g0.z; v[ks][3] *= rstd * g0.w; v[ks][4] *= rstd * g1.x; v[ks][5] *= rstd * g1.y; v[ks][6] *= rstd * g1.z; v[ks][7] *= rstd * g1.w; }
        if (qpos0 >= 0) {
            const int ts = qpos0 + 32 * wave + r, prow = ts >> 6, pcol = ts & 63;
#pragma unroll
            for (int hf = 0; hf < 2; ++hf) { const LAS f32x2* tg = ltg + (hf ? pcol : prow) * 16 + 8 * h;
#pragma unroll
                for (int j = 0; j < 8; ++j) { const f32x2 cs = tg[j]; const float x1 = v[2 * hf][j], x2 = v[2 * hf + 1][j]; v[2 * hf][j] = x1 * cs.x - x2 * cs.y; v[2 * hf + 1][j] = x2 * cs.x + x1 * cs.y; } }
        }
#pragma unroll
        for (int ks = 0; ks < 4; ++ks) qf[ks] = __builtin_bit_cast(bf16x8, pack8(v[ks]));
    }
    f32x16 o0, o1;
#pragma unroll
    for (int i = 0; i < 16; ++i) { o0[i] = 0.f; o1[i] = 0.f; }
    float m = -1e30f, l = 0.f; unsigned pf = 0u;
    AT_WRITE(0);
    __syncthreads();
    for (int j = 0; j < np; ++j) {
        const int cur = j & 1; const bool more = j + 1 < np;
        if (ABL != 3) { if (more) AT_LOAD(j + 1); }
        if (!more) {
            const unsigned* pa = (const unsigned*)(nx.Q + (size_t)(tid >> 1) * nx.ldq + (tid & 1) * 64);
            const unsigned* pb = tid < 128 ? (const unsigned*)(nx.K + (size_t)tid * nx.ldk)
                               : tid < 256 ? (const unsigned*)(nx.V + (size_t)((tid - 128) >> 1) * TK + (tid & 1) * 64)
                               : tid < 320 ? (const unsigned*)(nx.KR + (size_t)(2 * (tid - 256)) * 32) : pa;
            pf = *pa ^ *pb; }
#pragma unroll
        for (int q = 0; q < 2; ++q) { const int sl = 2 * cur + q;
            attn_tile<MLA, ABL>(lds + sl * KB_SZ, lds + KR_OFF + sl * KR_SZ, lds + VT_OFF + sl * VT_SZ, qf, o0, o1, m, l, c, r, h); }
        if (ABL != 3) { if (more) AT_WRITE(cur ^ 1);
        __syncthreads(); }
    }
#undef AT_LOAD
#undef AT_WRITE
    *(LAS unsigned*)(lds + 96 * 1024 + 4 * tid) = pf;
    l += __shfl_xor(l, 32);
    const float inv = 1.f / l;
    bf16* orow = O + (size_t)(32 * wave + r) * DM;
#pragma unroll
    for (int hf = 0; hf < 2; ++hf)
#pragma unroll
        for (int pp = 0; pp < 2; ++pp) {
            const int ga = 2 * pp, gb2 = 2 * pp + 1;
#define OV(g_, k_) ((hf ? o1[4 * (g_) + (k_)] : o0[4 * (g_) + (k_)]) * inv)
            const u32x2 wa = (u32x2){pk2(OV(ga, 0), OV(ga, 1)), pk2(OV(ga, 2), OV(ga, 3))}, wb = (u32x2){pk2(OV(gb2, 0), OV(gb2, 1)), pk2(OV(gb2, 2), OV(gb2, 3))};
#undef OV
            const u32x2 snd = h ? wa : wb;
            const u32x2 rcv = (u32x2){(unsigned)__shfl_xor((int)snd.x, 32), (unsigned)__shfl_xor((int)snd.y, 32)};
            const u32x4 w = h ? (u32x4){rcv.x, rcv.y, wb.x, wb.y} : (u32x4){wa.x, wa.y, rcv.x, rcv.y};
            *(u32x4*)(orow + 32 * hf + 16 * pp + 8 * h) = w; }
}
__device__ __forceinline__ void phase_attention(unsigned char* ws, LAS unsigned char* lds, const f32x2* tabg, const f32x2* tabm, const float* qn, int tid, int wave, int lane, int G) {
    const bf16* QC = (const bf16*)(ws + WS_C + C_QC); const bf16* MQ = (const bf16*)(ws + WS_C + C_MQ); const bf16* KN = (const bf16*)(ws + WS_C + C_KN);
    const bf16* VTM = (const bf16*)(ws + WS_C + C_VTM); const bf16* KC = (const bf16*)(ws + WS_A + A_KC); const bf16* VTC = (const bf16*)(ws + WS_A + A_VTC);
    const bf16* KR = (const bf16*)(ws + WS_A + A_KR); bf16* ATT = (bf16*)(ws + WS_B);
    constexpr float C_G = 0.125f * 1.4426950408889634f, C_M = 0.10206207261596577f * 1.4426950408889634f;
    {   ((LAS u32x4*)(lds + ATT_TAB_OFF))[tid] = ((const u32x4*)tabg)[tid];
        if (tid < 16) ((LAS f32x4*)(lds + ATT_TAB_OFF + 8192))[tid] = ((const f32x4*)qn)[tid];
        if (tid < 256) ((LAS u32x4*)(lds + ATT_TAB_OFF + 8448))[tid] = ((const u32x4*)tabm)[tid];
        __syncthreads(); }
    if (wave >= 4) __builtin_amdgcn_s_setprio(1);
    for (int i = blockIdx.x; i < 1280; i += G) {
        bool mla; int row0, key0, nkeys, hh, qpos0;
        if (i < 1024) { mla = i < 512; const int ii = i & 511, j = ii >> 3, b = j >> 3, qb = j & 7; hh = ii & 7;
            row0 = TP + b * SEQS + qb * 256; key0 = TP + b * KSEQ; nkeys = KSEQ; qpos0 = qb * 256; }
        else { mla = i < 1152; const int ii = (i - 1024) & 127, b = ii >> 3; hh = ii & 7; row0 = b * 256; key0 = row0; nkeys = 256; qpos0 = -1; }
        AttnNext nx;
        {   const int n = i + G < 1280 ? i + G : i; bool nm; int nr, nk, nh;
            if (n < 1024) { nm = n < 512; const int ii = n & 511, j = ii >> 3, b = j >> 3, qb = j & 7; nh = ii & 7; nr = TP + b * SEQS + qb * 256; nk = TP + b * KSEQ; }
            else { nm = n < 1152; const int ii = (n - 1024) & 127, b = ii >> 3; nh = ii & 7; nr = b * 256; nk = nr; }
            if (nm) { nx.Q = MQ + (size_t)nr * MQD + nh * 96; nx.ldq = MQD; nx.K = KN + (size_t)nk * 512 + nh * 64; nx.ldk = 512; nx.V = VTM + (size_t)(nh * 64) * TK + nk; nx.KR = KR + (size_t)nk * 32; }
            else { nx.Q = QC + (size_t)nr * 512 + nh * 64; nx.ldq = 512; nx.K = KC + (size_t)nk * 128 + (nh >> 2) * 64; nx.ldk = 128; nx.V = VTC + (size_t)((nh >> 2) * 64) * TK + nk; nx.KR = KR + (size_t)nk * 32; } }
        if (mla) attn_unit<true>(lds, MQ + (size_t)row0 * MQD + hh * 96, MQD, KN + (size_t)key0 * 512 + hh * 64, 512, KR + (size_t)key0 * 32, VTM + (size_t)(hh * 64) * TK + key0, nkeys,
                                 ATT + (size_t)row0 * DM + 512 + hh * 64, C_M, tabm, qpos0, tid, wave, lane, nx);
        else attn_unit<false>(lds, QC + (size_t)row0 * 512 + hh * 64, 512, KC + (size_t)key0 * 128 + (hh >> 2) * 64, 128, KR, VTC + (size_t)((hh >> 2) * 64) * TK + key0, nkeys,
                              ATT + (size_t)row0 * DM + hh * 64, C_G, tabm, qpos0, tid, wave, lane, nx);
    }
    if (wave >= 4) __builtin_amdgcn_s_setprio(0);
}

#define XB_TMO      128
#define XB_XCNT(j)  (256  + 64 * (j))
#define XB_XSUB(j)  (1280 + 64 * (j))
#define XB_XGEN(j)  (2304 + 64 * (j))
#define XB_TOP      3328
#define XB_TOPGEN   3392
#define XCD_BAR_WORDS 3456
#define XB_SPIN_CAP (1u << 18)

__device__ __forceinline__ unsigned xb_ld(unsigned* p)              { return __hip_atomic_load(p, __ATOMIC_RELAXED, __HIP_MEMORY_SCOPE_AGENT); }
__device__ __forceinline__ unsigned xb_add(unsigned* p, unsigned v) { return __hip_atomic_fetch_add(p, v, __ATOMIC_RELAXED, __HIP_MEMORY_SCOPE_AGENT); }
__device__ __forceinline__ unsigned xb_xcc_id() { return (unsigned)__builtin_amdgcn_s_getreg((3 << 11) | 20) & 0xFu; }
#define XB_SPIN(cond, bar) do { unsigned _sp = 0; while (cond) { __builtin_amdgcn_s_sleep(1); \
    if ((++_sp & 255u) == 0u) { if (xb_ld(&(bar)[XB_TMO])) break; if (_sp > XB_SPIN_CAP) { atomicAdd(&(bar)[XB_TMO], 1u); break; } } } } while (0)

struct XcdBarrier {
    unsigned* bar; unsigned x;
    volatile LAS unsigned* st;
};

__device__ __forceinline__ XcdBarrier xcd_barrier_post(unsigned* bar, volatile LAS unsigned* st) {
    XcdBarrier b; b.bar = bar; b.x = xb_xcc_id(); b.st = st;
    if (threadIdx.x == 0) (void)xb_add(&bar[XB_XCNT(b.x)], 1u);
    return b;
}
__device__ __forceinline__ void xcd_barrier_complete(unsigned* bar, unsigned x, unsigned& nloc, unsigned& nx) {
    const unsigned G = gridDim.x * gridDim.y * gridDim.z;
    unsigned sum, cnt, mine, sp = 0u;
    for (;;) {
        sum = 0u; cnt = 0u; mine = 0u;
#pragma unroll
        for (unsigned j = 0; j < 16; ++j) { const unsigned c = xb_ld(&bar[XB_XCNT(j)]); sum += c; cnt += (c > 0u) ? 1u : 0u; mine = (j == x) ? c : mine; }
        if (sum == G) break;
        __builtin_amdgcn_s_sleep(1);
        if ((++sp & 255u) == 0u) { if (xb_ld(&bar[XB_TMO])) break; if (sp > XB_SPIN_CAP) { atomicAdd(&bar[XB_TMO], 1u); break; } }
    }
    nloc = mine > 0u ? mine : 1u; nx = cnt > 0u ? cnt : 1u;
}

__device__ __forceinline__ void xcd_barrier(const XcdBarrier& b) {
    asm volatile("s_waitcnt vmcnt(0)" ::: "memory");
    __syncthreads();
    if (threadIdx.x == 64) {
        __builtin_amdgcn_fence(__ATOMIC_ACQUIRE, "agent");
        asm volatile("s_waitcnt vmcnt(0)" ::: "memory");
    }
    if (threadIdx.x == 0) {
        unsigned* bar = b.bar;
        __builtin_amdgcn_s_waitcnt(0);
        unsigned nloc = b.st[0], nx = b.st[1];
        const unsigned gen = b.st[2];
        if (nloc == 0u) { xcd_barrier_complete(bar, b.x, nloc, nx); b.st[0] = nloc; b.st[1] = nx; }
        b.st[2] = gen + 1u;
        const unsigned old = xb_add(&bar[XB_XSUB(b.x)], 1u);
        if (old + 1u == (gen + 1u) * nloc) {
            __builtin_amdgcn_fence(__ATOMIC_RELEASE, "agent");
            asm volatile("s_waitcnt vmcnt(0)" ::: "memory");
            (void)xb_add(&bar[XB_TOP], 1u);
        }
        const unsigned target = (gen + 1u) * nx;
        XB_SPIN(xb_ld(&bar[XB_TOP]) < target, bar);
        asm volatile("s_waitcnt vmcnt(0)" ::: "memory");
    }
    __syncthreads();
}

struct Args { const float* in[32]; float* out; unsigned char* ws; int ph_lo, ph_hi; };
constexpr int NPHASE = 18;

#ifndef PG8_SP2
#define PG8_SP2 true
#endif
#ifndef PG8_ALIGN
#define PG8_ALIGN true
#endif
struct FullOrder {
    pg8::StaticOrder S; int nt;
    __device__ __forceinline__ void init(int M, int N, int K, int G, int c) { S.init(M, N, G, c); nt = K / 64; }
    __device__ __forceinline__ bool next(int i, pg8::Unit& u) const { if (!S.next(i, u)) return false; u.koff = 0; u.nt = nt; u.part = 0; return true; }
    __device__ __forceinline__ void a_ready(const pg8::Unit&) const {}
    __device__ __forceinline__ void done(const pg8::Unit&) const {}
};
struct SplitTailOrder {
    int c, K;
    __device__ __forceinline__ bool next(int i, pg8::Unit& u) const {
        const int x = c & 7, slot = c >> 3;
        if (i == 0) { u.pm = 10 * x + (slot >> 2); u.pn = slot & 3; u.koff = 0; u.nt = K / 64; u.part = 0; return true; }
        if (i == 1) { u.pm = 10 * x + 8 + (slot >> 4); u.pn = (slot >> 2) & 3; u.part = slot & 3;
            if (K == 1024) { u.koff = 256 * u.part; u.nt = 4; } else { u.koff = 64 * (u.part < 2 ? 12 * u.part : 24 + 10 * (u.part - 2)); u.nt = u.part < 2 ? 12 : 10; }
            return true; }
        return false;
    }
    __device__ __forceinline__ void a_ready(const pg8::Unit&) const {}
    __device__ __forceinline__ void done(const pg8::Unit&) const {}
};
template <class Epi>
__device__ __forceinline__ void run_gemm(LAS unsigned char* lds, const bf16* A, const bf16* Bt, int M, int N, int K, int G, int cid, const Epi& E) {
    pg8::Gemm g{A, Bt, M, N, K}; FullOrder S; S.init(M, N, K, G, cid);
    pg8::gemm_phase<Epi, FullOrder, PG8_ALIGN, PG8_SP2>(lds, g, S, E);
}
template <class Epi>
__device__ __forceinline__ void run_gemm_split(LAS unsigned char* lds, const bf16* A, const bf16* Bt, int K, int cid, const Epi& E) {
    pg8::Gemm g{A, Bt, T, 1024, K}; SplitTailOrder S{cid, K};
    pg8::gemm_phase<Epi, SplitTailOrder, PG8_ALIGN, PG8_SP2>(lds, g, S, E);
}

__global__ void __launch_bounds__(NTHR, 2) fwd_kernel(Args args) {
    extern __shared__ __attribute__((aligned(16))) unsigned char lds_raw[];
    LAS unsigned char* lds = (LAS unsigned char*)lds_raw;
#if MK_CG_SYNC
    cg::grid_group grid = cg::this_grid();
#endif
    const int tid = threadIdx.x, lane = tid & 63, wave = __builtin_amdgcn_readfirstlane(tid >> 6);
    const int G = gridDim.x, bid = blockIdx.x, gw = bid * NWAVES + wave, ngw = G * NWAVES;
    unsigned char* ws = args.ws; const float* const* in = args.in; float* out = args.out;
    const int lo = args.ph_lo, hi = args.ph_hi;
#ifndef REP_PHASE
#define REP_PHASE (-1)
#define REP_N 1
#endif
#define PH(k) if (IN(k)) for (int rp_ = 0; rp_ < ((k) == REP_PHASE ? REP_N : 1); ++rp_)
#ifndef PH_MASK
#define PH_MASK 0x3ffff
#endif
#define IN(k) (((PH_MASK >> (k)) & 1) && lo <= (k) && (k) < hi)
#if MK_CG_SYNC
#define SEAM(k) do { if (IN(k) && IN((k) + 1)) grid.sync(); } while (0)
#else
    if (tid < 3) ((volatile LAS unsigned*)(lds + 131072))[tid] = 0u;
    __syncthreads();
    const XcdBarrier bar = xcd_barrier_post((unsigned*)(args.ws + WS_CTL), (volatile LAS unsigned*)(lds + 131072));
#ifdef PROBE_TS
    volatile LAS unsigned long long* tsl = (volatile LAS unsigned long long*)(lds + 131072 + 256);
    if (bid == 0 && tid == 0) tsl[0] = __builtin_amdgcn_s_memrealtime();
#ifndef PROBE_XBAR
#define PROBE_XBAR 0
#endif
#ifndef PROBE_SUB
#define PROBE_SUB 0.f
#endif
#define SEAM(k) do { if (IN(k) && IN((k) + 1)) { xcd_barrier(bar); for (int xb_ = 0; xb_ < PROBE_XBAR; ++xb_) xcd_barrier(bar); if (bid == 0 && tid == 0) tsl[(k) + 1] = __builtin_amdgcn_s_memrealtime(); } } while (0)
#else
#define SEAM(k) do { if (IN(k) && IN((k) + 1)) xcd_barrier(bar); } while (0)
#endif
#endif
    bf16* H = (bf16*)(ws + WS_A); bf16* OB = (bf16*)(ws + WS_A); bf16* MIX = (bf16*)(ws + WS_B); bf16* ATT = (bf16*)(ws + WS_B);
    bf16* U = (bf16*)(ws + WS_C); bf16* ACT = (bf16*)(ws + WS_C);
    bf16* SLABB = (bf16*)(ws + WS_B); bf16* SLABC = (bf16*)(ws + WS_C);
    const float* MOD0 = (const float*)(ws + WS_MOD); const float* MOD1 = MOD0 + 9 * 6144;
    const f32x2* tabg = (const f32x2*)(ws + WS_TABG); const f32x2* tabm = (const f32x2*)(ws + WS_TABM);
    float* Y = out + OUT_Y;

    PH(0) {
        if (G != 256 || bid < 128) p0_adaln(in, ws, lds, tid, wave, lane, bid, G == 256 ? 128 : G, 0, 128);
        if (bid == G - 1) p0_tables(in, ws, tid);
        if (G == 256) { if (bid >= 128) p0_weights(in, ws, (LAS float*)(lds + 57344 + wave * 8448), (bid - 128) * NWAVES + wave, 128 * NWAVES, lane, 0, P0_ITEMS_L0); }
        else p0_weights(in, ws, (LAS float*)(lds + 57344 + wave * 8448), gw, ngw, lane, 0, P0_ITEMS_L0);
    }
    SEAM(0);
    PH(1) phase_norm_in(in[0], in[1], in[10] + 0 * DM, MOD0, 0, H, row0_of(bid, wave), lane);
    SEAM(1);
    PH(2) run_gemm(lds, H, (const bf16*)(ws + WS_WCIN), T, CIN, 1024, G, bid, EpiConvIn{U, (const float*)(ws + WS_BCIN)});
    PH(2) { if (bid >= 32) p0_weights(in, ws, (LAS float*)(lds + wave * 8448), (bid - 32) * NWAVES + wave, (G - 32) * NWAVES, lane, P0_ITEMS_L0, P0_ITEMS_ALL);
            if (bid >= 128) { __syncthreads(); p0_adaln(in, ws, lds, tid, wave, lane, bid - 128, G - 128, 128, 256); } }
    SEAM(2);
    PH(3) phase_conv(U, MIX, in[13], in[15], in[16], in[17], in[18], lds, tid, wave, lane, G);
    SEAM(3);
    PH(4) run_gemm_split(lds, MIX, (const bf16*)(ws + WS_WCOUT), 1024, bid, EpiStore{OB, DM, in[20], SLABC});
    SEAM(4);
    PH(5) phase_post<true, false, true, true>(OB, SLABC, in[0], in[1], Y, in[11] + 0 * DM, MOD0, 2, in[10] + 1 * DM, MOD0, 3, H, row0_of(bid, wave), slab_off_of(bid), lane);
    SEAM(5);
    PH(6) run_gemm(lds, H, (const bf16*)(ws + WS_WGU0), T, 2 * FFN, 1024, G, bid, EpiSwiGLU{ACT});
    SEAM(6);
    PH(7) run_gemm_split(lds, ACT, (const bf16*)(ws + WS_WD0), FFN, bid, EpiStore{OB, DM, nullptr, SLABB});
    SEAM(7);
    PH(8) phase_post<true, true, true, true>(OB, SLABB, Y, Y + (size_t)TP * DM, Y, in[11] + 1 * DM, MOD0, 5, in[10] + 2 * DM, MOD1, 0, H, row0_of(bid, wave), slab_off_of(bid), lane);
    SEAM(8);
    PH(9) run_gemm(lds, H, (const bf16*)(ws + WS_WAIN), T, AINP, 1024, G, bid, EpiAttnIn{(bf16*)(ws + WS_C + C_QC), (bf16*)(ws + WS_C + C_U1)});
    SEAM(9);
    PH(10) phase_attn_rows((const bf16*)(ws + WS_C + C_U1), in[22], in[23], in[24], in[26], tabg, tabm,
                                (bf16*)(ws + WS_C + C_QC), (bf16*)(ws + WS_A + A_KC), (bf16*)(ws + WS_A + A_VTC), (bf16*)(ws + WS_A + A_QA), (bf16*)(ws + WS_A + A_CKV), (bf16*)(ws + WS_A + A_KR),
                                out + OUT_K, out + OUT_V, out + OUT_CKV, out + OUT_KR, in[2], in[3], in[4], in[5], lds, bid, tid, wave, lane);
    SEAM(10);
    PH(11) {
        run_gemm(lds, (const bf16*)(ws + WS_A + A_QA), (const bf16*)(ws + WS_WQB), T, MQD, QL, G, bid, EpiStore{(bf16*)(ws + WS_C + C_MQ), MQD, nullptr, nullptr});
        run_gemm(lds, (const bf16*)(ws + WS_A + A_CKV), (const bf16*)(ws + WS_WKN), TK, 512, KVL, G, (bid + 240) % G, EpiStore{(bf16*)(ws + WS_C + C_KN), 512, nullptr, nullptr});
        run_gemm(lds, (const bf16*)(ws + WS_WVT), (const bf16*)(ws + WS_A + A_CKV), 512, TK, KVL, G, (bid + 160) % G, EpiStore{(bf16*)(ws + WS_C + C_VTM), TK, nullptr, nullptr});
    }
    SEAM(11);
    PH(12) phase_attention(ws, lds, tabg, tabm, in[22], tid, wave, lane, G);
    SEAM(12);
    PH(13) run_gemm(lds, ATT, (const bf16*)(ws + WS_WAOUT), T, 1024, 1024, G, bid, EpiStore{OB, DM, nullptr, nullptr});
    SEAM(13);
    PH(14) phase_post<true, true, true, false>(OB, nullptr, Y, Y + (size_t)TP * DM, Y, in[11] + 2 * DM, MOD1, 2, in[10] + 3 * DM, MOD1, 3, H, row0_of(bid, wave), slab_off_of(bid), lane);
    SEAM(14);
    PH(15) run_gemm(lds, H, (const bf16*)(ws + WS_WGU1), T, 2 * FFN, 1024, G, bid, EpiSwiGLU{ACT});
    SEAM(15);
    PH(16) run_gemm_split(lds, ACT, (const bf16*)(ws + WS_WD1), FFN, bid, EpiStore{OB, DM, nullptr, SLABB});
    SEAM(16);
    PH(17) phase_post<false, true, false, true>(OB, SLABB, Y, Y + (size_t)TP * DM, Y, in[11] + 3 * DM, MOD1, 5, nullptr, nullptr, 0, nullptr, row0_of(bid, wave), slab_off_of(bid), lane);
#ifdef PROBE_TS
    xcd_barrier(bar);
    if (bid == 0) {
        if (tid == 0) tsl[18] = __builtin_amdgcn_s_memrealtime();
        __syncthreads();
        const unsigned long long t1 = tsl[PROBE_TS >= 18 ? 18 : PROBE_TS + 1], t0 = tsl[PROBE_TS >= 18 ? 0 : PROBE_TS];
        const float us = (float)(t1 - t0) * 0.01f - PROBE_SUB, eps = sqrtf(us * 1e-4f);
        float* okr = out + OUT_KR;
        for (int i = tid; i < TP * 32; i += NTHR) okr[i] *= (1.f + eps);
    }
#endif
#undef IN
#undef SEAM
}

#ifndef MK_ONE_LAUNCH
#define MK_ONE_LAUNCH 1
#endif
extern "C" void kernel_launch(void* const* d_in, const int* in_sizes, int n_in, void* d_out, int out_size, void* d_ws, size_t ws_size, hipStream_t stream) {
    static int grid = 0;
    if (grid == 0) {
        if (n_in != 32 || ws_size < WS_END) { fprintf(stderr, "kernel_launch: unexpected inputs (n_in %d, ws %zu)\n", n_in, ws_size); grid = -1; return; }
        int dev = 0, cus = 0, per_cu = 0;
        (void)hipGetDevice(&dev); (void)hipDeviceGetAttribute(&cus, hipDeviceAttributeMultiprocessorCount, dev);
        if (hipFuncSetAttribute((const void*)fwd_kernel, hipFuncAttributeMaxDynamicSharedMemorySize, LDS_BYTES) != hipSuccess) { fprintf(stderr, "kernel_launch: hipFuncSetAttribute failed\n"); grid = -1; return; }
        if (hipOccupancyMaxActiveBlocksPerMultiprocessor(&per_cu, (const void*)fwd_kernel, NTHR, LDS_BYTES) != hipSuccess || per_cu < 1) { fprintf(stderr, "kernel_launch: occupancy query says %d\n", per_cu); per_cu = 1; }
        (void)hipGetLastError();
        if (cus != 256) { fprintf(stderr, "kernel_launch: built for a 256-CU device (one workgroup per CU), found %d CUs; nothing launched\n", cus); grid = -1; return; }
        grid = cus;
    }
    if (grid < 0) return;
    Args a{};
    for (int i = 0; i < 32; ++i) a.in[i] = (const float*)d_in[i];
    a.out = (float*)d_out; a.ws = (unsigned char*)d_ws;
#if MK_ONE_LAUNCH && MK_CG_SYNC
    a.ph_lo = 0; a.ph_hi = NPHASE;
    void* kargs[] = {&a};
    hipError_t e = hipLaunchCooperativeKernel((const void*)fwd_kernel, dim3(grid), dim3(NTHR), kargs, LDS_BYTES, stream);
    if (e != hipSuccess) fprintf(stderr, "kernel_launch: cooperative launch failed: %s (grid %d)\n", hipGetErrorString(e), grid);
#elif MK_ONE_LAUNCH
    if (hipMemsetAsync((char*)d_ws + WS_CTL, 0, 16384, stream) != hipSuccess) { fprintf(stderr, "kernel_launch: memset failed\n"); return; }
    a.ph_lo = 0; a.ph_hi = NPHASE;
    hipLaunchKernelGGL(fwd_kernel, dim3(grid), dim3(NTHR), LDS_BYTES, stream, a);
#else
    for (int p = 0; p < NPHASE; ++p) { a.ph_lo = p; a.ph_hi = p + 1; hipLaunchKernelGGL(fwd_kernel, dim3(grid), dim3(NTHR), LDS_BYTES, stream, a); }
#endif
}
```

```cpp
#include <hip/hip_runtime.h>
#include <hip/hip_cooperative_groups.h>
#include <cstdio>
#include <cstdint>
namespace cg = cooperative_groups;
#ifndef MK_CG_SYNC
#define MK_CG_SYNC 0
#endif
namespace pg8 {
#define PG8_LAS __attribute__((address_space(3)))
typedef unsigned short bf16_t;
typedef short bf16x8 __attribute__((ext_vector_type(8)));
typedef float f32x4 __attribute__((ext_vector_type(4)));
typedef unsigned u32x4 __attribute__((ext_vector_type(4)));
constexpr int BM = 256, BK = 64, HALF = 128, HTB = HALF * BK * 2  , STAGE_BYTES = 8 * HTB, NXCD = 8, WGM = 4;

__host__ __device__ __forceinline__ int lds_byte(int r, int c) { const int st = (r >> 4) * 2 + (c >> 5), rr = r & 15, cc = c & 31, ob = rr * 64 + cc * 2; return st * 1024 + (ob ^ (((ob >> 9) & 1) << 5)); }
__host__ __device__ __forceinline__ void stage_rc(int b, int& R, int& C) { const int st = b / 1024, sb = b % 1024, swz = sb ^ (((sb >> 9) & 1) << 5); R = (st >> 1) * 16 + swz / 64; C = (st & 1) * 32 + (swz % 64) / 2; }
__host__ __device__ __forceinline__ int perm32(int rho) { const int n = rho >> 4, i = rho & 15; return 8 * (i >> 2) + 4 * n + (i & 3); }

struct Unit { int pm, pn, koff, nt, part; };
struct Gemm { const bf16_t* A; const bf16_t* Bt; int M, N, K; };

struct StaticOrder {
    int nM, nN, nwg, G, c;
    __host__ __device__ void init(int M, int N, int G_, int c_) { nM = M / BM; nN = N / BM; nwg = nM * nN; G = G_; c = c_; }
    __host__ __device__ bool next(int i, Unit& u) const {
        const long L = (long)i * G + c; if (L >= nwg) return false;
        int wgid = (int)L; { const int q = nwg / NXCD, r = nwg % NXCD, xcd = wgid % NXCD, off = wgid / NXCD; wgid = (xcd < r ? xcd * (q + 1) : r * (q + 1) + (xcd - r) * q) + off; }
        const int nig = WGM * nN, gid = wgid / nig, fm = gid * WGM, gsz = (nM - fm) < WGM ? (nM - fm) : WGM;
        u.pm = fm + ((wgid % nig) % gsz); u.pn = (wgid % nig) / gsz; return true;
    }
    __device__ __forceinline__ void a_ready(const Unit&) const {}
    __device__ __forceinline__ void done(const Unit&) const {}
};

__device__ __forceinline__ unsigned cvt_pk_bf16(float lo, float hi) { unsigned r; asm volatile("v_cvt_pk_bf16_f32 %0, %1, %2" : "=v"(r) : "v"(lo), "v"(hi)); return r; }
template <class Epi, class Sched, bool ALIGN_EPI = false, bool SP2 = false>
__device__ __forceinline__ void gemm_phase(PG8_LAS unsigned char* lds, const Gemm g, const Sched& S, const Epi& E) {
    const int tid = threadIdx.x, wid = __builtin_amdgcn_readfirstlane(tid >> 6), lane = tid & 63, wr = wid >> 2, wc = wid & 3, fr = lane & 15, fq = lane >> 4;
    const int K = g.K;
    unsigned voffA[2], voffB[2];
#pragma unroll
    for (int i = 0; i < 2; ++i) { int R, C; stage_rc(tid * 16 + i * 8192, R, C); const int Rb = Epi::PERM ? ((R & ~31) + perm32(R & 31)) : R;
        voffA[i] = (unsigned)(R * K + C) * 2u; voffB[i] = (unsigned)(Rb * K + C) * 2u; }
    const size_t kstep = (size_t)(BK * 2);
    const size_t hstep = (size_t)HALF * K * 2;
    const size_t tstep = 2 * hstep;
    const unsigned ldsw = (unsigned)wid * 1024u;
    const int aoff = lds_byte(wr * 64 + fr, fq * 8), boff = lds_byte(wc * 32 + fr, fq * 8);
#define PG8_SA(b, h) (((b) * 2 + (h)) * HTB)
#define PG8_SB(b, h) ((4 + (b) * 2 + (h)) * HTB)
#define PG8_STAGE(bufoff, gbase, voff) do { _Pragma("unroll") for (int _i = 0; _i < 2; ++_i) \
        __builtin_amdgcn_global_load_lds((const unsigned*)((const char*)(gbase) + (voff)[_i]), (PG8_LAS unsigned*)(lds + (bufoff) + ldsw + _i * 8192), 16, 0, 0); } while (0)
#define PG8_LDA(dst, b, h) do { _Pragma("unroll") for (int m = 0; m < 4; ++m) _Pragma("unroll") for (int k = 0; k < 2; ++k) dst[m][k] = *(const PG8_LAS bf16x8*)(lds + PG8_SA(b, h) + aoff + m * 2048 + k * 1024); } while (0)
#define PG8_LDB(dst, b, h) do { _Pragma("unroll") for (int n = 0; n < 2; ++n) _Pragma("unroll") for (int k = 0; k < 2; ++k) dst[n][k] = *(const PG8_LAS bf16x8*)(lds + PG8_SB(b, h) + boff + n * 2048 + k * 1024); } while (0)
#define PG8_MMA(ai, bj, At, Bt) do { __builtin_amdgcn_s_setprio(1); _Pragma("unroll") for (int m = 0; m < 4; ++m) _Pragma("unroll") for (int n = 0; n < 2; ++n) _Pragma("unroll") for (int k = 0; k < 2; ++k) \
        acc[ai][bj][m][n] = __builtin_amdgcn_mfma_f32_16x16x32_bf16(Bt[n][k], At[m][k], acc[ai][bj][m][n], 0, 0, 0); __builtin_amdgcn_s_setprio(0); } while (0)
#define PG8_WAIT_V(n) asm volatile("s_waitcnt vmcnt(" #n ")" ::: "memory")
#define PG8_WAIT_L(n) asm volatile("s_waitcnt lgkmcnt(" #n ")" ::: "memory")
#define PG8_BAR __builtin_amdgcn_s_barrier()
#define PG8_SCHED __builtin_amdgcn_sched_barrier(0)
    Unit cur, nxt; int ui = 0;
    if (!S.next(0, cur)) return;
    int nt = cur.nt;
    f32x4 acc[2][2][4][2];
#pragma unroll
    for (int a = 0; a < 2; ++a)
#pragma unroll
        for (int b = 0; b < 2; ++b)
#pragma unroll
            for (int m = 0; m < 4; ++m)
#pragma unroll
                for (int n = 0; n < 2; ++n) acc[a][b][m][n] = (f32x4){0.f, 0.f, 0.f, 0.f};
    bf16x8 At[4][2], B0[2][2], B1[2][2];
    const char* cA = (const char*)g.A + (size_t)cur.pm * tstep + (size_t)cur.koff * 2; const char* cB = (const char*)g.Bt + (size_t)cur.pn * tstep + (size_t)cur.koff * 2;
    S.a_ready(cur);
    if constexpr (SP2) {
        PG8_STAGE(PG8_SB(0, 0), cB, voffB); PG8_STAGE(PG8_SB(0, 1), cB + hstep, voffB); PG8_STAGE(PG8_SA(0, 0), cA, voffA); PG8_STAGE(PG8_SA(0, 1), cA + hstep, voffA);
        if (wr == 1) PG8_BAR;
        PG8_WAIT_V(2); PG8_BAR;
        PG8_STAGE(PG8_SB(1, 0), cB + kstep, voffB); PG8_STAGE(PG8_SA(1, 0), cA + kstep, voffA); PG8_STAGE(PG8_SB(1, 1), cB + hstep + kstep, voffB);
        PG8_WAIT_V(6); PG8_BAR;
    } else {
        PG8_STAGE(PG8_SB(0, 0), cB, voffB); PG8_STAGE(PG8_SA(0, 0), cA, voffA); PG8_STAGE(PG8_SB(0, 1), cB + hstep, voffB); PG8_STAGE(PG8_SA(0, 1), cA + hstep, voffA);
        if (wr == 1) PG8_BAR;
        PG8_WAIT_V(4); PG8_BAR;
        PG8_STAGE(PG8_SB(1, 0), cB + kstep, voffB); PG8_STAGE(PG8_SA(1, 0), cA + kstep, voffA); PG8_STAGE(PG8_SB(1, 1), cB + hstep + kstep, voffB);
        PG8_WAIT_V(6); PG8_BAR;
    }
    for (;;) {
        const bool has_next = S.next(ui + 1, nxt);
        const char* nA = has_next ? (const char*)g.A + (size_t)nxt.pm * tstep + (size_t)nxt.koff * 2 : cA; const char* nB = has_next ? (const char*)g.Bt + (size_t)nxt.pn * tstep + (size_t)nxt.koff * 2 : cB;
        for (int t = 0; t < nt; t += 2) {
            const bool last = (t == nt - 2);
            const char* a1 = cA + (size_t)(t + 1) * kstep;
            const char* a2 = last ? nA : cA + (size_t)(t + 2) * kstep; const char* b2 = last ? nB : cB + (size_t)(t + 2) * kstep;
            const char* a3 = a2 + kstep; const char* b3 = b2 + kstep;
            if (last && has_next) S.a_ready(nxt);
            if constexpr (SP2) {
            PG8_LDB(B0, 0, 0); PG8_LDB(B1, 0, 1); PG8_SCHED; PG8_LDA(At, 0, 0); PG8_STAGE(PG8_SA(1, 1), a1 + hstep, voffA);
            PG8_WAIT_V(8); PG8_WAIT_L(0); PG8_BAR; PG8_MMA(0, 0, At, B0); PG8_MMA(0, 1, At, B1); PG8_BAR; PG8_SCHED;
            PG8_LDA(At, 0, 1); PG8_STAGE(PG8_SB(0, 0), b2, voffB); PG8_STAGE(PG8_SB(0, 1), b2 + hstep, voffB); PG8_STAGE(PG8_SA(0, 0), a2, voffA);
            PG8_WAIT_V(8); PG8_WAIT_L(0); PG8_BAR; PG8_MMA(1, 0, At, B0); PG8_MMA(1, 1, At, B1); PG8_BAR; PG8_SCHED;
            PG8_LDB(B0, 1, 0); PG8_LDB(B1, 1, 1); PG8_SCHED; PG8_LDA(At, 1, 0); PG8_STAGE(PG8_SA(0, 1), a2 + hstep, voffA);
            PG8_WAIT_V(8); PG8_WAIT_L(0); PG8_BAR; PG8_MMA(0, 0, At, B0); PG8_MMA(0, 1, At, B1); PG8_BAR; PG8_SCHED;
            PG8_LDA(At, 1, 1); PG8_STAGE(PG8_SB(1, 0), b3, voffB); PG8_STAGE(PG8_SB(1, 1), b3 + hstep, voffB); PG8_STAGE(PG8_SA(1, 0), a3, voffA);
            PG8_WAIT_V(8); PG8_WAIT_L(0); PG8_BAR; PG8_MMA(1, 0, At, B0); PG8_MMA(1, 1, At, B1); PG8_BAR; PG8_SCHED;
            } else {
            PG8_LDB(B0, 0, 0); PG8_SCHED; PG8_LDA(At, 0, 0); PG8_STAGE(PG8_SA(1, 1), a1 + hstep, voffA);
            PG8_WAIT_L(8); PG8_BAR; PG8_WAIT_L(0); PG8_MMA(0, 0, At, B0); PG8_BAR; PG8_SCHED;
            PG8_LDB(B1, 0, 1); PG8_STAGE(PG8_SB(0, 0), b2, voffB);
            PG8_BAR; PG8_WAIT_L(0); PG8_MMA(0, 1, At, B1); PG8_BAR;
            PG8_LDA(At, 0, 1); PG8_STAGE(PG8_SA(0, 0), a2, voffA);
            PG8_BAR; PG8_WAIT_L(0); PG8_MMA(1, 0, At, B0); PG8_BAR; PG8_SCHED;
            PG8_STAGE(PG8_SB(0, 1), b2 + hstep, voffB);
            PG8_WAIT_V(6); PG8_BAR; PG8_MMA(1, 1, At, B1); PG8_BAR;
            PG8_LDB(B0, 1, 0); PG8_SCHED; PG8_LDA(At, 1, 0); PG8_STAGE(PG8_SA(0, 1), a2 + hstep, voffA);
            PG8_WAIT_L(8); PG8_BAR; PG8_WAIT_L(0); PG8_MMA(0, 0, At, B0); PG8_BAR; PG8_SCHED;
            PG8_LDB(B1, 1, 1); PG8_STAGE(PG8_SB(1, 0), b3, voffB);
            PG8_BAR; PG8_WAIT_L(0); PG8_MMA(0, 1, At, B1); PG8_BAR;
            PG8_LDA(At, 1, 1); PG8_STAGE(PG8_SA(1, 0), a3, voffA);
            PG8_BAR; PG8_WAIT_L(0); PG8_MMA(1, 0, At, B0); PG8_BAR; PG8_SCHED;
            PG8_STAGE(PG8_SB(1, 1), b3 + hstep, voffB);
            PG8_WAIT_V(6); PG8_BAR; PG8_MMA(1, 1, At, B1); PG8_BAR;
            }
        }
        if constexpr (ALIGN_EPI) { if (wr == 0) PG8_BAR; }
        if constexpr (!Epi::AFTER_DRAIN) { E(acc, cur, wr, wc, fr, fq); S.done(cur); }
        if (!has_next) break;
#pragma unroll
        for (int a = 0; a < 2; ++a)
#pragma unroll
            for (int b = 0; b < 2; ++b)
#pragma unroll
                for (int m = 0; m < 4; ++m)
#pragma unroll
                    for (int n = 0; n < 2; ++n) acc[a][b][m][n] = (f32x4){0.f, 0.f, 0.f, 0.f};
        cur = nxt; cA = nA; cB = nB; nt = cur.nt; ++ui;
        if constexpr (ALIGN_EPI) { if (wr == 1) PG8_BAR; }
    }
    PG8_WAIT_V(0);
    if constexpr (!ALIGN_EPI) { if (wr == 0) PG8_BAR; }
    PG8_BAR;
    if constexpr (Epi::AFTER_DRAIN) { E.fused(acc, cur, wr, wc, fr, fq, lds, wid, lane); S.done(cur); }
#undef PG8_SA
#undef PG8_SB
#undef PG8_STAGE
#undef PG8_LDA
#undef PG8_LDB
#undef PG8_MMA
#undef PG8_WAIT_V
#undef PG8_WAIT_L
#undef PG8_BAR
#undef PG8_SCHED
}
}

#define LAS __attribute__((address_space(3)))
typedef unsigned short bf16;
typedef float f32x4 __attribute__((ext_vector_type(4)));
typedef float f32x2 __attribute__((ext_vector_type(2)));
typedef float f32x16 __attribute__((ext_vector_type(16)));
typedef short bf16x8 __attribute__((ext_vector_type(8)));
typedef unsigned u32x4 __attribute__((ext_vector_type(4)));
typedef unsigned u32x2 __attribute__((ext_vector_type(2)));

constexpr int DM = 1024, TP = 4096, TS = 16384, T = TP + TS, SEQS = 2048, NBS = 8, PAST = 256;
constexpr int KSEQ = PAST + SEQS;
constexpr int TK = TP + NBS * KSEQ;
constexpr int FFN = 2816, CIN = 2560, CU2 = 1536, AIN = 1440, AINP = 1536, QL = 384, KVL = 256, MQD = 768;
constexpr float EPS = 1e-6f;
constexpr int NWAVES = 8, NTHR = 512;
constexpr int LDS_BYTES = 147456;
constexpr int SPLIT_ROW0 = 16384;
constexpr size_t SLAB_ELEMS = (size_t)(T - SPLIT_ROW0) * DM;

constexpr size_t MiB = (size_t)1 << 20;
constexpr size_t al256(size_t x) { return (x + 255) & ~(size_t)255; }
constexpr size_t WS_CTL = 0;
constexpr size_t WS_MOD = 1 * MiB;
constexpr size_t WS_TABG = WS_MOD + al256((size_t)2 * 9 * 6144 * 4);
constexpr size_t WS_TABM = WS_TABG + al256(64 * 16 * 8);
constexpr size_t WS_BCIN = WS_TABM + al256(64 * 8 * 8);
constexpr size_t WS_WCIN = 2 * MiB;
constexpr size_t WS_WCOUT = WS_WCIN + (size_t)2560 * 1024 * 2;
constexpr size_t WS_WGU0 = WS_WCOUT + (size_t)1024 * 1024 * 2;
constexpr size_t WS_WD0 = WS_WGU0 + (size_t)5632 * 1024 * 2;
constexpr size_t WS_WGU1 = WS_WD0 + (size_t)1024 * 2816 * 2;
constexpr size_t WS_WD1 = WS_WGU1 + (size_t)5632 * 1024 * 2;
constexpr size_t WS_WAIN = WS_WD1 + (size_t)1024 * 2816 * 2;
constexpr size_t WS_WQB = WS_WAIN + (size_t)1536 * 1024 * 2;
constexpr size_t WS_WKN = WS_WQB + (size_t)768 * 384 * 2;
constexpr size_t WS_WVT = WS_WKN + (size_t)512 * 256 * 2;
constexpr size_t WS_WAOUT = WS_WVT + (size_t)512 * 256 * 2;
constexpr size_t WS_WEND = WS_WAOUT + (size_t)1024 * 1024 * 2;
constexpr size_t WS_A = 50 * MiB;
constexpr size_t WS_B = 90 * MiB;
constexpr size_t WS_C = 130 * MiB;
constexpr size_t WS_END = 240 * MiB;
static_assert(WS_BCIN + 2560 * 4 <= WS_WCIN && WS_WEND <= WS_A, "ws map");
constexpr size_t A_QA = 0;
constexpr size_t A_CKV = A_QA + (size_t)T * QL * 2;
constexpr size_t A_KR = A_CKV + (size_t)TK * KVL * 2;
constexpr size_t A_KC = A_KR + (size_t)TK * 32 * 2;
constexpr size_t A_VTC = A_KC + (size_t)TK * 128 * 2;
static_assert(A_VTC + (size_t)128 * TK * 2 <= 40 * MiB, "region A");
constexpr int U1W = AINP - 512;
constexpr size_t C_U1 = 0;
constexpr size_t C_QC = (size_t)T * U1W * 2;
constexpr size_t C_VTM = C_QC + (size_t)T * 512 * 2;
constexpr size_t C_MQ = 0;
constexpr size_t C_KN = C_VTM + (size_t)512 * TK * 2;
static_assert((size_t)T * MQD * 2 <= C_QC && C_KN + (size_t)TK * 512 * 2 <= 110 * MiB, "region C");
constexpr size_t OUT_Y = 0, OUT_K = (size_t)T * DM, OUT_V = OUT_K + (size_t)TP * 128, OUT_CKV = OUT_V + (size_t)TP * 128, OUT_KR = OUT_CKV + (size_t)TP * 256;

typedef __bf16 bf16x2_t __attribute__((ext_vector_type(2)));
__device__ __forceinline__ unsigned pk2(float lo, float hi) { bf16x2_t v = {(__bf16)lo, (__bf16)hi}; return __builtin_bit_cast(unsigned, v); }
__device__ __forceinline__ bf16 f2bf(float x) { return (bf16)(pk2(x, 0.f) & 0xffffu); }
__device__ __forceinline__ float bf2f(bf16 b) { return __uint_as_float((unsigned)b << 16); }
__device__ __forceinline__ float bflo(unsigned w) { return __uint_as_float(w << 16); }
__device__ __forceinline__ float bfhi(unsigned w) { return __uint_as_float(w & 0xffff0000u); }
__device__ __forceinline__ float wave_sum(float v) {
#pragma unroll
    for (int o = 1; o < 64; o <<= 1) v += __shfl_xor(v, o);
    return v;
}
__device__ __forceinline__ float fsigmoid(float x) { return __builtin_amdgcn_rcpf(1.f + __builtin_amdgcn_exp2f(-1.4426950408889634f * x)); }
__device__ __forceinline__ float fsilu(float x) { return x * fsigmoid(x); }
__device__ __forceinline__ const float* xrow_in(const float* xp, const float* xs, int r) { return r < TP ? xp + (size_t)r * DM : xs + (size_t)(r - TP) * DM; }
__device__ __forceinline__ int cond_of(int r) { return r < TP ? 0 : 1 + ((r - TP) >> 11); }
__device__ __forceinline__ void unpack8(u32x4 w, float (&v)[8]) {
    v[0] = bflo(w.x); v[1] = bfhi(w.x); v[2] = bflo(w.y); v[3] = bfhi(w.y); v[4] = bflo(w.z); v[5] = bfhi(w.z); v[6] = bflo(w.w); v[7] = bfhi(w.w);
}
__device__ __forceinline__ u32x4 pack8(const float (&v)[8]) { u32x4 w; w.x = pk2(v[0], v[1]); w.y = pk2(v[2], v[3]); w.z = pk2(v[4], v[5]); w.w = pk2(v[6], v[7]); return w; }

struct EpiAttnIn {
    static constexpr bool PERM = true, AFTER_DRAIN = false;
    bf16* Q; bf16* U;
    __device__ __forceinline__ void operator()(const f32x4 (&acc)[2][2][4][2], const pg8::Unit& u, int wr, int wc, int fr, int fq) const {
        const bool isq = u.pn < 2; const int ldc = isq ? 512 : U1W;
        const int row0 = u.pm * 256 + wr * 64 + fr, col0 = (isq ? u.pn : u.pn - 2) * 256 + wc * 32 + 8 * fq;
        bf16* base = isq ? Q : U;
#pragma unroll
        for (int ai = 0; ai < 2; ++ai)
#pragma unroll
            for (int m = 0; m < 4; ++m) { bf16* rowp = base + (size_t)(row0 + ai * 128 + m * 16) * ldc + col0;
#pragma unroll
                for (int bj = 0; bj < 2; ++bj) { const f32x4 v0 = acc[ai][bj][m][0], v1 = acc[ai][bj][m][1];
                    u32x4 w; w.x = pk2(v0[0], v0[1]); w.y = pk2(v0[2], v0[3]); w.z = pk2(v1[0], v1[1]); w.w = pk2(v1[2], v1[3]);
                    *(u32x4*)(rowp + bj * 128) = w; } }
    }
};
struct EpiStore {
    static constexpr bool PERM = true, AFTER_DRAIN = false;
    bf16* O; int ldc; const float* bias; bf16* slab;
    __device__ __forceinline__ void operator()(const f32x4 (&acc)[2][2][4][2], const pg8::Unit& u, int wr, int wc, int fr, int fq) const {
        const int row0 = u.pm * 256 + wr * 64 + fr, col0 = u.pn * 256 + wc * 32 + 8 * fq;
        bf16* base = u.part == 0 ? O : slab + (size_t)(u.part - 1) * SLAB_ELEMS - (size_t)(2048 + 2048 * (u.pm / 10)) * DM;
        const bool hb = bias != nullptr && u.part == 0;
        f32x4 bv[2][2];
#pragma unroll
        for (int bj = 0; bj < 2; ++bj)
#pragma unroll
            for (int n = 0; n < 2; ++n) bv[bj][n] = hb ? *(const f32x4*)(bias + col0 + bj * 128 + 4 * n) : (f32x4){0.f, 0.f, 0.f, 0.f};
#pragma unroll
        for (int ai = 0; ai < 2; ++ai)
#pragma unroll
            for (int m = 0; m < 4; ++m) { bf16* rowp = base + (size_t)(row0 + ai * 128 + m * 16) * ldc + col0;
#pragma unroll
                for (int bj = 0; bj < 2; ++bj) { const f32x4 v0 = acc[ai][bj][m][0] + bv[bj][0], v1 = acc[ai][bj][m][1] + bv[bj][1];
                    u32x4 w; w.x = pk2(v0[0], v0[1]); w.y = pk2(v0[2], v0[3]); w.z = pk2(v1[0], v1[1]); w.w = pk2(v1[2], v1[3]);
                    *(u32x4*)(rowp + bj * 128) = w; } }
    }
};
struct EpiConvIn {
    static constexpr bool PERM = true, AFTER_DRAIN = false;
    bf16* O; const float* bias;
    __device__ __forceinline__ void operator()(const f32x4 (&acc)[2][2][4][2], const pg8::Unit& u, int wr, int wc, int fr, int fq) const {
        const int row0 = u.pm * 256 + wr * 64 + fr, cin = u.pn * 256 + wc * 32 + 8 * fq;
        if (u.pn < 2) {
#pragma unroll
            for (int ai = 0; ai < 2; ++ai)
#pragma unroll
                for (int m = 0; m < 4; ++m) { bf16* rowp = O + (size_t)(row0 + ai * 128 + m * 16) * CU2 + cin;
#pragma unroll
                    for (int bj = 0; bj < 2; ++bj) { const f32x4 v0 = acc[ai][bj][m][0], v1 = acc[ai][bj][m][1];
                        u32x4 w; w.x = pk2(v0[0], v0[1]); w.y = pk2(v0[2], v0[3]); w.z = pk2(v1[0], v1[1]); w.w = pk2(v1[2], v1[3]);
                        *(u32x4*)(rowp + bj * 128) = w; } }
        } else {
            const bool glu = u.pn >= 6; const int col0 = 512 + (u.pn - 2) * 128 + wc * 32 + 8 * fq;
            f32x4 ba[2], bg[2];
#pragma unroll
            for (int n = 0; n < 2; ++n) { ba[n] = glu ? *(const f32x4*)(bias + cin + 4 * n) : (f32x4){0.f, 0.f, 0.f, 0.f}; bg[n] = glu ? *(const f32x4*)(bias + cin + 128 + 4 * n) : (f32x4){0.f, 0.f, 0.f, 0.f}; }
#pragma unroll
            for (int ai = 0; ai < 2; ++ai)
#pragma unroll
                for (int m = 0; m < 4; ++m) { bf16* rowp = O + (size_t)(row0 + ai * 128 + m * 16) * CU2 + col0;
                    f32x4 o[2];
#pragma unroll
                    for (int n = 0; n < 2; ++n) { const f32x4 a = acc[ai][0][m][n] + ba[n], g = acc[ai][1][m][n] + bg[n];
                        o[n] = glu ? (f32x4){a[0] * fsigmoid(g[0]), a[1] * fsigmoid(g[1]), a[2] * fsigmoid(g[2]), a[3] * fsigmoid(g[3])} : a * g; }
                    u32x4 w; w.x = pk2(o[0][0], o[0][1]); w.y = pk2(o[0][2], o[0][3]); w.z = pk2(o[1][0], o[1][1]); w.w = pk2(o[1][2], o[1][3]);
                    *(u32x4*)rowp = w; }
        }
    }
};
struct EpiSwiGLU {
    static constexpr bool PERM = true, AFTER_DRAIN = false;
    bf16* O;
    __device__ __forceinline__ void operator()(const f32x4 (&acc)[2][2][4][2], const pg8::Unit& u, int wr, int wc, int fr, int fq) const {
        const int row0 = u.pm * 256 + wr * 64 + fr, col0 = u.pn * 128 + wc * 32 + 8 * fq;
#pragma unroll
        for (int ai = 0; ai < 2; ++ai)
#pragma unroll
            for (int m = 0; m < 4; ++m) { bf16* rowp = O + (size_t)(row0 + ai * 128 + m * 16) * FFN + col0;
                const f32x4 g0 = acc[ai][0][m][0], g1 = acc[ai][0][m][1], u0 = acc[ai][1][m][0], u1 = acc[ai][1][m][1];
                u32x4 w; w.x = pk2(fsilu(g0[0]) * u0[0], fsilu(g0[1]) * u0[1]); w.y = pk2(fsilu(g0[2]) * u0[2], fsilu(g0[3]) * u0[3]);
                w.z = pk2(fsilu(g1[0]) * u1[0], fsilu(g1[1]) * u1[1]); w.w = pk2(fsilu(g1[2]) * u1[2], fsilu(g1[3]) * u1[3]);
                *(u32x4*)rowp = w; }
    }
};
__device__ __forceinline__ int cin_src_col(int n) {
    if (n < 512) return n;
    const int q = n - 512, grp = q >> 10, t4 = (q >> 8) & 3, w = q & 255;
    return 512 + grp * 1024 + (w >> 7) * 512 + 128 * t4 + (w & 127);
}
struct TrItem { const float* src; int ldw; bf16* WT; int K, k0, drow0; };
__device__ __forceinline__ void tr_load(const TrItem& t, float (&tv)[32], int lane) {
#pragma unroll
    for (int i = 0; i < 32; ++i) { const int kk = 2 * i + (lane >> 5); tv[i] = t.src ? t.src[(size_t)(t.k0 + kk) * t.ldw] : 0.f; }
}
__device__ __forceinline__ void tr_store(const TrItem& t, const float (&tv)[32], LAS float* scr, int lane) {
#pragma unroll
    for (int i = 0; i < 32; ++i) { const int kk = 2 * i + (lane >> 5); scr[kk * 33 + (lane & 31)] = tv[i]; }
    asm volatile("s_waitcnt lgkmcnt(0)" ::: "memory");
    const int c = lane & 7;
#pragma unroll
    for (int j = 0; j < 4; ++j) { const int n = (lane >> 3) + 8 * j; const LAS float* s = scr + (8 * c) * 33 + n;
        u32x4 o; o.x = pk2(s[0 * 33], s[1 * 33]); o.y = pk2(s[2 * 33], s[3 * 33]); o.z = pk2(s[4 * 33], s[5 * 33]); o.w = pk2(s[6 * 33], s[7 * 33]);
        *(u32x4*)(t.WT + (size_t)(t.drow0 + n) * t.K + t.k0 + 8 * c) = o; }
    asm volatile("s_waitcnt lgkmcnt(0)" ::: "memory");
}
constexpr int P0_ITEMS_L0 = 16 * 80 + 16 * 32 + 16 * 176 + 44 * 32, P0_ITEMS_ALL = P0_ITEMS_L0 + 16 * 176 + 44 * 32 + 16 * 48 + 6 * 24 + 2 * 4 * 16 + 16 * 32;
__device__ __forceinline__ TrItem p0_decode(const float* const* in, unsigned char* ws, int it, int ln) {
    constexpr int I_CIN = 16 * 80, I_COUT = 16 * 32, I_GU = 16 * 176, I_D = 44 * 32, I_AIN = 16 * 48, I_QB = 6 * 24, I_KN = 4 * 16, I_AOUT = 16 * 32;
    constexpr int NITEMS = I_CIN + I_COUT + 2 * I_GU + 2 * I_D + I_AIN + I_QB + 2 * I_KN + I_AOUT;
    static_assert(NITEMS == P0_ITEMS_ALL, "item count");

        int r = it;
        if (r < I_CIN) { const int nblk = 80, kb = r / nblk, nb = r % nblk, n = 32 * nb + ln;
            return TrItem{in[12] + cin_src_col(n), CIN, (bf16*)(ws + WS_WCIN), 1024, 64 * kb, 32 * nb}; } r -= I_CIN;
        if (r < I_COUT) { const int nblk = 32, kb = r / nblk, nb = r % nblk, n = 32 * nb + ln;
            return TrItem{in[19] + n, 1024, (bf16*)(ws + WS_WCOUT), 1024, 64 * kb, 32 * nb}; } r -= I_COUT;
        if (r < 2 * (I_GU + I_D)) { const int l = r >= (I_GU + I_D) ? 1 : 0; r -= l * (I_GU + I_D);
            if (r < I_GU) { const int nblk = 176, kb = r / nblk, nb = r % nblk, n = 32 * nb + ln, t = n >> 8, w = n & 255;
                const float* src = (w < 128 ? in[29] : in[30]) + (size_t)l * 1024 * FFN + 128 * t + (w & 127);
                return TrItem{src, FFN, (bf16*)(ws + (l ? WS_WGU1 : WS_WGU0)), 1024, 64 * kb, 32 * nb}; }
            else { r -= I_GU; const int nblk = 32, kb = r / nblk, nb = r % nblk, n = 32 * nb + ln;
                return TrItem{in[31] + (size_t)l * FFN * 1024 + n, 1024, (bf16*)(ws + (l ? WS_WD1 : WS_WD0)), FFN, 64 * kb, 32 * nb}; }
            } r -= 2 * (I_GU + I_D);
        if (r < I_AIN) { const int nblk = 48, kb = r / nblk, nb = r % nblk, n = 32 * nb + ln;
            return TrItem{n < AIN ? in[21] + n : nullptr, AIN, (bf16*)(ws + WS_WAIN), 1024, 64 * kb, 32 * nb}; } r -= I_AIN;
        if (r < I_QB) { const int nblk = 24, kb = r / nblk, nb = r % nblk, n = 32 * nb + ln, hh = n / 96, w = n % 96;
            int sc = n; if (w >= 64) { const int e = w - 64, blk = e >> 4, loc = e & 15; sc = hh * 96 + 64 + 16 * blk + 8 * (loc & 1) + (loc >> 1); }
            return TrItem{in[25] + sc, MQD, (bf16*)(ws + WS_WQB), QL, 64 * kb, 32 * nb}; } r -= I_QB;
        if (r < I_KN) { const int nblk = 16, kb = r / nblk, nb = r % nblk, n = 32 * nb + ln;
            return TrItem{in[27] + (n >> 6) * 128 + (n & 63), 1024, (bf16*)(ws + WS_WKN), KVL, 64 * kb, 32 * nb}; } r -= I_KN;
        if (r < I_KN) { const int nblk = 16, kb = r / nblk, nb = r % nblk, n = 32 * nb + ln;
            return TrItem{in[27] + (n >> 6) * 128 + 64 + (n & 63), 1024, (bf16*)(ws + WS_WVT), KVL, 64 * kb, 32 * nb}; } r -= I_KN;
        { const int nblk = 32, kb = r / nblk, nb = r % nblk, n = 32 * nb + ln;
            return TrItem{in[28] + n, 1024, (bf16*)(ws + WS_WAOUT), 1024, 64 * kb, 32 * nb}; }
}
__device__ __forceinline__ void p0_weights(const float* const* in, unsigned char* ws, LAS float* scr, int gw, int ngw, int lane, int item_lo, int item_hi) {
    const int ln = lane & 31;
    int it = item_lo + gw;
    if (it >= item_hi) return;
    TrItem a = p0_decode(in, ws, it, ln); float ta[32], tb[32];
    tr_load(a, ta, lane);
    for (;;) {
        const int nx = it + ngw; const bool more = nx < item_hi;
        TrItem b = a;
        if (more) { b = p0_decode(in, ws, nx, ln); tr_load(b, tb, lane); }
        tr_store(a, ta, scr, lane);
        if (!more) break;
        a = b; it = nx;
#pragma unroll
        for (int i = 0; i < 32; ++i) ta[i] = tb[i];
    }
}
__device__ __forceinline__ void p0_adaln(const float* const* in, unsigned char* ws, LAS unsigned char* lds, int tid, int wave, int lane, int b0, int nb, int item_lo, int item_hi) {
    LAS float* sS = (LAS float*)lds;
    LAS float* red = (LAS float*)(lds + 1024 * 12 * 4);
    float* MOD = (float*)(ws + WS_MOD);
    {   float xv[18];
#pragma unroll
        for (int q = 0; q < 18; ++q) { const int i = tid + NTHR * q, cnd = i >> 10, k = i & 1023; xv[q] = cnd == 0 ? in[7][k] : in[6][(cnd - 1) * 1024 + k]; }
#pragma unroll
        for (int q = 0; q < 18; ++q) { const int i = tid + NTHR * q, cnd = i >> 10, k = i & 1023; sS[k * 12 + cnd] = fsilu(xv[q]); } }
    __syncthreads();
    const int la = lane < 48 ? lane : 47, g = la / 12, cq = la - 12 * g;
    const int krow0 = 128 * wave + 32 * g;
    for (int it = item_lo + b0; it < item_hi; it += nb) {
        const int l = it >> 7, n0 = 48 * (it & 127);
        const float* wp = in[8] + (size_t)l * 1024 * 6144 + n0 + 4 * cq + (size_t)krow0 * 6144;
        f32x4 acc[9];
#pragma unroll
        for (int c = 0; c < 9; ++c) acc[c] = (f32x4){0.f, 0.f, 0.f, 0.f};
#pragma unroll 1
        for (int kk = 0; kk < 32; kk += 16) {
            f32x4 wv[16];
#pragma unroll
            for (int q = 0; q < 16; ++q) wv[q] = *(const f32x4*)(wp + (size_t)(kk + q) * 6144);
#pragma unroll
            for (int q = 0; q < 16; ++q) { const LAS f32x4* s4 = (const LAS f32x4*)(sS + (krow0 + kk + q) * 12); const f32x4 s0 = s4[0], s1 = s4[1], s2 = s4[2];
                acc[0] += s0.x * wv[q]; acc[1] += s0.y * wv[q]; acc[2] += s0.z * wv[q]; acc[3] += s0.w * wv[q];
                acc[4] += s1.x * wv[q]; acc[5] += s1.y * wv[q]; acc[6] += s1.z * wv[q]; acc[7] += s1.w * wv[q]; acc[8] += s2.x * wv[q]; }
        }
        if (lane < 48) {
#pragma unroll
            for (int c = 0; c < 9; ++c) *(LAS f32x4*)(red + ((wave * 4 + g) * 9 + c) * 48 + 4 * cq) = acc[c]; }
        __syncthreads();
        if (tid < 432) { const int c = tid / 48, col = tid - 48 * c; float sum = in[9][l * 6144 + n0 + col];
#pragma unroll
            for (int pp = 0; pp < 32; ++pp) sum += red[(pp * 9 + c) * 48 + col];
            MOD[(size_t)(l * 9 + c) * 6144 + n0 + col] = sum; }
        __syncthreads();
    }
}
__device__ __forceinline__ void p0_tables(const float* const* in, unsigned char* ws, int tid) {
    f32x2* tabg = (f32x2*)(ws + WS_TABG); f32x2* tabm = (f32x2*)(ws + WS_TABM); float* bcin = (float*)(ws + WS_BCIN);
    for (int i = tid; i < 64 * 16; i += NTHR) { const int pos = i >> 4, f = i & 15; const float inv = exp2f(-(float)f * (13.287712379549449f / 16.f)), a = (float)pos * inv; tabg[i] = (f32x2){__cosf(a), __sinf(a)}; }
    for (int i = tid; i < 64 * 8; i += NTHR) { const int pos = i >> 3, f = i & 7; const float inv = exp2f(-(float)f * (13.287712379549449f / 8.f)), a = (float)pos * inv; tabm[i] = (f32x2){__cosf(a), __sinf(a)}; }
    static_assert(CIN == 5 * NTHR, "bias permutation loop");
    {   float bv_[5];
#pragma unroll
        for (int q = 0; q < 5; ++q) { const int sc = cin_src_col(tid + NTHR * q); bv_[q] = sc < 1536 ? 0.f : in[14][sc - 1536]; }
#pragma unroll
        for (int q = 0; q < 5; ++q) bcin[tid + NTHR * q] = bv_[q]; }
}

constexpr int NIT = T / (256 * NWAVES);
static_assert(NIT * 256 * NWAVES == T && NIT == 10, "row phases assume a 256-workgroup grid");
__device__ __forceinline__ int row0_of(int bid, int wave) { return 2560 * (bid & 7) + 8 * (bid >> 3) + wave; }
__device__ __forceinline__ int slab_off_of(int bid) { return 2048 + 2048 * (bid & 7); }
__device__ __forceinline__ f32x4 bf4(u32x2 w) { return (f32x4){bflo(w.x), bfhi(w.x), bflo(w.y), bfhi(w.y)}; }
__device__ __forceinline__ float sq4(f32x4 v) { return (v.x * v.x + v.y * v.y) + (v.z * v.z + v.w * v.w); }
__device__ __forceinline__ void phase_norm_in(const float* xp, const float* xs, const float* gpre, const float* modl, int sidx, bf16* H, int gw, int lane) {
    f32x4 g[4];
#pragma unroll
    for (int j = 0; j < 4; ++j) g[j] = ((const f32x4*)gpre + lane)[64 * j];
    f32x4 cur[4], nxt[4];
    { const f32x4* x4 = (const f32x4*)xrow_in(xp, xs, gw) + lane;
#pragma unroll
      for (int j = 0; j < 4; ++j) cur[j] = x4[64 * j]; }
    f32x4 sh[4], sc[4]; int pcnd = -1;
#pragma unroll
    for (int i = 0; i < NIT; ++i) {
        const int r = gw + 256 * i, cnd = cond_of(r);
        if (cnd != pcnd) {
            pcnd = cnd; const float* mb = modl + (size_t)cnd * 6144;
#pragma unroll
            for (int j = 0; j < 4; ++j) { sh[j] = ((const f32x4*)(mb + sidx * DM) + lane)[64 * j]; sc[j] = ((const f32x4*)(mb + (sidx + 1) * DM) + lane)[64 * j]; }
        }
        if (i + 1 < NIT) { const f32x4* x4 = (const f32x4*)xrow_in(xp, xs, r + 256) + lane;
#pragma unroll
            for (int j = 0; j < 4; ++j) nxt[j] = x4[64 * j]; }
        float ss = 0.f;
#pragma unroll
        for (int j = 0; j < 4; ++j) ss += sq4(cur[j]);
        const float rstd = rsqrtf(wave_sum(ss) * (1.f / DM) + EPS);
        u32x2* h2 = (u32x2*)(H + (size_t)r * DM) + lane;
#pragma unroll
        for (int j = 0; j < 4; ++j) { const f32x4 o = cur[j] * rstd * g[j] * (1.f + sc[j]) + sh[j]; h2[64 * j] = (u32x2){pk2(o.x, o.y), pk2(o.z, o.w)}; }
#pragma unroll
        for (int j = 0; j < 4; ++j) cur[j] = nxt[j];
    }
}
template <bool NEXT, bool XIN16, bool XOUT16, bool SLAB>
__device__ __forceinline__ void phase_post(const bf16* O, const bf16* slab, const float* xp, const float* xs, float* Y, const float* gpost, const float* modl, int gidx,
                                           const float* gpre_n, const float* modn, int sidx_n, bf16* H, int gw, int slab_off, int lane) {
    f32x4 gp[4], gn[4];
#pragma unroll
    for (int j = 0; j < 4; ++j) { gp[j] = ((const f32x4*)gpost + lane)[64 * j]; if (NEXT) gn[j] = ((const f32x4*)gpre_n + lane)[64 * j]; }
    u32x2 co[4], no[4], cxb[4], nxb[4], cs[3][4], ns[3][4]; f32x4 cxf[4], nxf[4];
#define POST_LOAD(rr, it, po, pxb, pxf, ps) do { \
        const u32x2* o2_ = (const u32x2*)(O + (size_t)(rr) * DM) + lane; \
        _Pragma("unroll") for (int j = 0; j < 4; ++j) po[j] = o2_[64 * j]; \
        if (XIN16) { const u32x2* b2_ = (const u32x2*)(Y + (size_t)(rr) * DM) + lane; _Pragma("unroll") for (int j = 0; j < 4; ++j) pxb[j] = b2_[64 * j]; } \
        else { const f32x4* x4_ = (const f32x4*)xrow_in(xp, xs, (rr)) + lane; _Pragma("unroll") for (int j = 0; j < 4; ++j) pxf[j] = x4_[64 * j]; } \
        if (SLAB && (it) >= 8) { _Pragma("unroll") for (int p = 0; p < 3; ++p) { const u32x2* s2_ = (const u32x2*)(slab + (size_t)p * SLAB_ELEMS + (size_t)((rr) - slab_off) * DM) + lane; \
            _Pragma("unroll") for (int j = 0; j < 4; ++j) ps[p][j] = s2_[64 * j]; } } } while (0)
    POST_LOAD(gw, 0, co, cxb, cxf, cs);
    f32x4 gt[4], sh[4], sc[4]; int pcnd = -1;
#pragma unroll
    for (int i = 0; i < NIT; ++i) {
        const int r = gw + 256 * i, cnd = cond_of(r);
        if (cnd != pcnd) {
            pcnd = cnd;
#pragma unroll
            for (int j = 0; j < 4; ++j) { gt[j] = ((const f32x4*)(modl + (size_t)cnd * 6144 + gidx * DM) + lane)[64 * j];
                if (NEXT) { sh[j] = ((const f32x4*)(modn + (size_t)cnd * 6144 + sidx_n * DM) + lane)[64 * j]; sc[j] = ((const f32x4*)(modn + (size_t)cnd * 6144 + (sidx_n + 1) * DM) + lane)[64 * j]; } }
        }
        if (i + 1 < NIT) POST_LOAD(r + 256, i + 1, no, nxb, nxf, ns);
        f32x4 o[4], x[4]; float ss = 0.f;
#pragma unroll
        for (int j = 0; j < 4; ++j) { o[j] = bf4(co[j]); x[j] = XIN16 ? bf4(cxb[j]) : cxf[j]; }
        if (SLAB && i >= 8) {
#pragma unroll
            for (int p = 0; p < 3; ++p)
#pragma unroll
                for (int j = 0; j < 4; ++j) o[j] = o[j] + bf4(cs[p][j]); }
#pragma unroll
        for (int j = 0; j < 4; ++j) ss += sq4(o[j]);
        const float ro = rsqrtf(wave_sum(ss) * (1.f / DM) + EPS);
        f32x4* y4 = (f32x4*)(Y + (size_t)r * DM) + lane; u32x2* yb2 = (u32x2*)(Y + (size_t)r * DM) + lane; float s2 = 0.f;
#pragma unroll
        for (int j = 0; j < 4; ++j) { x[j] = x[j] + gt[j] * (o[j] * ro * gp[j]);
            if (XOUT16) yb2[64 * j] = (u32x2){pk2(x[j].x, x[j].y), pk2(x[j].z, x[j].w)}; else y4[64 * j] = x[j];
            s2 += sq4(x[j]); }
        if (NEXT) {
            const float rx = rsqrtf(wave_sum(s2) * (1.f / DM) + EPS);
            u32x2* h2 = (u32x2*)(H + (size_t)r * DM) + lane;
#pragma unroll
            for (int j = 0; j < 4; ++j) { const f32x4 h = x[j] * rx * gn[j] * (1.f + sc[j]) + sh[j]; h2[64 * j] = (u32x2){pk2(h.x, h.y), pk2(h.z, h.w)}; }
        }
#pragma unroll
        for (int j = 0; j < 4; ++j) { co[j] = no[j]; cxb[j] = nxb[j]; cxf[j] = nxf[j];
#pragma unroll
            for (int p = 0; p < 3; ++p) cs[p][j] = ns[p][j]; }
    }
#undef POST_LOAD
}

template <bool SLAB>
__device__ __forceinline__ void phase_post16(const bf16* O, const bf16* slab, float* Y, const float* gpost, const float* modl, int gidx,
                                             const float* gpre_n, const float* modn, int sidx_n, bf16* H, int gw, int slab_off, int lane) {
    int l8 = 8 * lane; asm volatile("" : "+v"(l8));
#define RC(q) (l8 + 512 * ((q) >> 1) + 4 * ((q) & 1))
#define BF8(vv_, lo_, hi_) do { const u32x4 t_ = (vv_); lo_ = bf4((u32x2){t_.x, t_.y}); hi_ = bf4((u32x2){t_.z, t_.w}); } while (0)
#define PK8(a_, b_) ((u32x4){pk2((a_).x, (a_).y), pk2((a_).z, (a_).w), pk2((b_).x, (b_).y), pk2((b_).z, (b_).w)})
    f32x4 gp[4], gn[4];
#pragma unroll
    for (int q = 0; q < 4; ++q) { gp[q] = *(const f32x4*)(gpost + RC(q)); gn[q] = *(const f32x4*)(gpre_n + RC(q)); }
    u32x4 co[2], no[2], cxb[2], nxb[2], cs[3][2], ns[3][2];
#define POST_LOAD16(rr, it, po, pxb, ps) do { \
        const u32x4* o4_ = (const u32x4*)(O + (size_t)(rr) * DM + l8); po[0] = o4_[0]; po[1] = o4_[64]; \
        const u32x4* b4_ = (const u32x4*)((const bf16*)Y + (size_t)(rr) * (2 * DM) + l8); pxb[0] = b4_[0]; pxb[1] = b4_[64]; \
        if (SLAB && (it) >= 8) { _Pragma("unroll") for (int p = 0; p < 3; ++p) { const u32x4* s4_ = (const u32x4*)(slab + (size_t)p * SLAB_ELEMS + (size_t)((rr) - slab_off) * DM + l8); \
            ps[p][0] = s4_[0]; ps[p][1] = s4_[64]; } } } while (0)
    POST_LOAD16(gw, 0, co, cxb, cs);
    f32x4 gt[4], sh[4], sc[4]; int pcnd = -1;
#pragma unroll
    for (int i = 0; i < NIT; ++i) {
        const int r = gw + 256 * i, cnd = cond_of(r);
        if (cnd != pcnd) {
            pcnd = cnd;
#pragma unroll
            for (int q = 0; q < 4; ++q) { gt[q] = *(const f32x4*)(modl + (size_t)cnd * 6144 + gidx * DM + RC(q));
                sh[q] = *(const f32x4*)(modn + (size_t)cnd * 6144 + sidx_n * DM + RC(q)); sc[q] = *(const f32x4*)(modn + (size_t)cnd * 6144 + (sidx_n + 1) * DM + RC(q)); }
        }
        if (i + 1 < NIT) POST_LOAD16(r + 256, i + 1, no, nxb, ns);
        f32x4 o[4], x[4]; float ss = 0.f;
        BF8(co[0], o[0], o[1]); BF8(co[1], o[2], o[3]); BF8(cxb[0], x[0], x[1]); BF8(cxb[1], x[2], x[3]);
        if (SLAB && i >= 8) {
#pragma unroll
            for (int p = 0; p < 3; ++p) { f32x4 a0, a1, a2, a3; BF8(cs[p][0], a0, a1); BF8(cs[p][1], a2, a3); o[0] = o[0] + a0; o[1] = o[1] + a1; o[2] = o[2] + a2; o[3] = o[3] + a3; } }
#pragma unroll
        for (int q = 0; q < 4; ++q) ss += sq4(o[q]);
        const float ro = rsqrtf(wave_sum(ss) * (1.f / DM) + EPS);
        float s2 = 0.f;
#pragma unroll
        for (int q = 0; q < 4; ++q) { x[q] = x[q] + gt[q] * (o[q] * ro * gp[q]); s2 += sq4(x[q]); }
        { u32x4* y4b = (u32x4*)((bf16*)Y + (size_t)r * (2 * DM) + l8); y4b[0] = PK8(x[0], x[1]); y4b[64] = PK8(x[2], x[3]); }
        const float rx = rsqrtf(wave_sum(s2) * (1.f / DM) + EPS);
        f32x4 hq[4];
#pragma unroll
        for (int q = 0; q < 4; ++q) hq[q] = x[q] * rx * gn[q] * (1.f + sc[q]) + sh[q];
        { u32x4* h4 = (u32x4*)(H + (size_t)r * DM + l8); h4[0] = PK8(hq[0], hq[1]); h4[64] = PK8(hq[2], hq[3]); }
#pragma unroll
        for (int jj = 0; jj < 2; ++jj) { co[jj] = no[jj]; cxb[jj] = nxb[jj];
#pragma unroll
            for (int p = 0; p < 3; ++p) cs[p][jj] = ns[p][jj]; }
    }
#undef POST_LOAD16
#undef RC
#undef BF8
#undef PK8
}

__device__ __forceinline__ void phase_conv(const bf16* U, bf16* MIX, const float* sc_w, const float* dw_w, const float* dw_b, const float* ln_g, const float* ln_b,
                                           LAS unsigned char* lds, int tid, int wave, int lane, int G) {
    LAS bf16* zsb = (LAS bf16*)lds;
    LAS bf16* pbuf = (LAS bf16*)(lds + 62 * 1024);
    LAS bf16* zbuf = (LAS bf16*)(lds + 96 * 1024);
    LAS float* part = (LAS float*)(lds + 129 * 1024);
    LAS float* stat = part + 512;
    const int c = tid, srow = tid >> 6, ch8 = tid & 63;
    float w[31];
#pragma unroll
    for (int j = 0; j < 31; ++j) w[j] = dw_w[j * 512 + c];
    const float bdw = dw_b[c], lg = ln_g[c], lb = ln_b[c];
    u32x4 bv[8], ac[5];
#define CONV_LOAD(chn) do { const int r0n_ = 32 * (chn); const bf16* ub_ = U + (size_t)(r0n_ - 15 + srow) * CU2 + 1024 + 8 * ch8; \
        _Pragma("unroll") for (int p = 0; p < 8; ++p) { const int row = srow + 8 * p; bv[p] = *(const u32x4*)(ub_ + (size_t)(row < 62 ? 8 * p : 0) * CU2); } } while (0)
#define CONV_LOAD_A(chn) do { const int r0n_ = 32 * (chn); const bf16* ua_ = U + (size_t)(r0n_ - 1 + srow) * CU2 + 512 + 8 * ch8; \
        _Pragma("unroll") for (int p = 0; p < 5; ++p) { const int row = srow + 8 * p; ac[p] = *(const u32x4*)(ua_ + (size_t)(row < 34 ? 8 * p : 0) * CU2); } } while (0)
    const int cx = 80 * ((int)blockIdx.x & 7), cs0 = (int)blockIdx.x >> 3;
    CONV_LOAD(cx + cs0); CONV_LOAD_A(cx + cs0);
    for (int cs = cs0; cs < 80; cs += 32) { const int ch = cx + cs;
        const int r0 = 32 * ch;
        const int sq0 = r0 < TP ? (r0 & ~255) : TP + ((r0 - TP) & ~2047), sq1 = sq0 + (r0 < TP ? 256 : 2048);
#pragma unroll
        for (int p = 0; p < 8; ++p) { const int row = srow + 8 * p, rr = r0 - 15 + row; const bool ok = rr >= sq0 && rr < sq1;
            if (row < 62) *(LAS u32x4*)(zsb + row * 512 + 8 * ch8) = ok ? bv[p] : (u32x4){0u, 0u, 0u, 0u}; }
#pragma unroll
        for (int p = 0; p < 5; ++p) { const int row = srow + 8 * p, rr = r0 - 1 + row; const bool ok = rr >= sq0 && rr < sq1;
            if (row < 34) *(LAS u32x4*)(pbuf + row * 512 + 8 * ch8) = ok ? ac[p] : (u32x4){0u, 0u, 0u, 0u}; }
        __syncthreads();
        float z1[32];
        {   float z0[62];
#pragma unroll
            for (int j = 0; j < 62; ++j) z0[j] = bf2f(zsb[j * 512 + c]);
#pragma unroll
            for (int t = 0; t < 32; ++t) z1[t] = bdw;
#pragma unroll
            for (int j = 0; j < 31; ++j)
#pragma unroll
                for (int t = 0; t < 32; ++t) z1[t] += w[j] * z0[t + j]; }
        __builtin_amdgcn_sched_barrier(0);
        u32x4 gb[4];
        {   const bf16* ug = U + (size_t)(r0 + srow) * CU2 + 8 * ch8;
#pragma unroll
            for (int p = 0; p < 4; ++p) gb[p] = *(const u32x4*)(ug + (size_t)(8 * p) * CU2); }
        if (cs + 32 < 80) CONV_LOAD(ch + 32);
        __builtin_amdgcn_sched_barrier(0);
#pragma unroll
        for (int pass = 0; pass < 2; ++pass) { float v1[32];
#pragma unroll
            for (int t = 0; t < 32; ++t) v1[t] = pass ? z1[t] * z1[t] : z1[t];
#pragma unroll
            for (int st = 0; st < 5; ++st) { const int B = 32 >> st, n = 16 >> st; const bool hi = (lane & B) != 0;
#pragma unroll
                for (int i = 0; i < 16; ++i) if (i < n) { const float s1 = hi ? v1[i] : v1[i + n], k1 = hi ? v1[i + n] : v1[i]; v1[i] = k1 + __shfl_xor(s1, B); } }
            v1[0] += __shfl_xor(v1[0], 1);
            if ((lane & 1) == 0) part[pass * 256 + wave * 32 + (lane >> 1)] = v1[0];
            __builtin_amdgcn_sched_barrier(0); }
        __syncthreads();
        if (tid < 32) { float a = 0.f, b = 0.f;
#pragma unroll
            for (int q = 0; q < 8; ++q) { a += part[q * 32 + tid]; b += part[256 + q * 32 + tid]; }
            const float mean = a * (1.f / 512.f), var = fmaxf(b * (1.f / 512.f) - mean * mean, 0.f);
            stat[2 * tid] = mean; stat[2 * tid + 1] = rsqrtf(var + EPS); }
        __syncthreads();
#pragma unroll
        for (int t = 0; t < 32; ++t) { const f32x2 ms = *(const LAS f32x2*)(stat + 2 * t); const float y = (z1[t] - ms.x) * ms.y * lg + lb; zbuf[t * 512 + c] = f2bf(fsilu(y)); }
        float scw[3][8];
#pragma unroll
        for (int j = 0; j < 3; ++j) { const f32x4 a = *(const f32x4*)(sc_w + j * 512 + 8 * ch8), b = *(const f32x4*)(sc_w + j * 512 + 8 * ch8 + 4);
            scw[j][0] = a.x; scw[j][1] = a.y; scw[j][2] = a.z; scw[j][3] = a.w; scw[j][4] = b.x; scw[j][5] = b.y; scw[j][6] = b.z; scw[j][7] = b.w; }
#pragma unroll
        for (int p = 0; p < 4; ++p) { const int t = srow + 8 * p;
            float g[8], p0[8], p1[8], p2[8]; unpack8(gb[p], g);
            unpack8(*(const LAS u32x4*)(pbuf + t * 512 + 8 * ch8), p0); unpack8(*(const LAS u32x4*)(pbuf + (t + 1) * 512 + 8 * ch8), p1); unpack8(*(const LAS u32x4*)(pbuf + (t + 2) * 512 + 8 * ch8), p2);
#pragma unroll
            for (int k = 0; k < 8; ++k) g[k] = g[k] * (scw[0][k] * p0[k] + scw[1][k] * p1[k] + scw[2][k] * p2[k]);
            *(u32x4*)(MIX + (size_t)(r0 + t) * DM + 8 * ch8) = pack8(g); }
        __builtin_amdgcn_sched_barrier(0);
        if (cs + 32 < 80) CONV_LOAD_A(ch + 32);
        __syncthreads();
#pragma unroll
        for (int p = 0; p < 4; ++p) { const int t = srow + 8 * p; *(u32x4*)(MIX + (size_t)(r0 + t) * DM + 512 + 8 * ch8) = *(const LAS u32x4*)(zbuf + t * 512 + 8 * ch8); }
    }
#undef CONV_LOAD
#undef CONV_LOAD_A
}

__device__ __forceinline__ void rope_head64(float (&v)[8], int lane, const f32x2 (&cs)[8]) {
    const bool second = (lane & 2) != 0;
#pragma unroll
    for (int j = 0; j < 8; ++j) { const float pv = __shfl_xor(v[j], 2);
        v[j] = second ? v[j] * cs[j].x + pv * cs[j].y : v[j] * cs[j].x - pv * cs[j].y; }
}
__device__ __forceinline__ void phase_attn_rows(const bf16* U1, const float* qn, const float* kn, const float* qan, const float* kvan, const f32x2* tabg, const f32x2* tabm,
                                                bf16* QC, bf16* KC, bf16* VtC, bf16* QA, bf16* CKV, bf16* KR, float* o_k, float* o_v, float* o_ckv, float* o_kr,
                                                const float* c_k, const float* c_v, const float* c_ckv, const float* c_kr, LAS unsigned char* lds, int bid, int tid, int wave, int lane) {
    LAS bf16* vbuf = (LAS bf16*)lds;
    LAS f32x2* ltg = (LAS f32x2*)(lds + 8192);
    LAS f32x2* ltm = ltg + 64 * 16;
    { const u32x4* src = (const u32x4*)tabg; LAS u32x4* dst = (LAS u32x4*)(lds + 8192); dst[tid] = src[tid]; if (tid < 256) dst[512 + tid] = src[512 + tid]; }
    const int pb = (bid & 7) * 32 + (bid >> 3);
    const int gw = pb * NWAVES + wave, rb0 = 2560 * (bid & 7) + 8 * (bid >> 3), r0 = rb0 + wave, l2 = lane & 31,
    l3 = lane < 48 ? lane : 0, l4 = lane & 3, d0 = 8 * (lane & 7);
    const bool hi32 = lane >= 32, krl = lane >= 48 && lane < 52;
    float knv[8], qav[8], kvv[8];
#pragma unroll
    for (int j = 0; j < 8; ++j) { knv[j] = kn[d0 + j]; qav[j] = qan[8 * l3 + j]; kvv[j] = kvan[8 * l2 + j]; }
    u32x4 ckv_, cqa, nkv, nqa;
    const int okv = hi32 ? 640 + 8 * l2 : 8 * l2, oqa = lane < 48 ? 256 + 8 * lane : 896 + 8 * l4;
#define AR_LOAD(rr, pkv, pqa) do { const bf16* u_ = U1 + (size_t)(rr) * U1W; pkv = *(const u32x4*)(u_ + okv); pqa = *(const u32x4*)(u_ + oqa); } while (0)
    AR_LOAD(r0, ckv_, cqa);
    const f32x4 ck4 = *(const f32x4*)(c_k + (size_t)gw * 128 + 4 * l2), cv4 = *(const f32x4*)(c_v + (size_t)gw * 128 + 4 * l2), cc4 = *(const f32x4*)(c_ckv + (size_t)gw * 256 + 4 * lane);
    const float ckr1 = c_kr[(size_t)gw * 32 + l2];
    __syncthreads();
#pragma unroll 1
    for (int i = 0; i < NIT; ++i) {
        const int r = r0 + 256 * i;
        if (i + 1 < NIT) AR_LOAD(r + 256, nkv, nqa);
        const bool smp = r >= TP; const int ts = (r - TP) & 2047, prow = ts >> 6, pcol = ts & 63;
        const int krow = smp ? TP + ((r - TP) >> 11) * KSEQ + PAST + ts : r;
        f32x2 csg[8];
        { const LAS f32x4* t4 = (const LAS f32x4*)(ltg + ((lane & 4) ? pcol : prow) * 16 + 8 * (lane & 1));
#pragma unroll
          for (int j = 0; j < 4; ++j) { const f32x4 t = t4[j]; csg[2 * j] = (f32x2){t.x, t.y}; csg[2 * j + 1] = (f32x2){t.z, t.w}; } }
        float ssc;
        {
            float v[8], raw[8]; unpack8(ckv_, v);
            float ss = 0.f;
#pragma unroll
            for (int j = 0; j < 8; ++j) { raw[j] = v[j]; ss += v[j] * v[j]; }
            ssc = ss;
            ss += __shfl_xor(ss, 1); ss += __shfl_xor(ss, 2); ss += __shfl_xor(ss, 4);
            const float rstd = rsqrtf(ss * (1.f / 64.f) + EPS);
#pragma unroll
            for (int j = 0; j < 8; ++j) v[j] = v[j] * rstd * knv[j];
            if (lane < 16 && !smp) { float* ok = o_k + (size_t)r * 128 + 8 * lane; *(f32x4*)ok = (f32x4){v[0], v[1], v[2], v[3]}; *(f32x4*)(ok + 4) = (f32x4){v[4], v[5], v[6], v[7]}; }
            float vr[8];
#pragma unroll
            for (int j = 0; j < 8; ++j) vr[j] = v[j];
            rope_head64(vr, lane, csg);
#pragma unroll
            for (int j = 0; j < 8; ++j) v[j] = smp ? vr[j] : v[j];
            if (lane < 16) *(u32x4*)(KC + (size_t)krow * 128 + 8 * lane) = pack8(v);
            else if (lane < 32) { const int cv = 8 * (lane - 16);
                *(LAS u32x4*)(vbuf + ((i & 1) * 8 + wave) * 128 + cv) = ckv_;
                if (!smp) { float* ov = o_v + (size_t)r * 128 + cv; *(f32x4*)ov = (f32x4){raw[0], raw[1], raw[2], raw[3]}; *(f32x4*)(ov + 4) = (f32x4){raw[4], raw[5], raw[6], raw[7]}; } }
            const float sc = wave_sum(hi32 ? ssc : 0.f);
            const float rc = rsqrtf(sc * (1.f / 256.f) + EPS);
            if (hi32) { float c[8];
#pragma unroll
                for (int j = 0; j < 8; ++j) c[j] = raw[j] * rc * kvv[j];
                *(u32x4*)(CKV + (size_t)krow * KVL + 8 * l2) = pack8(c);
                if (!smp) { float* oc = o_ckv + (size_t)r * 256 + 8 * l2; *(f32x4*)oc = (f32x4){c[0], c[1], c[2], c[3]}; *(f32x4*)(oc + 4) = (f32x4){c[4], c[5], c[6], c[7]}; } }
        }
        {
            float v[8]; unpack8(cqa, v);
            float ss = 0.f;
#pragma unroll
            for (int j = 0; j < 8; ++j) ss += v[j] * v[j];
            ss = wave_sum(lane < 48 ? ss : 0.f);
            const float rstd = rsqrtf(ss * (1.f / 384.f) + EPS);
            if (lane < 48) { float a[8];
#pragma unroll
                for (int j = 0; j < 8; ++j) a[j] = v[j] * rstd * qav[j];
                *(u32x4*)(QA + (size_t)r * QL + 8 * lane) = pack8(a); }
            const int blk = l4 >> 1, pos = blk ? pcol : prow; const bool second = (l4 & 1) != 0;
            if (krl && !smp) { float* okr = o_kr + (size_t)r * 32 + 8 * l4; *(f32x4*)okr = (f32x4){v[0], v[1], v[2], v[3]}; *(f32x4*)(okr + 4) = (f32x4){v[4], v[5], v[6], v[7]}; }
            const LAS f32x4* t4 = (const LAS f32x4*)(ltm + pos * 8);
            unsigned wd[8];
#pragma unroll
            for (int j = 0; j < 4; ++j) { const f32x4 t = t4[j];
#pragma unroll
                for (int q = 0; q < 2; ++q) { const int jj = 2 * j + q; const float cx = q ? t.z : t.x, sx = q ? t.w : t.y;
                    const float pv = __shfl_xor(v[jj], 1);
                    const float rv = second ? v[jj] * cx + pv * sx : v[jj] * cx - pv * sx; const float o = smp ? rv : v[jj];
                    const float po = __shfl_xor(o, 1);
                    wd[jj] = second ? pk2(po, o) : pk2(o, po); } }
            if (krl) *(u32x4*)(KR + (size_t)krow * 32 + 16 * blk + (second ? 8 : 0)) = second ? (u32x4){wd[4], wd[5], wd[6], wd[7]} : (u32x4){wd[0], wd[1], wd[2], wd[3]};
        }
        __syncthreads();
        if (tid < 128) {
            const int rb = rb0 + 256 * i, kb = rb >= TP ? TP + ((rb - TP) >> 11) * KSEQ + PAST + ((rb - TP) & 2047) : rb;
            const LAS bf16* vp = vbuf + (i & 1) * 1024 + tid; u32x4 w;
            w.x = (unsigned)vp[0] | ((unsigned)vp[128] << 16); w.y = (unsigned)vp[256] | ((unsigned)vp[384] << 16); w.z = (unsigned)vp[512] | ((unsigned)vp[640] << 16); w.w = (unsigned)vp[768] | ((unsigned)vp[896] << 16);
            *(u32x4*)(VtC + (size_t)tid * TK + kb) = w; }
        ckv_ = nkv; cqa = nqa;
    }
#undef AR_LOAD
    {   const int cr = gw, krow = TP + (cr >> 8) * KSEQ + (cr & 255);
        __syncthreads();
        if (lane < 32) { *(u32x2*)(KC + (size_t)krow * 128 + 4 * lane) = (u32x2){pk2(ck4.x, ck4.y), pk2(ck4.z, ck4.w)};
            *(LAS u32x2*)(vbuf + wave * 128 + 4 * lane) = (u32x2){pk2(cv4.x, cv4.y), pk2(cv4.z, cv4.w)};
            const int e = lane, blk = e >> 4, loc = e & 15; KR[(size_t)krow * 32 + 16 * blk + 2 * (loc & 7) + (loc >> 3)] = f2bf(ckr1); }
        *(u32x2*)(CKV + (size_t)krow * KVL + 4 * lane) = (u32x2){pk2(cc4.x, cc4.y), pk2(cc4.z, cc4.w)};
        __syncthreads();
        if (tid < 128) { const int cb = pb * NWAVES, kb = TP + (cb >> 8) * KSEQ + (cb & 255);
            const LAS bf16* vp = vbuf + tid; u32x4 w;
            w.x = (unsigned)vp[0] | ((unsigned)vp[128] << 16); w.y = (unsigned)vp[256] | ((unsigned)vp[384] << 16); w.z = (unsigned)vp[512] | ((unsigned)vp[640] << 16); w.w = (unsigned)vp[768] | ((unsigned)vp[896] << 16);
            *(u32x4*)(VtC + (size_t)tid * TK + kb) = w; }
        __syncthreads();
    }
}

#define MFMA32(a, b, c) __builtin_amdgcn_mfma_f32_32x32x16_bf16((a), (b), (c), 0, 0, 0)
template <bool MLA, int ABL>
__device__ __forceinline__ void attn_tile(const LAS unsigned char* kb, const LAS unsigned char* rb, const LAS unsigned char* vb, const bf16x8 (&qf)[MLA ? 6 : 4],
                                          f32x16& o0, f32x16& o1, float& m, float& l, float c, int r, int h) {
    constexpr int NQ = MLA ? 6 : 4;
    f32x16 p0, p1;
#pragma unroll
    for (int i = 0; i < 16; ++i) { p0[i] = 0.f; p1[i] = 0.f; }
#pragma unroll
    for (int ks = 0; ks < 4; ++ks) { const bf16x8 a0 = *(const LAS bf16x8*)(kb + r * 144 + ks * 32 + h * 16), a1 = *(const LAS bf16x8*)(kb + (32 + r) * 144 + ks * 32 + h * 16);
        p0 = MFMA32(a0, qf[ks], p0); p1 = MFMA32(a1, qf[ks], p1); }
    if (MLA) {
#pragma unroll
        for (int ks = 0; ks < 2; ++ks) { const bf16x8 a0 = *(const LAS bf16x8*)(rb + r * 80 + ks * 32 + h * 16), a1 = *(const LAS bf16x8*)(rb + (32 + r) * 80 + ks * 32 + h * 16);
            p0 = MFMA32(a0, qf[NQ - 2 + ks], p0); p1 = MFMA32(a1, qf[NQ - 2 + ks], p1); } }
    bf16x8 vf[2][2][2];
#pragma unroll
    for (int t = 0; t < 2; ++t)
#pragma unroll
        for (int s = 0; s < 2; ++s)
#pragma unroll
            for (int dh = 0; dh < 2; ++dh) vf[t][s][dh] = *(const LAS bf16x8*)(vb + (32 * dh + r) * 144 + 64 * t + 32 * s + 16 * h);
    __builtin_amdgcn_sched_barrier(0);
    if (ABL != 1 && ABL != 3) {
    float mx = p0[0];
#pragma unroll
    for (int i = 1; i < 16; ++i) mx = fmaxf(mx, p0[i]);
#pragma unroll
    for (int i = 0; i < 16; ++i) mx = fmaxf(mx, p1[i]);
    mx = fmaxf(mx, __shfl_xor(mx, 32));
    if (!__all((mx - m) * c <= 8.f)) {
        const float mn = fmaxf(m, mx), alpha = __builtin_amdgcn_exp2f((m - mn) * c); m = mn; l *= alpha;
#pragma unroll
        for (int i = 0; i < 16; ++i) { o0[i] *= alpha; o1[i] *= alpha; }
    }
    const float mc = -m * c;
    float ps = 0.f;
#pragma unroll
    for (int i = 0; i < 16; ++i) { p0[i] = __builtin_amdgcn_exp2f(fmaf(p0[i], c, mc)); ps += p0[i]; }
#pragma unroll
    for (int i = 0; i < 16; ++i) { p1[i] = __builtin_amdgcn_exp2f(fmaf(p1[i], c, mc)); ps += p1[i]; }
    l += ps;
    }
    bf16x8 pb[2][2];
#pragma unroll
    for (int s = 0; s < 2; ++s) {
        u32x4 w0; w0.x = pk2(p0[8 * s + 0], p0[8 * s + 1]); w0.y = pk2(p0[8 * s + 2], p0[8 * s + 3]); w0.z = pk2(p0[8 * s + 4], p0[8 * s + 5]); w0.w = pk2(p0[8 * s + 6], p0[8 * s + 7]);
        u32x4 w1; w1.x = pk2(p1[8 * s + 0], p1[8 * s + 1]); w1.y = pk2(p1[8 * s + 2], p1[8 * s + 3]); w1.z = pk2(p1[8 * s + 4], p1[8 * s + 5]); w1.w = pk2(p1[8 * s + 6], p1[8 * s + 7]);
        pb[0][s] = __builtin_bit_cast(bf16x8, w0); pb[1][s] = __builtin_bit_cast(bf16x8, w1); }
    __builtin_amdgcn_sched_barrier(0);
#pragma unroll
    for (int t = 0; t < 2; ++t)
#pragma unroll
        for (int s = 0; s < 2; ++s) {
            o0 = MFMA32(vf[t][s][0], pb[t][s], o0);
            o1 = MFMA32(vf[t][s][1], pb[t][s], o1); }
    __builtin_amdgcn_sched_barrier(0);
}
constexpr int ATT_TAB_OFF = 100 * 1024;
struct AttnNext { const bf16* Q; const bf16* K; const bf16* V; const bf16* KR; int ldq, ldk; };
template <bool MLA, int ABL = 0>
__device__ __forceinline__ void attn_unit(LAS unsigned char* lds, const bf16* Q, int ldq, const bf16* K, int ldk, const bf16* KRp, const bf16* Vt, int nkeys, bf16* O, float c,
                                          const f32x2* tabm, int qpos0, int tid, int wave, int lane, const AttnNext& nx) {
    constexpr int NQ = MLA ? 6 : 4;
    constexpr int KB_SZ = 64 * 144, KR_OFF = 4 * KB_SZ, KR_SZ = 64 * 80, VT_OFF = KR_OFF + 4 * KR_SZ, VT_SZ = 64 * 144;
    const int r = lane & 31, h = lane >> 5;
    const int skey = tid >> 3, sch = tid & 7;
    const bf16* kg = K + (size_t)skey * ldk + 8 * sch;
    const bf16* vg = Vt + (size_t)skey * TK + 8 * sch;
    const bf16* rg = KRp + (size_t)(tid >> 2) * 32 + 8 * (tid & 3);
    const int kw = skey * 144 + sch * 16, vw = skey * 144 + (sch >> 1) * 32 + (sch & 1) * 8, rw = (tid >> 2) * 80 + (tid & 3) * 16;
    const int np = nkeys >> 7;
    u32x4 kreg[2], vreg[2], rreg[2];
#define AT_LOAD(pp) do { _Pragma("unroll") for (int q_ = 0; q_ < 2; ++q_) { const int tt_ = 2 * (pp) + q_; kreg[q_] = *(const u32x4*)(kg + (size_t)tt_ * 64 * ldk); vreg[q_] = *(const u32x4*)(vg + tt_ * 64); \
        if (MLA && tid < 256) rreg[q_] = *(const u32x4*)(rg + (size_t)tt_ * 64 * 32); } } while (0)
#define AT_WRITE(pr) do { _Pragma("unroll") for (int q_ = 0; q_ < 2; ++q_) { const int sl_ = 2 * (pr) + q_; *(LAS u32x4*)(lds + sl_ * KB_SZ + kw) = kreg[q_]; \
        *(LAS u32x2*)(lds + VT_OFF + sl_ * VT_SZ + vw) = (u32x2){vreg[q_].x, vreg[q_].y}; *(LAS u32x2*)(lds + VT_OFF + sl_ * VT_SZ + vw + 16) = (u32x2){vreg[q_].z, vreg[q_].w}; \
        if (MLA && tid < 256) *(LAS u32x4*)(lds + KR_OFF + sl_ * KR_SZ + rw) = rreg[q_]; } } while (0)
    AT_LOAD(0);
    bf16x8 qf[NQ];
    { const bf16* qrow = Q + (size_t)(32 * wave + r) * ldq + 8 * h;
#pragma unroll
      for (int ks = 0; ks < NQ; ++ks) qf[ks] = *(const bf16x8*)(qrow + 16 * ks); }
    if (MLA && qpos0 >= 0) {
        const int ts = qpos0 + 32 * wave + r, prow = ts >> 6, pcol = ts & 63;
#pragma unroll
        for (int blk = 0; blk < 2; ++blk) { const u32x4 w = __builtin_bit_cast(u32x4, qf[NQ - 2 + blk]); float v[8]; unpack8(w, v); const int pos = blk ? pcol : prow;
#pragma unroll
            for (int jj = 0; jj < 4; ++jj) { const f32x2 cs = ((const LAS f32x2*)(lds + ATT_TAB_OFF + 8448))[pos * 8 + 4 * h + jj]; const float x1 = v[2 * jj], x2 = v[2 * jj + 1]; v[2 * jj] = x1 * cs.x - x2 * cs.y; v[2 * jj + 1] = x2 * cs.x + x1 * cs.y; }
            qf[NQ - 2 + blk] = __builtin_bit_cast(bf16x8, pack8(v)); }
    }
    const LAS f32x2* ltg = (const LAS f32x2*)(lds + ATT_TAB_OFF); const LAS float* lqn = (const LAS float*)(lds + ATT_TAB_OFF + 8192);
    if (!MLA) {
        float v[4][8];
#pragma unroll
        for (int ks = 0; ks < 4; ++ks) unpack8(__builtin_bit_cast(u32x4, qf[ks]), v[ks]);
        float ss = 0.f;
#pragma unroll
        for (int ks = 0; ks < 4; ++ks)
#pragma unroll
            for (int j = 0; j < 8; ++j) ss += v[ks][j] * v[ks][j];
        ss += __shfl_xor(ss, 32);
        const float rstd = rsqrtf(ss * (1.f / 64.f) + EPS);
#pragma unroll
        for (int ks = 0; ks < 4; ++ks) { const f32x4 g0 = *(const LAS f32x4*)(lqn + 16 * ks + 8 * h), g1 = *(const LAS f32x4*)(lqn + 16 * ks + 8 * h + 4);
            v[ks][0] *= rstd * g0.x; v[ks][1] *= rstd * g0.y; v[ks][2] *= rstd * g0.z; v[ks][3] *= rstd * g0.w; v[ks][4] *= rstd * g1.x; v[ks][5] *= rstd * g1.y; v[ks][6] *= rstd * g1.z; v[ks][7] *= rstd * g1.w; }
        if (qpos0 >= 0) {
            const int ts = qpos0 + 32 * wave + r, prow = ts >> 6, pcol = ts & 63;
#pragma unroll
            for (int hf = 0; hf < 2; ++hf) { const LAS f32x2* tg = ltg + (hf ? pcol : prow) * 16 + 8 * h;
#pragma unroll
                for (int j = 0; j < 8; ++j) { const f32x2 cs = tg[j]; const float x1 = v[2 * hf][j], x2 = v[2 * hf + 1][j]; v[2 * hf][j] = x1 * cs.x - x2 * cs.y; v[2 * hf + 1][j] = x2 * cs.x + x1 * cs.y; } }
        }
#pragma unroll
        for (int ks = 0; ks < 4; ++ks) qf[ks] = __builtin_bit_cast(bf16x8, pack8(v[ks]));
    }
    f32x16 o0, o1;
#pragma unroll
    for (int i = 0; i < 16; ++i) { o0[i] = 0.f; o1[i] = 0.f; }
    float m = -1e30f, l = 0.f; unsigned pf = 0u;
    AT_WRITE(0);
    __syncthreads();
    for (int j = 0; j < np; ++j) {
        const int cur = j & 1; const bool more = j + 1 < np;
        if (ABL != 3) { if (more) AT_LOAD(j + 1); }
        if (!more) {
            const unsigned* pa = (const unsigned*)(nx.Q + (size_t)(tid >> 1) * nx.ldq + (tid & 1) * 64);
            const unsigned* pb = tid < 128 ? (const unsigned*)(nx.K + (size_t)tid * nx.ldk)
                               : tid < 256 ? (const unsigned*)(nx.V + (size_t)((tid - 128) >> 1) * TK + (tid & 1) * 64)
                               : tid < 320 ? (const unsigned*)(nx.KR + (size_t)(2 * (tid - 256)) * 32) : pa;
            pf = *pa ^ *pb; }
#pragma unroll
        for (int q = 0; q < 2; ++q) { const int sl = 2 * cur + q;
            attn_tile<MLA, ABL>(lds + sl * KB_SZ, lds + KR_OFF + sl * KR_SZ, lds + VT_OFF + sl * VT_SZ, qf, o0, o1, m, l, c, r, h); }
        if (ABL != 3) { if (more) AT_WRITE(cur ^ 1);
        __syncthreads(); }
    }
#undef AT_LOAD
#undef AT_WRITE
    *(LAS unsigned*)(lds + 96 * 1024 + 4 * tid) = pf;
    l += __shfl_xor(l, 32);
    const float inv = 1.f / l;
    bf16* orow = O + (size_t)(32 * wave + r) * DM;
#pragma unroll
    for (int hf = 0; hf < 2; ++hf)
#pragma unroll
        for (int pp = 0; pp < 2; ++pp) {
            const int ga = 2 * pp, gb2 = 2 * pp + 1;
#define OV(g_, k_) ((hf ? o1[4 * (g_) + (k_)] : o0[4 * (g_) + (k_)]) * inv)
            const u32x2 wa = (u32x2){pk2(OV(ga, 0), OV(ga, 1)), pk2(OV(ga, 2), OV(ga, 3))}, wb = (u32x2){pk2(OV(gb2, 0), OV(gb2, 1)), pk2(OV(gb2, 2), OV(gb2, 3))};
#undef OV
            const u32x2 snd = h ? wa : wb;
            const u32x2 rcv = (u32x2){(unsigned)__shfl_xor((int)snd.x, 32), (unsigned)__shfl_xor((int)snd.y, 32)};
            const u32x4 w = h ? (u32x4){rcv.x, rcv.y, wb.x, wb.y} : (u32x4){wa.x, wa.y, rcv.x, rcv.y};
            *(u32x4*)(orow + 32 * hf + 16 * pp + 8 * h) = w; }
}
__device__ __forceinline__ void phase_attention(unsigned char* ws, LAS unsigned char* lds, const f32x2* tabg, const f32x2* tabm, const float* qn, int tid, int wave, int lane, int G) {
    const bf16* QC = (const bf16*)(ws + WS_C + C_QC); const bf16* MQ = (const bf16*)(ws + WS_C + C_MQ); const bf16* KN = (const bf16*)(ws + WS_C + C_KN);
    const bf16* VTM = (const bf16*)(ws + WS_C + C_VTM); const bf16* KC = (const bf16*)(ws + WS_A + A_KC); const bf16* VTC = (const bf16*)(ws + WS_A + A_VTC);
    const bf16* KR = (const bf16*)(ws + WS_A + A_KR); bf16* ATT = (bf16*)(ws + WS_B);
    constexpr float C_G = 0.125f * 1.4426950408889634f, C_M = 0.10206207261596577f * 1.4426950408889634f;
    {   ((LAS u32x4*)(lds + ATT_TAB_OFF))[tid] = ((const u32x4*)tabg)[tid];
        if (tid < 16) ((LAS f32x4*)(lds + ATT_TAB_OFF + 8192))[tid] = ((const f32x4*)qn)[tid];
        if (tid < 256) ((LAS u32x4*)(lds + ATT_TAB_OFF + 8448))[tid] = ((const u32x4*)tabm)[tid];
        __syncthreads(); }
    if (wave >= 4) __builtin_amdgcn_s_setprio(1);
    for (int i = blockIdx.x; i < 1280; i += G) {
        bool mla; int row0, key0, nkeys, hh, qpos0;
        if (i < 1024) { mla = i < 512; const int ii = i & 511, j = ii >> 3, b = j >> 3, qb = j & 7; hh = ii & 7;
            row0 = TP + b * SEQS + qb * 256; key0 = TP + b * KSEQ; nkeys = KSEQ; qpos0 = qb * 256; }
        else { mla = i < 1152; const int ii = (i - 1024) & 127, b = ii >> 3; hh = ii & 7; row0 = b * 256; key0 = row0; nkeys = 256; qpos0 = -1; }
        AttnNext nx;
        {   const int n = i + G < 1280 ? i + G : i; bool nm; int nr, nk, nh;
            if (n < 1024) { nm = n < 512; const int ii = n & 511, j = ii >> 3, b = j >> 3, qb = j & 7; nh = ii & 7; nr = TP + b * SEQS + qb * 256; nk = TP + b * KSEQ; }
            else { nm = n < 1152; const int ii = (n - 1024) & 127, b = ii >> 3; nh = ii & 7; nr = b * 256; nk = nr; }
            if (nm) { nx.Q = MQ + (size_t)nr * MQD + nh * 96; nx.ldq = MQD; nx.K = KN + (size_t)nk * 512 + nh * 64; nx.ldk = 512; nx.V = VTM + (size_t)(nh * 64) * TK + nk; nx.KR = KR + (size_t)nk * 32; }
            else { nx.Q = QC + (size_t)nr * 512 + nh * 64; nx.ldq = 512; nx.K = KC + (size_t)nk * 128 + (nh >> 2) * 64; nx.ldk = 128; nx.V = VTC + (size_t)((nh >> 2) * 64) * TK + nk; nx.KR = KR + (size_t)nk * 32; } }
        if (mla) attn_unit<true>(lds, MQ + (size_t)row0 * MQD + hh * 96, MQD, KN + (size_t)key0 * 512 + hh * 64, 512, KR + (size_t)key0 * 32, VTM + (size_t)(hh * 64) * TK + key0, nkeys,
                                 ATT + (size_t)row0 * DM + 512 + hh * 64, C_M, tabm, qpos0, tid, wave, lane, nx);
        else attn_unit<false>(lds, QC + (size_t)row0 * 512 + hh * 64, 512, KC + (size_t)key0 * 128 + (hh >> 2) * 64, 128, KR, VTC + (size_t)((hh >> 2) * 64) * TK + key0, nkeys,
                              ATT + (size_t)row0 * DM + hh * 64, C_G, tabm, qpos0, tid, wave, lane, nx);
    }
    if (wave >= 4) __builtin_amdgcn_s_setprio(0);
}

#define XB_TMO      128
#define XB_XCNT(j)  (256  + 64 * (j))
#define XB_XSUB(j)  (1280 + 64 * (j))
#define XB_XGEN(j)  (2304 + 64 * (j))
#define XB_TOP      3328
#define XB_TOPGEN   3392
#define XCD_BAR_WORDS 3456
#define XB_SPIN_CAP (1u << 18)

__device__ __forceinline__ unsigned xb_ld(unsigned* p)              { return __hip_atomic_load(p, __ATOMIC_RELAXED, __HIP_MEMORY_SCOPE_AGENT); }
__device__ __forceinline__ unsigned xb_add(unsigned* p, unsigned v) { return __hip_atomic_fetch_add(p, v, __ATOMIC_RELAXED, __HIP_MEMORY_SCOPE_AGENT); }
__device__ __forceinline__ unsigned xb_xcc_id() { return (unsigned)__builtin_amdgcn_s_getreg((3 << 11) | 20) & 0xFu; }
#define XB_SPIN(cond, bar) do { unsigned _sp = 0; while (cond) { __builtin_amdgcn_s_sleep(1); \
    if ((++_sp & 255u) == 0u) { if (xb_ld(&(bar)[XB_TMO])) break; if (_sp > XB_SPIN_CAP) { atomicAdd(&(bar)[XB_TMO], 1u); break; } } } } while (0)

struct XcdBarrier {
    unsigned* bar; unsigned x;
    volatile LAS unsigned* st;
};

__device__ __forceinline__ XcdBarrier xcd_barrier_post(unsigned* bar, volatile LAS unsigned* st) {
    XcdBarrier b; b.bar = bar; b.x = xb_xcc_id(); b.st = st;
    if (threadIdx.x == 0) (void)xb_add(&bar[XB_XCNT(b.x)], 1u);
    return b;
}
__device__ __forceinline__ void xcd_barrier_complete(unsigned* bar, unsigned x, unsigned& nloc, unsigned& nx) {
    const unsigned G = gridDim.x * gridDim.y * gridDim.z;
    unsigned sum, cnt, mine, sp = 0u;
    for (;;) {
        sum = 0u; cnt = 0u; mine = 0u;
#pragma unroll
        for (unsigned j = 0; j < 16; ++j) { const unsigned c = xb_ld(&bar[XB_XCNT(j)]); sum += c; cnt += (c > 0u) ? 1u : 0u; mine = (j == x) ? c : mine; }
        if (sum == G) break;
        __builtin_amdgcn_s_sleep(1);
        if ((++sp & 255u) == 0u) { if (xb_ld(&bar[XB_TMO])) break; if (sp > XB_SPIN_CAP) { atomicAdd(&bar[XB_TMO], 1u); break; } }
    }
    nloc = mine > 0u ? mine : 1u; nx = cnt > 0u ? cnt : 1u;
}

__device__ __forceinline__ void xcd_barrier(const XcdBarrier& b) {
    asm volatile("s_waitcnt vmcnt(0)" ::: "memory");
    __syncthreads();
    if (threadIdx.x == 64) {
        __builtin_amdgcn_fence(__ATOMIC_ACQUIRE, "agent");
        asm volatile("s_waitcnt vmcnt(0)" ::: "memory");
    }
    if (threadIdx.x == 0) {
        unsigned* bar = b.bar;
        __builtin_amdgcn_s_waitcnt(0);
        unsigned nloc = b.st[0], nx = b.st[1];
        const unsigned gen = b.st[2];
        if (nloc == 0u) { xcd_barrier_complete(bar, b.x, nloc, nx); b.st[0] = nloc; b.st[1] = nx; }
        b.st[2] = gen + 1u;
        const unsigned old = xb_add(&bar[XB_XSUB(b.x)], 1u);
        if (old + 1u == (gen + 1u) * nloc) {
            __builtin_amdgcn_fence(__ATOMIC_RELEASE, "agent");
            asm volatile("s_waitcnt vmcnt(0)" ::: "memory");
            (void)xb_add(&bar[XB_TOP], 1u);
        }
        const unsigned target = (gen + 1u) * nx;
        XB_SPIN(xb_ld(&bar[XB_TOP]) < target, bar);
        asm volatile("s_waitcnt vmcnt(0)" ::: "memory");
    }
    __syncthreads();
}

struct Args { const float* in[32]; float* out; unsigned char* ws; int ph_lo, ph_hi; };
constexpr int NPHASE = 18;

#ifndef PG8_SP2
#define PG8_SP2 true
#endif
#ifndef PG8_ALIGN
#define PG8_ALIGN true
#endif
struct FullOrder {
    pg8::StaticOrder S; int nt;
    __device__ __forceinline__ void init(int M, int N, int K, int G, int c) { S.init(M, N, G, c); nt = K / 64; }
    __device__ __forceinline__ bool next(int i, pg8::Unit& u) const { if (!S.next(i, u)) return false; u.koff = 0; u.nt = nt; u.part = 0; return true; }
    __device__ __forceinline__ void a_ready(const pg8::Unit&) const {}
    __device__ __forceinline__ void done(const pg8::Unit&) const {}
};
struct SplitTailOrder {
    int c, K;
    __device__ __forceinline__ bool next(int i, pg8::Unit& u) const {
        const int x = c & 7, slot = c >> 3;
        if (i == 0) { u.pm = 10 * x + (slot >> 2); u.pn = slot & 3; u.koff = 0; u.nt = K / 64; u.part = 0; return true; }
        if (i == 1) { u.pm = 10 * x + 8 + (slot >> 4); u.pn = (slot >> 2) & 3; u.part = slot & 3;
            if (K == 1024) { u.koff = 256 * u.part; u.nt = 4; } else { u.koff = 64 * (u.part < 2 ? 12 * u.part : 24 + 10 * (u.part - 2)); u.nt = u.part < 2 ? 12 : 10; }
            return true; }
        return false;
    }
    __device__ __forceinline__ void a_ready(const pg8::Unit&) const {}
    __device__ __forceinline__ void done(const pg8::Unit&) const {}
};
template <class Epi>
__device__ __forceinline__ void run_gemm(LAS unsigned char* lds, const bf16* A, const bf16* Bt, int M, int N, int K, int G, int cid, const Epi& E) {
    pg8::Gemm g{A, Bt, M, N, K}; FullOrder S; S.init(M, N, K, G, cid);
    pg8::gemm_phase<Epi, FullOrder, PG8_ALIGN, PG8_SP2>(lds, g, S, E);
}
template <class Epi>
__device__ __forceinline__ void run_gemm_split(LAS unsigned char* lds, const bf16* A, const bf16* Bt, int K, int cid, const Epi& E) {
    pg8::Gemm g{A, Bt, T, 1024, K}; SplitTailOrder S{cid, K};
    pg8::gemm_phase<Epi, SplitTailOrder, PG8_ALIGN, PG8_SP2>(lds, g, S, E);
}

__global__ void __launch_bounds__(NTHR, 2) fwd_kernel(Args args) {
    extern __shared__ __attribute__((aligned(16))) unsigned char lds_raw[];
    LAS unsigned char* lds = (LAS unsigned char*)lds_raw;
#if MK_CG_SYNC
    cg::grid_group grid = cg::this_grid();
#endif
    const int tid = threadIdx.x, lane = tid & 63, wave = __builtin_amdgcn_readfirstlane(tid >> 6);
    const int G = gridDim.x, bid = blockIdx.x, gw = bid * NWAVES + wave, ngw = G * NWAVES;
    unsigned char* ws = args.ws; const float* const* in = args.in; float* out = args.out;
    const int lo = args.ph_lo, hi = args.ph_hi;
#ifndef REP_PHASE
#define REP_PHASE (-1)
#define REP_N 1
#endif
#define PH(k) if (IN(k)) for (int rp_ = 0; rp_ < ((k) == REP_PHASE ? REP_N : 1); ++rp_)
#ifndef PH_MASK
#define PH_MASK 0x3ffff
#endif
#define IN(k) (((PH_MASK >> (k)) & 1) && lo <= (k) && (k) < hi)
#if MK_CG_SYNC
#define SEAM(k) do { if (IN(k) && IN((k) + 1)) grid.sync(); } while (0)
#else
    if (tid < 3) ((volatile LAS unsigned*)(lds + 131072))[tid] = 0u;
    __syncthreads();
    const XcdBarrier bar = xcd_barrier_post((unsigned*)(args.ws + WS_CTL), (volatile LAS unsigned*)(lds + 131072));
#ifdef PROBE_TS
    volatile LAS unsigned long long* tsl = (volatile LAS unsigned long long*)(lds + 131072 + 256);
    if (bid == 0 && tid == 0) tsl[0] = __builtin_amdgcn_s_memrealtime();
#ifndef PROBE_XBAR
#define PROBE_XBAR 0
#endif
#ifndef PROBE_SUB
#define PROBE_SUB 0.f
#endif
#define SEAM(k) do { if (IN(k) && IN((k) + 1)) { xcd_barrier(bar); for (int xb_ = 0; xb_ < PROBE_XBAR; ++xb_) xcd_barrier(bar); if (bid == 0 && tid == 0) tsl[(k) + 1] = __builtin_amdgcn_s_memrealtime(); } } while (0)
#else
#define SEAM(k) do { if (IN(k) && IN((k) + 1)) xcd_barrier(bar); } while (0)
#endif
#endif
    bf16* H = (bf16*)(ws + WS_A); bf16* OB = (bf16*)(ws + WS_A); bf16* MIX = (bf16*)(ws + WS_B); bf16* ATT = (bf16*)(ws + WS_B);
    bf16* U = (bf16*)(ws + WS_C); bf16* ACT = (bf16*)(ws + WS_C);
    bf16* SLABB = (bf16*)(ws + WS_B); bf16* SLABC = (bf16*)(ws + WS_C);
    const float* MOD0 = (const float*)(ws + WS_MOD); const float* MOD1 = MOD0 + 9 * 6144;
    const f32x2* tabg = (const f32x2*)(ws + WS_TABG); const f32x2* tabm = (const f32x2*)(ws + WS_TABM);
    float* Y = out + OUT_Y;

    PH(0) {
        if (G != 256 || bid < 128) p0_adaln(in, ws, lds, tid, wave, lane, bid, G == 256 ? 128 : G, 0, 128);
        if (bid == G - 1) p0_tables(in, ws, tid);
        if (G == 256) { if (bid >= 128) p0_weights(in, ws, (LAS float*)(lds + 57344 + wave * 8448), (bid - 128) * NWAVES + wave, 128 * NWAVES, lane, 0, P0_ITEMS_L0); }
        else p0_weights(in, ws, (LAS float*)(lds + 57344 + wave * 8448), gw, ngw, lane, 0, P0_ITEMS_L0);
    }
    SEAM(0);
    PH(1) phase_norm_in(in[0], in[1], in[10] + 0 * DM, MOD0, 0, H, row0_of(bid, wave), lane);
    SEAM(1);
    PH(2) run_gemm(lds, H, (const bf16*)(ws + WS_WCIN), T, CIN, 1024, G, bid, EpiConvIn{U, (const float*)(ws + WS_BCIN)});
    PH(2) { if (bid >= 32) p0_weights(in, ws, (LAS float*)(lds + wave * 8448), (bid - 32) * NWAVES + wave, (G - 32) * NWAVES, lane, P0_ITEMS_L0, P0_ITEMS_ALL);
            if (bid >= 128) { __syncthreads(); p0_adaln(in, ws, lds, tid, wave, lane, bid - 128, G - 128, 128, 256); } }
    SEAM(2);
    PH(3) phase_conv(U, MIX, in[13], in[15], in[16], in[17], in[18], lds, tid, wave, lane, G);
    SEAM(3);
    PH(4) run_gemm_split(lds, MIX, (const bf16*)(ws + WS_WCOUT), 1024, bid, EpiStore{OB, DM, in[20], SLABC});
    SEAM(4);
    PH(5) phase_post<true, false, true, true>(OB, SLABC, in[0], in[1], Y, in[11] + 0 * DM, MOD0, 2, in[10] + 1 * DM, MOD0, 3, H, row0_of(bid, wave), slab_off_of(bid), lane);
    SEAM(5);
    PH(6) run_gemm(lds, H, (const bf16*)(ws + WS_WGU0), T, 2 * FFN, 1024, G, bid, EpiSwiGLU{ACT});
    SEAM(6);
    PH(7) run_gemm_split(lds, ACT, (const bf16*)(ws + WS_WD0), FFN, bid, EpiStore{OB, DM, nullptr, SLABB});
    SEAM(7);
    PH(8) phase_post16<true>(OB, SLABB, Y, in[11] + 1 * DM, MOD0, 5, in[10] + 2 * DM, MOD1, 0, H, row0_of(bid, wave), slab_off_of(bid), lane);
    SEAM(8);
    PH(9) run_gemm(lds, H, (const bf16*)(ws + WS_WAIN), T, AINP, 1024, G, bid, EpiAttnIn{(bf16*)(ws + WS_C + C_QC), (bf16*)(ws + WS_C + C_U1)});
    SEAM(9);
    PH(10) phase_attn_rows((const bf16*)(ws + WS_C + C_U1), in[22], in[23], in[24], in[26], tabg, tabm,
                                (bf16*)(ws + WS_C + C_QC), (bf16*)(ws + WS_A + A_KC), (bf16*)(ws + WS_A + A_VTC), (bf16*)(ws + WS_A + A_QA), (bf16*)(ws + WS_A + A_CKV), (bf16*)(ws + WS_A + A_KR),
                                out + OUT_K, out + OUT_V, out + OUT_CKV, out + OUT_KR, in[2], in[3], in[4], in[5], lds, bid, tid, wave, lane);
    SEAM(10);
    PH(11) {
        run_gemm(lds, (const bf16*)(ws + WS_A + A_QA), (const bf16*)(ws + WS_WQB), T, MQD, QL, G, bid, EpiStore{(bf16*)(ws + WS_C + C_MQ), MQD, nullptr, nullptr});
        run_gemm(lds, (const bf16*)(ws + WS_A + A_CKV), (const bf16*)(ws + WS_WKN), TK, 512, KVL, G, (bid + 240) % G, EpiStore{(bf16*)(ws + WS_C + C_KN), 512, nullptr, nullptr});
        run_gemm(lds, (const bf16*)(ws + WS_WVT), (const bf16*)(ws + WS_A + A_CKV), 512, TK, KVL, G, (bid + 160) % G, EpiStore{(bf16*)(ws + WS_C + C_VTM), TK, nullptr, nullptr});
    }
    SEAM(11);
    PH(12) phase_attention(ws, lds, tabg, tabm, in[22], tid, wave, lane, G);
    SEAM(12);
    PH(13) run_gemm(lds, ATT, (const bf16*)(ws + WS_WAOUT), T, 1024, 1024, G, bid, EpiStore{OB, DM, nullptr, nullptr});
    SEAM(13);
    PH(14) phase_post16<false>(OB, nullptr, Y, in[11] + 2 * DM, MOD1, 2, in[10] + 3 * DM, MOD1, 3, H, row0_of(bid, wave), slab_off_of(bid), lane);
    SEAM(14);
    PH(15) run_gemm(lds, H, (const bf16*)(ws + WS_WGU1), T, 2 * FFN, 1024, G, bid, EpiSwiGLU{ACT});
    SEAM(15);
    PH(16) run_gemm_split(lds, ACT, (const bf16*)(ws + WS_WD1), FFN, bid, EpiStore{OB, DM, nullptr, SLABB});
    SEAM(16);
    PH(17) phase_post<false, true, false, true>(OB, SLABB, Y, Y + (size_t)TP * DM, Y, in[11] + 3 * DM, MOD1, 5, nullptr, nullptr, 0, nullptr, row0_of(bid, wave), slab_off_of(bid), lane);
#ifdef PROBE_TS
    xcd_barrier(bar);
    if (bid == 0) {
        if (tid == 0) tsl[18] = __builtin_amdgcn_s_memrealtime();
        __syncthreads();
        const unsigned long long t1 = tsl[PROBE_TS >= 18 ? 18 : PROBE_TS + 1], t0 = tsl[PROBE_TS >= 18 ? 0 : PROBE_TS];
        const float us = (float)(t1 - t0) * 0.01f - PROBE_SUB, eps = sqrtf(us * 1e-4f);
        float* okr = out + OUT_KR;
        for (int i = tid; i < TP * 32; i += NTHR) okr[i] *= (1.f + eps);
    }
#endif
#undef IN
#undef SEAM
}

#ifndef MK_ONE_LAUNCH
#define MK_ONE_LAUNCH 1
#endif
extern "C" void kernel_launch(void* const* d_in, const int* in_sizes, int n_in, void* d_out, int out_size, void* d_ws, size_t ws_size, hipStream_t stream) {
    static int grid = 0;
    if (grid == 0) {
        if (n_in != 32 || ws_size < WS_END) { fprintf(stderr, "kernel_launch: unexpected inputs (n_in %d, ws %zu)\n", n_in, ws_size); grid = -1; return; }
        int dev = 0, cus = 0, per_cu = 0;
        (void)hipGetDevice(&dev); (void)hipDeviceGetAttribute(&cus, hipDeviceAttributeMultiprocessorCount, dev);
        if (hipFuncSetAttribute((const void*)fwd_kernel, hipFuncAttributeMaxDynamicSharedMemorySize, LDS_BYTES) != hipSuccess) { fprintf(stderr, "kernel_launch: hipFuncSetAttribute failed\n"); grid = -1; return; }
        if (hipOccupancyMaxActiveBlocksPerMultiprocessor(&per_cu, (const void*)fwd_kernel, NTHR, LDS_BYTES) != hipSuccess || per_cu < 1) { fprintf(stderr, "kernel_launch: occupancy query says %d\n", per_cu); per_cu = 1; }
        (void)hipGetLastError();
        if (cus != 256) { fprintf(stderr, "kernel_launch: built for a 256-CU device (one workgroup per CU), found %d CUs; nothing launched\n", cus); grid = -1; return; }
        grid = cus;
    }
    if (grid < 0) return;
    Args a{};
    for (int i = 0; i < 32; ++i) a.in[i] = (const float*)d_in[i];
    a.out = (float*)d_out; a.ws = (unsigned char*)d_ws;
#if MK_ONE_LAUNCH && MK_CG_SYNC
    a.ph_lo = 0; a.ph_hi = NPHASE;
    void* kargs[] = {&a};
    hipError_t e = hipLaunchCooperativeKernel((const void*)fwd_kernel, dim3(grid), dim3(NTHR), kargs, LDS_BYTES, stream);
    if (e != hipSuccess) fprintf(stderr, "kernel_launch: cooperative launch failed: %s (grid %d)\n", hipGetErrorString(e), grid);
#elif MK_ONE_LAUNCH
    if (hipMemsetAsync((char*)d_ws + WS_CTL, 0, 16384, stream) != hipSuccess) { fprintf(stderr, "kernel_launch: memset failed\n"); return; }
    a.ph_lo = 0; a.ph_hi = NPHASE;
    hipLaunchKernelGGL(fwd_kernel, dim3(grid), dim3(NTHR), LDS_BYTES, stream, a);
#else
    for (int p = 0; p < NPHASE; ++p) { a.ph_lo = p; a.ph_hi = p + 1; hipLaunchKernelGGL(fwd_kernel, dim3(grid), dim3(NTHR), LDS_BYTES, stream, a); }
#endif
}
```

```cpp
#include <hip/hip_runtime.h>
#include <hip/hip_cooperative_groups.h>
#include <cstdio>
#include <cstdint>
namespace cg = cooperative_groups;
#ifndef MK_CG_SYNC
#define MK_CG_SYNC 0
#endif
namespace pg8 {
#define PG8_LAS __attribute__((address_space(3)))
typedef unsigned short bf16_t;
typedef short bf16x8 __attribute__((ext_vector_type(8)));
typedef float f32x4 __attribute__((ext_vector_type(4)));
typedef unsigned u32x4 __attribute__((ext_vector_type(4)));
constexpr int BM = 256, BK = 64, HALF = 128, HTB = HALF * BK * 2  , STAGE_BYTES = 8 * HTB, NXCD = 8, WGM = 4;

__host__ __device__ __forceinline__ int lds_byte(int r, int c) { const int st = (r >> 4) * 2 + (c >> 5), rr = r & 15, cc = c & 31, ob = rr * 64 + cc * 2; return st * 1024 + (ob ^ (((ob >> 9) & 1) << 5)); }
__host__ __device__ __forceinline__ void stage_rc(int b, int& R, int& C) { const int st = b / 1024, sb = b % 1024, swz = sb ^ (((sb >> 9) & 1) << 5); R = (st >> 1) * 16 + swz / 64; C = (st & 1) * 32 + (swz % 64) / 2; }
__host__ __device__ __forceinline__ int perm32(int rho) { const int n = rho >> 4, i = rho & 15; return 8 * (i >> 2) + 4 * n + (i & 3); }

struct Unit { int pm, pn, koff, nt, part; };
struct Gemm { const bf16_t* A; const bf16_t* Bt; int M, N, K; };

struct StaticOrder {
    int nM, nN, nwg, G, c;
    __host__ __device__ void init(int M, int N, int G_, int c_) { nM = M / BM; nN = N / BM; nwg = nM * nN; G = G_; c = c_; }
    __host__ __device__ bool next(int i, Unit& u) const {
        const long L = (long)i * G + c; if (L >= nwg) return false;
        int wgid = (int)L; { const int q = nwg / NXCD, r = nwg % NXCD, xcd = wgid % NXCD, off = wgid / NXCD; wgid = (xcd < r ? xcd * (q + 1) : r * (q + 1) + (xcd - r) * q) + off; }
        const int nig = WGM * nN, gid = wgid / nig, fm = gid * WGM, gsz = (nM - fm) < WGM ? (nM - fm) : WGM;
        u.pm = fm + ((wgid % nig) % gsz); u.pn = (wgid % nig) / gsz; return true;
    }
    __device__ __forceinline__ void a_ready(const Unit&) const {}
    __device__ __forceinline__ void done(const Unit&) const {}
};

__device__ __forceinline__ unsigned cvt_pk_bf16(float lo, float hi) { unsigned r; asm volatile("v_cvt_pk_bf16_f32 %0, %1, %2" : "=v"(r) : "v"(lo), "v"(hi)); return r; }
template <class Epi, class Sched, bool ALIGN_EPI = false, bool SP2 = false>
__device__ __forceinline__ void gemm_phase(PG8_LAS unsigned char* lds, const Gemm g, const Sched& S, const Epi& E) {
    const int tid = threadIdx.x, wid = __builtin_amdgcn_readfirstlane(tid >> 6), lane = tid & 63, wr = wid >> 2, wc = wid & 3, fr = lane & 15, fq = lane >> 4;
    const int K = g.K;
    unsigned voffA[2], voffB[2];
#pragma unroll
    for (int i = 0; i < 2; ++i) { int R, C; stage_rc(tid * 16 + i * 8192, R, C); const int Rb = Epi::PERM ? ((R & ~31) + perm32(R & 31)) : R;
        voffA[i] = (unsigned)(R * K + C) * 2u; voffB[i] = (unsigned)(Rb * K + C) * 2u; }
    const size_t kstep = (size_t)(BK * 2);
    const size_t hstep = (size_t)HALF * K * 2;
    const size_t tstep = 2 * hstep;
    const unsigned ldsw = (unsigned)wid * 1024u;
    const int aoff = lds_byte(wr * 64 + fr, fq * 8), boff = lds_byte(wc * 32 + fr, fq * 8);
#define PG8_SA(b, h) (((b) * 2 + (h)) * HTB)
#define PG8_SB(b, h) ((4 + (b) * 2 + (h)) * HTB)
#define PG8_STAGE(bufoff, gbase, voff) do { _Pragma("unroll") for (int _i = 0; _i < 2; ++_i) \
        __builtin_amdgcn_global_load_lds((const unsigned*)((const char*)(gbase) + (voff)[_i]), (PG8_LAS unsigned*)(lds + (bufoff) + ldsw + _i * 8192), 16, 0, 0); } while (0)
#define PG8_LDA(dst, b, h) do { _Pragma("unroll") for (int m = 0; m < 4; ++m) _Pragma("unroll") for (int k = 0; k < 2; ++k) dst[m][k] = *(const PG8_LAS bf16x8*)(lds + PG8_SA(b, h) + aoff + m * 2048 + k * 1024); } while (0)
#define PG8_LDB(dst, b, h) do { _Pragma("unroll") for (int n = 0; n < 2; ++n) _Pragma("unroll") for (int k = 0; k < 2; ++k) dst[n][k] = *(const PG8_LAS bf16x8*)(lds + PG8_SB(b, h) + boff + n * 2048 + k * 1024); } while (0)
#define PG8_MMA(ai, bj, At, Bt) do { __builtin_amdgcn_s_setprio(1); _Pragma("unroll") for (int m = 0; m < 4; ++m) _Pragma("unroll") for (int n = 0; n < 2; ++n) _Pragma("unroll") for (int k = 0; k < 2; ++k) \
        acc[ai][bj][m][n] = __builtin_amdgcn_mfma_f32_16x16x32_bf16(Bt[n][k], At[m][k], acc[ai][bj][m][n], 0, 0, 0); __builtin_amdgcn_s_setprio(0); } while (0)
#define PG8_WAIT_V(n) asm volatile("s_waitcnt vmcnt(" #n ")" ::: "memory")
#define PG8_WAIT_L(n) asm volatile("s_waitcnt lgkmcnt(" #n ")" ::: "memory")
#define PG8_BAR __builtin_amdgcn_s_barrier()
#define PG8_SCHED __builtin_amdgcn_sched_barrier(0)
    Unit cur, nxt; int ui = 0;
    if (!S.next(0, cur)) return;
    int nt = cur.nt;
    f32x4 acc[2][2][4][2];
#pragma unroll
    for (int a = 0; a < 2; ++a)
#pragma unroll
        for (int b = 0; b < 2; ++b)
#pragma unroll
            for (int m = 0; m < 4; ++m)
#pragma unroll
                for (int n = 0; n < 2; ++n) acc[a][b][m][n] = (f32x4){0.f, 0.f, 0.f, 0.f};
    bf16x8 At[4][2], B0[2][2], B1[2][2];
    const char* cA = (const char*)g.A + (size_t)cur.pm * tstep + (size_t)cur.koff * 2; const char* cB = (const char*)g.Bt + (size_t)cur.pn * tstep + (size_t)cur.koff * 2;
    S.a_ready(cur);
    if constexpr (SP2) {
        PG8_STAGE(PG8_SB(0, 0), cB, voffB); PG8_STAGE(PG8_SB(0, 1), cB + hstep, voffB); PG8_STAGE(PG8_SA(0, 0), cA, voffA); PG8_STAGE(PG8_SA(0, 1), cA + hstep, voffA);
        if (wr == 1) PG8_BAR;
        PG8_WAIT_V(2); PG8_BAR;
        PG8_STAGE(PG8_SB(1, 0), cB + kstep, voffB); PG8_STAGE(PG8_SA(1, 0), cA + kstep, voffA); PG8_STAGE(PG8_SB(1, 1), cB + hstep + kstep, voffB);
        PG8_WAIT_V(6); PG8_BAR;
    } else {
        PG8_STAGE(PG8_SB(0, 0), cB, voffB); PG8_STAGE(PG8_SA(0, 0), cA, voffA); PG8_STAGE(PG8_SB(0, 1), cB + hstep, voffB); PG8_STAGE(PG8_SA(0, 1), cA + hstep, voffA);
        if (wr == 1) PG8_BAR;
        PG8_WAIT_V(4); PG8_BAR;
        PG8_STAGE(PG8_SB(1, 0), cB + kstep, voffB); PG8_STAGE(PG8_SA(1, 0), cA + kstep, voffA); PG8_STAGE(PG8_SB(1, 1), cB + hstep + kstep, voffB);
        PG8_WAIT_V(6); PG8_BAR;
    }
    for (;;) {
        const bool has_next = S.next(ui + 1, nxt);
        const char* nA = has_next ? (const char*)g.A + (size_t)nxt.pm * tstep + (size_t)nxt.koff * 2 : cA; const char* nB = has_next ? (const char*)g.Bt + (size_t)nxt.pn * tstep + (size_t)nxt.koff * 2 : cB;
        for (int t = 0; t < nt; t += 2) {
            const bool last = (t == nt - 2);
            const char* a1 = cA + (size_t)(t + 1) * kstep;
            const char* a2 = last ? nA : cA + (size_t)(t + 2) * kstep; const char* b2 = last ? nB : cB + (size_t)(t + 2) * kstep;
            const char* a3 = a2 + kstep; const char* b3 = b2 + kstep;
            if (last && has_next) S.a_ready(nxt);
            if constexpr (SP2) {
            PG8_LDB(B0, 0, 0); PG8_LDB(B1, 0, 1); PG8_SCHED; PG8_LDA(At, 0, 0); PG8_STAGE(PG8_SA(1, 1), a1 + hstep, voffA);
            PG8_WAIT_V(8); PG8_WAIT_L(0); PG8_BAR; PG8_MMA(0, 0, At, B0); PG8_MMA(0, 1, At, B1); PG8_BAR; PG8_SCHED;
            PG8_LDA(At, 0, 1); PG8_STAGE(PG8_SB(0, 0), b2, voffB); PG8_STAGE(PG8_SB(0, 1), b2 + hstep, voffB); PG8_STAGE(PG8_SA(0, 0), a2, voffA);
            PG8_WAIT_V(8); PG8_WAIT_L(0); PG8_BAR; PG8_MMA(1, 0, At, B0); PG8_MMA(1, 1, At, B1); PG8_BAR; PG8_SCHED;
            PG8_LDB(B0, 1, 0); PG8_LDB(B1, 1, 1); PG8_SCHED; PG8_LDA(At, 1, 0); PG8_STAGE(PG8_SA(0, 1), a2 + hstep, voffA);
            PG8_WAIT_V(8); PG8_WAIT_L(0); PG8_BAR; PG8_MMA(0, 0, At, B0); PG8_MMA(0, 1, At, B1); PG8_BAR; PG8_SCHED;
            PG8_LDA(At, 1, 1); PG8_STAGE(PG8_SB(1, 0), b3, voffB); PG8_STAGE(PG8_SB(1, 1), b3 + hstep, voffB); PG8_STAGE(PG8_SA(1, 0), a3, voffA);
            PG8_WAIT_V(8); PG8_WAIT_L(0); PG8_BAR; PG8_MMA(1, 0, At, B0); PG8_MMA(1, 1, At, B1); PG8_BAR; PG8_SCHED;
            } else {
            PG8_LDB(B0, 0, 0); PG8_SCHED; PG8_LDA(At, 0, 0); PG8_STAGE(PG8_SA(1, 1), a1 + hstep, voffA);
            PG8_WAIT_L(8); PG8_BAR; PG8_WAIT_L(0); PG8_MMA(0, 0, At, B0); PG8_BAR; PG8_SCHED;
            PG8_LDB(B1, 0, 1); PG8_STAGE(PG8_SB(0, 0), b2, voffB);
            PG8_BAR; PG8_WAIT_L(0); PG8_MMA(0, 1, At, B1); PG8_BAR;
            PG8_LDA(At, 0, 1); PG8_STAGE(PG8_SA(0, 0), a2, voffA);
            PG8_BAR; PG8_WAIT_L(0); PG8_MMA(1, 0, At, B0); PG8_BAR; PG8_SCHED;
            PG8_STAGE(PG8_SB(0, 1), b2 + hstep, voffB);
            PG8_WAIT_V(6); PG8_BAR; PG8_MMA(1, 1, At, B1); PG8_BAR;
            PG8_LDB(B0, 1, 0); PG8_SCHED; PG8_LDA(At, 1, 0); PG8_STAGE(PG8_SA(0, 1), a2 + hstep, voffA);
            PG8_WAIT_L(8); PG8_BAR; PG8_WAIT_L(0); PG8_MMA(0, 0, At, B0); PG8_BAR; PG8_SCHED;
            PG8_LDB(B1, 1, 1); PG8_STAGE(PG8_SB(1, 0), b3, voffB);
            PG8_BAR; PG8_WAIT_L(0); PG8_MMA(0, 1, At, B1); PG8_BAR;
            PG8_LDA(At, 1, 1); PG8_STAGE(PG8_SA(1, 0), a3, voffA);
            PG8_BAR; PG8_WAIT_L(0); PG8_MMA(1, 0, At, B0); PG8_BAR; PG8_SCHED;
            PG8_STAGE(PG8_SB(1, 1), b3 + hstep, voffB);
            PG8_WAIT_V(6); PG8_BAR; PG8_MMA(1, 1, At, B1); PG8_BAR;
            }
        }
        if constexpr (ALIGN_EPI) { if (wr == 0) PG8_BAR; }
        if constexpr (!Epi::AFTER_DRAIN) { E(acc, cur, wr, wc, fr, fq); S.done(cur); }
        if (!has_next) break;
#pragma unroll
        for (int a = 0; a < 2; ++a)
#pragma unroll
            for (int b = 0; b < 2; ++b)
#pragma unroll
                for (int m = 0; m < 4; ++m)
#pragma unroll
                    for (int n = 0; n < 2; ++n) acc[a][b][m][n] = (f32x4){0.f, 0.f, 0.f, 0.f};
        cur = nxt; cA = nA; cB = nB; nt = cur.nt; ++ui;
        if constexpr (ALIGN_EPI) { if (wr == 1) PG8_BAR; }
    }
    PG8_WAIT_V(0);
    if constexpr (!ALIGN_EPI) { if (wr == 0) PG8_BAR; }
    PG8_BAR;
    if constexpr (Epi::AFTER_DRAIN) { E.fused(acc, cur, wr, wc, fr, fq, lds, wid, lane); S.done(cur); }
#undef PG8_SA
#undef PG8_SB
#undef PG8_STAGE
#undef PG8_LDA
#undef PG8_LDB
#undef PG8_MMA
#undef PG8_WAIT_V
#undef PG8_WAIT_L
#undef PG8_BAR
#undef PG8_SCHED
}
}

#define LAS __attribute__((address_space(3)))
typedef unsigned short bf16;
typedef float f32x4 __attribute__((ext_vector_type(4)));
typedef float f32x2 __attribute__((ext_vector_type(2)));
typedef float f32x16 __attribute__((ext_vector_type(16)));
typedef short bf16x8 __attribute__((ext_vector_type(8)));
typedef unsigned u32x4 __attribute__((ext_vector_type(4)));
typedef unsigned u32x2 __attribute__((ext_vector_type(2)));

constexpr int DM = 1024, TP = 4096, TS = 16384, T = TP + TS, SEQS = 2048, NBS = 8, PAST = 256;
constexpr int KSEQ = PAST + SEQS;
constexpr int TK = TP + NBS * KSEQ;
constexpr int FFN = 2816, CIN = 2560, CU2 = 1536, AIN = 1440, AINP = 1536, QL = 384, KVL = 256, MQD = 768;
constexpr float EPS = 1e-6f;
constexpr int NWAVES = 8, NTHR = 512;
constexpr int LDS_BYTES = 147456;
constexpr int SPLIT_ROW0 = 16384;
constexpr size_t SLAB_ELEMS = (size_t)(T - SPLIT_ROW0) * DM;

constexpr size_t MiB = (size_t)1 << 20;
constexpr size_t al256(size_t x) { return (x + 255) & ~(size_t)255; }
constexpr size_t WS_CTL = 0;
constexpr size_t WS_MOD = 1 * MiB;
constexpr size_t WS_TABG = WS_MOD + al256((size_t)2 * 9 * 6144 * 4);
constexpr size_t WS_TABM = WS_TABG + al256(64 * 16 * 8);
constexpr size_t WS_BCIN = WS_TABM + al256(64 * 8 * 8);
constexpr size_t WS_WCIN = 2 * MiB;
constexpr size_t WS_WCOUT = WS_WCIN + (size_t)2560 * 1024 * 2;
constexpr size_t WS_WGU0 = WS_WCOUT + (size_t)1024 * 1024 * 2;
constexpr size_t WS_WD0 = WS_WGU0 + (size_t)5632 * 1024 * 2;
constexpr size_t WS_WGU1 = WS_WD0 + (size_t)1024 * 2816 * 2;
constexpr size_t WS_WD1 = WS_WGU1 + (size_t)5632 * 1024 * 2;
constexpr size_t WS_WAIN = WS_WD1 + (size_t)1024 * 2816 * 2;
constexpr size_t WS_WQB = WS_WAIN + (size_t)1536 * 1024 * 2;
constexpr size_t WS_WKN = WS_WQB + (size_t)768 * 384 * 2;
constexpr size_t WS_WVT = WS_WKN + (size_t)512 * 256 * 2;
constexpr size_t WS_WAOUT = WS_WVT + (size_t)512 * 256 * 2;
constexpr size_t WS_WEND = WS_WAOUT + (size_t)1024 * 1024 * 2;
constexpr size_t WS_A = 50 * MiB;
constexpr size_t WS_B = 90 * MiB;
constexpr size_t WS_C = 130 * MiB;
constexpr size_t WS_END = 240 * MiB;
static_assert(WS_BCIN + 2560 * 4 <= WS_WCIN && WS_WEND <= WS_A, "ws map");
constexpr size_t A_QA = 0;
constexpr size_t A_CKV = A_QA + (size_t)T * QL * 2;
constexpr size_t A_KR = A_CKV + (size_t)TK * KVL * 2;
constexpr size_t A_KC = A_KR + (size_t)TK * 32 * 2;
constexpr size_t A_VTC = A_KC + (size_t)TK * 128 * 2;
static_assert(A_VTC + (size_t)128 * TK * 2 <= 40 * MiB, "region A");
constexpr int U1W = AINP - 512;
constexpr size_t C_U1 = 0;
constexpr size_t C_QC = (size_t)T * U1W * 2;
constexpr size_t C_VTM = C_QC + (size_t)T * 512 * 2;
constexpr size_t C_MQ = 0;
constexpr size_t C_KN = C_VTM + (size_t)512 * TK * 2;
static_assert((size_t)T * MQD * 2 <= C_QC && C_KN + (size_t)TK * 512 * 2 <= 110 * MiB, "region C");
constexpr size_t OUT_Y = 0, OUT_K = (size_t)T * DM, OUT_V = OUT_K + (size_t)TP * 128, OUT_CKV = OUT_V + (size_t)TP * 128, OUT_KR = OUT_CKV + (size_t)TP * 256;

typedef __bf16 bf16x2_t __attribute__((ext_vector_type(2)));
__device__ __forceinline__ unsigned pk2(float lo, float hi) { bf16x2_t v = {(__bf16)lo, (__bf16)hi}; return __builtin_bit_cast(unsigned, v); }
__device__ __forceinline__ bf16 f2bf(float x) { return (bf16)(pk2(x, 0.f) & 0xffffu); }
__device__ __forceinline__ float bf2f(bf16 b) { return __uint_as_float((unsigned)b << 16); }
__device__ __forceinline__ float bflo(unsigned w) { return __uint_as_float(w << 16); }
__device__ __forceinline__ float bfhi(unsigned w) { return __uint_as_float(w & 0xffff0000u); }
__device__ __forceinline__ float wave_sum(float v) {
#pragma unroll
    for (int o = 1; o < 64; o <<= 1) v += __shfl_xor(v, o);
    return v;
}
__device__ __forceinline__ float fsigmoid(float x) { return __builtin_amdgcn_rcpf(1.f + __builtin_amdgcn_exp2f(-1.4426950408889634f * x)); }
__device__ __forceinline__ float fsilu(float x) { return x * fsigmoid(x); }
__device__ __forceinline__ const float* xrow_in(const float* xp, const float* xs, int r) { return r < TP ? xp + (size_t)r * DM : xs + (size_t)(r - TP) * DM; }
__device__ __forceinline__ int cond_of(int r) { return r < TP ? 0 : 1 + ((r - TP) >> 11); }
__device__ __forceinline__ void unpack8(u32x4 w, float (&v)[8]) {
    v[0] = bflo(w.x); v[1] = bfhi(w.x); v[2] = bflo(w.y); v[3] = bfhi(w.y); v[4] = bflo(w.z); v[5] = bfhi(w.z); v[6] = bflo(w.w); v[7] = bfhi(w.w);
}
__device__ __forceinline__ u32x4 pack8(const float (&v)[8]) { u32x4 w; w.x = pk2(v[0], v[1]); w.y = pk2(v[2], v[3]); w.z = pk2(v[4], v[5]); w.w = pk2(v[6], v[7]); return w; }

struct EpiAttnIn {
    static constexpr bool PERM = true, AFTER_DRAIN = false;
    bf16* Q; bf16* U;
    __device__ __forceinline__ void operator()(const f32x4 (&acc)[2][2][4][2], const pg8::Unit& u, int wr, int wc, int fr, int fq) const {
        const bool isq = u.pn < 2; const int ldc = isq ? 512 : U1W;
        const int row0 = u.pm * 256 + wr * 64 + fr, col0 = (isq ? u.pn : u.pn - 2) * 256 + wc * 32 + 8 * fq;
        bf16* base = isq ? Q : U;
#pragma unroll
        for (int ai = 0; ai < 2; ++ai)
#pragma unroll
            for (int m = 0; m < 4; ++m) { bf16* rowp = base + (size_t)(row0 + ai * 128 + m * 16) * ldc + col0;
#pragma unroll
                for (int bj = 0; bj < 2; ++bj) { const f32x4 v0 = acc[ai][bj][m][0], v1 = acc[ai][bj][m][1];
                    u32x4 w; w.x = pk2(v0[0], v0[1]); w.y = pk2(v0[2], v0[3]); w.z = pk2(v1[0], v1[1]); w.w = pk2(v1[2], v1[3]);
                    *(u32x4*)(rowp + bj * 128) = w; } }
    }
};
struct EpiStore {
    static constexpr bool PERM = true, AFTER_DRAIN = false;
    bf16* O; int ldc; const float* bias; bf16* slab;
    __device__ __forceinline__ void operator()(const f32x4 (&acc)[2][2][4][2], const pg8::Unit& u, int wr, int wc, int fr, int fq) const {
        const int row0 = u.pm * 256 + wr * 64 + fr, col0 = u.pn * 256 + wc * 32 + 8 * fq;
        bf16* base = u.part == 0 ? O : slab + (size_t)(u.part - 1) * SLAB_ELEMS - (size_t)(2048 + 2048 * (u.pm / 10)) * DM;
        const bool hb = bias != nullptr && u.part == 0;
        f32x4 bv[2][2];
#pragma unroll
        for (int bj = 0; bj < 2; ++bj)
#pragma unroll
            for (int n = 0; n < 2; ++n) bv[bj][n] = hb ? *(const f32x4*)(bias + col0 + bj * 128 + 4 * n) : (f32x4){0.f, 0.f, 0.f, 0.f};
#pragma unroll
        for (int ai = 0; ai < 2; ++ai)
#pragma unroll
            for (int m = 0; m < 4; ++m) { bf16* rowp = base + (size_t)(row0 + ai * 128 + m * 16) * ldc + col0;
#pragma unroll
                for (int bj = 0; bj < 2; ++bj) { const f32x4 v0 = acc[ai][bj][m][0] + bv[bj][0], v1 = acc[ai][bj][m][1] + bv[bj][1];
                    u32x4 w; w.x = pk2(v0[0], v0[1]); w.y = pk2(v0[2], v0[3]); w.z = pk2(v1[0], v1[1]); w.w = pk2(v1[2], v1[3]);
                    *(u32x4*)(rowp + bj * 128) = w; } }
    }
};
struct EpiConvIn {
    static constexpr bool PERM = true, AFTER_DRAIN = false;
    bf16* O; const float* bias;
    __device__ __forceinline__ void operator()(const f32x4 (&acc)[2][2][4][2], const pg8::Unit& u, int wr, int wc, int fr, int fq) const {
        const int row0 = u.pm * 256 + wr * 64 + fr, cin = u.pn * 256 + wc * 32 + 8 * fq;
        if (u.pn < 2) {
#pragma unroll
            for (int ai = 0; ai < 2; ++ai)
#pragma unroll
                for (int m = 0; m < 4; ++m) { bf16* rowp = O + (size_t)(row0 + ai * 128 + m * 16) * CU2 + cin;
#pragma unroll
                    for (int bj = 0; bj < 2; ++bj) { const f32x4 v0 = acc[ai][bj][m][0], v1 = acc[ai][bj][m][1];
                        u32x4 w; w.x = pk2(v0[0], v0[1]); w.y = pk2(v0[2], v0[3]); w.z = pk2(v1[0], v1[1]); w.w = pk2(v1[2], v1[3]);
                        *(u32x4*)(rowp + bj * 128) = w; } }
        } else {
            const bool glu = u.pn >= 6; const int col0 = 512 + (u.pn - 2) * 128 + wc * 32 + 8 * fq;
            f32x4 ba[2], bg[2];
#pragma unroll
            for (int n = 0; n < 2; ++n) { ba[n] = glu ? *(const f32x4*)(bias + cin + 4 * n) : (f32x4){0.f, 0.f, 0.f, 0.f}; bg[n] = glu ? *(const f32x4*)(bias + cin + 128 + 4 * n) : (f32x4){0.f, 0.f, 0.f, 0.f}; }
#pragma unroll
            for (int ai = 0; ai < 2; ++ai)
#pragma unroll
                for (int m = 0; m < 4; ++m) { bf16* rowp = O + (size_t)(row0 + ai * 128 + m * 16) * CU2 + col0;
                    f32x4 o[2];
#pragma unroll
                    for (int n = 0; n < 2; ++n) { const f32x4 a = acc[ai][0][m][n] + ba[n], g = acc[ai][1][m][n] + bg[n];
                        o[n] = glu ? (f32x4){a[0] * fsigmoid(g[0]), a[1] * fsigmoid(g[1]), a[2] * fsigmoid(g[2]), a[3] * fsigmoid(g[3])} : a * g; }
                    u32x4 w; w.x = pk2(o[0][0], o[0][1]); w.y = pk2(o[0][2], o[0][3]); w.z = pk2(o[1][0], o[1][1]); w.w = pk2(o[1][2], o[1][3]);
                    *(u32x4*)rowp = w; }
        }
    }
};
struct EpiSwiGLU {
    static constexpr bool PERM = true, AFTER_DRAIN = false;
    bf16* O;
    __device__ __forceinline__ void operator()(const f32x4 (&acc)[2][2][4][2], const pg8::Unit& u, int wr, int wc, int fr, int fq) const {
        const int row0 = u.pm * 256 + wr * 64 + fr, col0 = u.pn * 128 + wc * 32 + 8 * fq;
#pragma unroll
        for (int ai = 0; ai < 2; ++ai)
#pragma unroll
            for (int m = 0; m < 4; ++m) { bf16* rowp = O + (size_t)(row0 + ai * 128 + m * 16) * FFN + col0;
                const f32x4 g0 = acc[ai][0][m][0], g1 = acc[ai][0][m][1], u0 = acc[ai][1][m][0], u1 = acc[ai][1][m][1];
                u32x4 w; w.x = pk2(fsilu(g0[0]) * u0[0], fsilu(g0[1]) * u0[1]); w.y = pk2(fsilu(g0[2]) * u0[2], fsilu(g0[3]) * u0[3]);
                w.z = pk2(fsilu(g1[0]) * u1[0], fsilu(g1[1]) * u1[1]); w.w = pk2(fsilu(g1[2]) * u1[2], fsilu(g1[3]) * u1[3]);
                *(u32x4*)rowp = w; }
    }
};
__device__ __forceinline__ int cin_src_col(int n) {
    if (n < 512) return n;
    const int q = n - 512, grp = q >> 10, t4 = (q >> 8) & 3, w = q & 255;
    return 512 + grp * 1024 + (w >> 7) * 512 + 128 * t4 + (w & 127);
}
struct TrItem { const float* src; int ldw; bf16* WT; int K, k0, drow0; };
__device__ __forceinline__ void tr_load(const TrItem& t, float (&tv)[32], int lane) {
#pragma unroll
    for (int i = 0; i < 32; ++i) { const int kk = 2 * i + (lane >> 5); tv[i] = t.src ? t.src[(size_t)(t.k0 + kk) * t.ldw] : 0.f; }
}
__device__ __forceinline__ void tr_store(const TrItem& t, const float (&tv)[32], LAS float* scr, int lane) {
#pragma unroll
    for (int i = 0; i < 32; ++i) { const int kk = 2 * i + (lane >> 5); scr[kk * 33 + (lane & 31)] = tv[i]; }
    asm volatile("s_waitcnt lgkmcnt(0)" ::: "memory");
    const int c = lane & 7;
#pragma unroll
    for (int j = 0; j < 4; ++j) { const int n = (lane >> 3) + 8 * j; const LAS float* s = scr + (8 * c) * 33 + n;
        u32x4 o; o.x = pk2(s[0 * 33], s[1 * 33]); o.y = pk2(s[2 * 33], s[3 * 33]); o.z = pk2(s[4 * 33], s[5 * 33]); o.w = pk2(s[6 * 33], s[7 * 33]);
        *(u32x4*)(t.WT + (size_t)(t.drow0 + n) * t.K + t.k0 + 8 * c) = o; }
    asm volatile("s_waitcnt lgkmcnt(0)" ::: "memory");
}
constexpr int P0_ITEMS_L0 = 16 * 80 + 16 * 32 + 16 * 176 + 44 * 32, P0_ITEMS_ALL = P0_ITEMS_L0 + 16 * 176 + 44 * 32 + 16 * 48 + 6 * 24 + 2 * 4 * 16 + 16 * 32;
__device__ __forceinline__ TrItem p0_decode(const float* const* in, unsigned char* ws, int it, int ln) {
    constexpr int I_CIN = 16 * 80, I_COUT = 16 * 32, I_GU = 16 * 176, I_D = 44 * 32, I_AIN = 16 * 48, I_QB = 6 * 24, I_KN = 4 * 16, I_AOUT = 16 * 32;
    constexpr int NITEMS = I_CIN + I_COUT + 2 * I_GU + 2 * I_D + I_AIN + I_QB + 2 * I_KN + I_AOUT;
    static_assert(NITEMS == P0_ITEMS_ALL, "item count");

        int r = it;
        if (r < I_CIN) { const int nblk = 80, kb = r / nblk, nb = r % nblk, n = 32 * nb + ln;
            return TrItem{in[12] + cin_src_col(n), CIN, (bf16*)(ws + WS_WCIN), 1024, 64 * kb, 32 * nb}; } r -= I_CIN;
        if (r < I_COUT) { const int nblk = 32, kb = r / nblk, nb = r % nblk, n = 32 * nb + ln;
            return TrItem{in[19] + n, 1024, (bf16*)(ws + WS_WCOUT), 1024, 64 * kb, 32 * nb}; } r -= I_COUT;
        if (r < 2 * (I_GU + I_D)) { const int l = r >= (I_GU + I_D) ? 1 : 0; r -= l * (I_GU + I_D);
            if (r < I_GU) { const int nblk = 176, kb = r / nblk, nb = r % nblk, n = 32 * nb + ln, t = n >> 8, w = n & 255;
                const float* src = (w < 128 ? in[29] : in[30]) + (size_t)l * 1024 * FFN + 128 * t + (w & 127);
                return TrItem{src, FFN, (bf16*)(ws + (l ? WS_WGU1 : WS_WGU0)), 1024, 64 * kb, 32 * nb}; }
            else { r -= I_GU; const int nblk = 32, kb = r / nblk, nb = r % nblk, n = 32 * nb + ln;
                return TrItem{in[31] + (size_t)l * FFN * 1024 + n, 1024, (bf16*)(ws + (l ? WS_WD1 : WS_WD0)), FFN, 64 * kb, 32 * nb}; }
            } r -= 2 * (I_GU + I_D);
        if (r < I_AIN) { const int nblk = 48, kb = r / nblk, nb = r % nblk, n = 32 * nb + ln;
            return TrItem{n < AIN ? in[21] + n : nullptr, AIN, (bf16*)(ws + WS_WAIN), 1024, 64 * kb, 32 * nb}; } r -= I_AIN;
        if (r < I_QB) { const int nblk = 24, kb = r / nblk, nb = r % nblk, n = 32 * nb + ln, hh = n / 96, w = n % 96;
            int sc = n; if (w >= 64) { const int e = w - 64, blk = e >> 4, loc = e & 15; sc = hh * 96 + 64 + 16 * blk + 8 * (loc & 1) + (loc >> 1); }
            return TrItem{in[25] + sc, MQD, (bf16*)(ws + WS_WQB), QL, 64 * kb, 32 * nb}; } r -= I_QB;
        if (r < I_KN) { const int nblk = 16, kb = r / nblk, nb = r % nblk, n = 32 * nb + ln;
            return TrItem{in[27] + (n >> 6) * 128 + (n & 63), 1024, (bf16*)(ws + WS_WKN), KVL, 64 * kb, 32 * nb}; } r -= I_KN;
        if (r < I_KN) { const int nblk = 16, kb = r / nblk, nb = r % nblk, n = 32 * nb + ln;
            return TrItem{in[27] + (n >> 6) * 128 + 64 + (n & 63), 1024, (bf16*)(ws + WS_WVT), KVL, 64 * kb, 32 * nb}; } r -= I_KN;
        { const int nblk = 32, kb = r / nblk, nb = r % nblk, n = 32 * nb + ln;
            return TrItem{in[28] + n, 1024, (bf16*)(ws + WS_WAOUT), 1024, 64 * kb, 32 * nb}; }
}
__device__ __forceinline__ void p0_weights(const float* const* in, unsigned char* ws, LAS float* scr, int gw, int ngw, int lane, int item_lo, int item_hi) {
    const int ln = lane & 31;
    int it = item_lo + gw;
    if (it >= item_hi) return;
    TrItem a = p0_decode(in, ws, it, ln); float ta[32], tb[32];
    tr_load(a, ta, lane);
    for (;;) {
        const int nx = it + ngw; const bool more = nx < item_hi;
        TrItem b = a;
        if (more) { b = p0_decode(in, ws, nx, ln); tr_load(b, tb, lane); }
        tr_store(a, ta, scr, lane);
        if (!more) break;
        a = b; it = nx;
#pragma unroll
        for (int i = 0; i < 32; ++i) ta[i] = tb[i];
    }
}
__device__ __forceinline__ void p0_adaln(const float* const* in, unsigned char* ws, LAS unsigned char* lds, int tid, int wave, int lane, int b0, int nb, int item_lo, int item_hi) {
    LAS float* sS = (LAS float*)lds;
    LAS float* red = (LAS float*)(lds + 1024 * 12 * 4);
    float* MOD = (float*)(ws + WS_MOD);
    {   float xv[18];
#pragma unroll
        for (int q = 0; q < 18; ++q) { const int i = tid + NTHR * q, cnd = i >> 10, k = i & 1023; xv[q] = cnd == 0 ? in[7][k] : in[6][(cnd - 1) * 1024 + k]; }
#pragma unroll
        for (int q = 0; q < 18; ++q) { const int i = tid + NTHR * q, cnd = i >> 10, k = i & 1023; sS[k * 12 + cnd] = fsilu(xv[q]); } }
    __syncthreads();
    const int la = lane < 48 ? lane : 47, g = la / 12, cq = la - 12 * g;
    const int krow0 = 128 * wave + 32 * g;
    for (int it = item_lo + b0; it < item_hi; it += nb) {
        const int l = it >> 7, n0 = 48 * (it & 127);
        const float* wp = in[8] + (size_t)l * 1024 * 6144 + n0 + 4 * cq + (size_t)krow0 * 6144;
        f32x4 acc[9];
#pragma unroll
        for (int c = 0; c < 9; ++c) acc[c] = (f32x4){0.f, 0.f, 0.f, 0.f};
#pragma unroll 1
        for (int kk = 0; kk < 32; kk += 16) {
            f32x4 wv[16];
#pragma unroll
            for (int q = 0; q < 16; ++q) wv[q] = *(const f32x4*)(wp + (size_t)(kk + q) * 6144);
#pragma unroll
            for (int q = 0; q < 16; ++q) { const LAS f32x4* s4 = (const LAS f32x4*)(sS + (krow0 + kk + q) * 12); const f32x4 s0 = s4[0], s1 = s4[1], s2 = s4[2];
                acc[0] += s0.x * wv[q]; acc[1] += s0.y * wv[q]; acc[2] += s0.z * wv[q]; acc[3] += s0.w * wv[q];
                acc[4] += s1.x * wv[q]; acc[5] += s1.y * wv[q]; acc[6] += s1.z * wv[q]; acc[7] += s1.w * wv[q]; acc[8] += s2.x * wv[q]; }
        }
        if (lane < 48) {
#pragma unroll
            for (int c = 0; c < 9; ++c) *(LAS f32x4*)(red + ((wave * 4 + g) * 9 + c) * 48 + 4 * cq) = acc[c]; }
        __syncthreads();
        if (tid < 432) { const int c = tid / 48, col = tid - 48 * c; float sum = in[9][l * 6144 + n0 + col];
#pragma unroll
            for (int pp = 0; pp < 32; ++pp) sum += red[(pp * 9 + c) * 48 + col];
            MOD[(size_t)(l * 9 + c) * 6144 + n0 + col] = sum; }
        __syncthreads();
    }
}
__device__ __forceinline__ void p0_tables(const float* const* in, unsigned char* ws, int tid) {
    f32x2* tabg = (f32x2*)(ws + WS_TABG); f32x2* tabm = (f32x2*)(ws + WS_TABM); float* bcin = (float*)(ws + WS_BCIN);
    for (int i = tid; i < 64 * 16; i += NTHR) { const int pos = i >> 4, f = i & 15; const float inv = exp2f(-(float)f * (13.287712379549449f / 16.f)), a = (float)pos * inv; tabg[i] = (f32x2){__cosf(a), __sinf(a)}; }
    for (int i = tid; i < 64 * 8; i += NTHR) { const int pos = i >> 3, f = i & 7; const float inv = exp2f(-(float)f * (13.287712379549449f / 8.f)), a = (float)pos * inv; tabm[i] = (f32x2){__cosf(a), __sinf(a)}; }
    static_assert(CIN == 5 * NTHR, "bias permutation loop");
    {   float bv_[5];
#pragma unroll
        for (int q = 0; q < 5; ++q) { const int sc = cin_src_col(tid + NTHR * q); bv_[q] = sc < 1536 ? 0.f : in[14][sc - 1536]; }
#pragma unroll
        for (int q = 0; q < 5; ++q) bcin[tid + NTHR * q] = bv_[q]; }
}

constexpr int NIT = T / (256 * NWAVES);
static_assert(NIT * 256 * NWAVES == T && NIT == 10, "row phases assume a 256-workgroup grid");
__device__ __forceinline__ int row0_of(int bid, int wave) { return 2560 * (bid & 7) + 8 * (bid >> 3) + wave; }
__device__ __forceinline__ int slab_off_of(int bid) { return 2048 + 2048 * (bid & 7); }
__device__ __forceinline__ f32x4 bf4(u32x2 w) { return (f32x4){bflo(w.x), bfhi(w.x), bflo(w.y), bfhi(w.y)}; }
__device__ __forceinline__ float sq4(f32x4 v) { return (v.x * v.x + v.y * v.y) + (v.z * v.z + v.w * v.w); }
__device__ __forceinline__ void phase_norm_in(const float* xp, const float* xs, const float* gpre, const float* modl, int sidx, bf16* H, int gw, int lane) {
    f32x4 g[4];
#pragma unroll
    for (int j = 0; j < 4; ++j) g[j] = ((const f32x4*)gpre + lane)[64 * j];
    f32x4 cur[4], nxt[4];
    { const f32x4* x4 = (const f32x4*)xrow_in(xp, xs, gw) + lane;
#pragma unroll
      for (int j = 0; j < 4; ++j) cur[j] = x4[64 * j]; }
    f32x4 sh[4], sc[4]; int pcnd = -1;
#pragma unroll
    for (int i = 0; i < NIT; ++i) {
        const int r = gw + 256 * i, cnd = cond_of(r);
        if (cnd != pcnd) {
            pcnd = cnd; const float* mb = modl + (size_t)cnd * 6144;
#pragma unroll
            for (int j = 0; j < 4; ++j) { sh[j] = ((const f32x4*)(mb + sidx * DM) + lane)[64 * j]; sc[j] = ((const f32x4*)(mb + (sidx + 1) * DM) + lane)[64 * j]; }
        }
        if (i + 1 < NIT) { const f32x4* x4 = (const f32x4*)xrow_in(xp, xs, r + 256) + lane;
#pragma unroll
            for (int j = 0; j < 4; ++j) nxt[j] = x4[64 * j]; }
        float ss = 0.f;
#pragma unroll
        for (int j = 0; j < 4; ++j) ss += sq4(cur[j]);
        const float rstd = rsqrtf(wave_sum(ss) * (1.f / DM) + EPS);
        u32x2* h2 = (u32x2*)(H + (size_t)r * DM) + lane;
#pragma unroll
        for (int j = 0; j < 4; ++j) { const f32x4 o = cur[j] * rstd * g[j] * (1.f + sc[j]) + sh[j]; h2[64 * j] = (u32x2){pk2(o.x, o.y), pk2(o.z, o.w)}; }
#pragma unroll
        for (int j = 0; j < 4; ++j) cur[j] = nxt[j];
    }
}
template <bool NEXT, bool XIN16, bool XOUT16, bool SLAB>
__device__ __forceinline__ void phase_post(const bf16* O, const bf16* slab, const float* xp, const float* xs, float* Y, const float* gpost, const float* modl, int gidx,
                                           const float* gpre_n, const float* modn, int sidx_n, bf16* H, int gw, int slab_off, int lane) {
    f32x4 gp[4], gn[4];
#pragma unroll
    for (int j = 0; j < 4; ++j) { gp[j] = ((const f32x4*)gpost + lane)[64 * j]; if (NEXT) gn[j] = ((const f32x4*)gpre_n + lane)[64 * j]; }
    u32x2 co[4], no[4], cxb[4], nxb[4], cs[3][4], ns[3][4]; f32x4 cxf[4], nxf[4];
#define POST_LOAD(rr, it, po, pxb, pxf, ps) do { \
        const u32x2* o2_ = (const u32x2*)(O + (size_t)(rr) * DM) + lane; \
        _Pragma("unroll") for (int j = 0; j < 4; ++j) po[j] = o2_[64 * j]; \
        if (XIN16) { const u32x2* b2_ = (const u32x2*)(Y + (size_t)(rr) * DM) + lane; _Pragma("unroll") for (int j = 0; j < 4; ++j) pxb[j] = b2_[64 * j]; } \
        else { const f32x4* x4_ = (const f32x4*)xrow_in(xp, xs, (rr)) + lane; _Pragma("unroll") for (int j = 0; j < 4; ++j) pxf[j] = x4_[64 * j]; } \
        if (SLAB && (it) >= 8) { _Pragma("unroll") for (int p = 0; p < 3; ++p) { const u32x2* s2_ = (const u32x2*)(slab + (size_t)p * SLAB_ELEMS + (size_t)((rr) - slab_off) * DM) + lane; \
            _Pragma("unroll") for (int j = 0; j < 4; ++j) ps[p][j] = s2_[64 * j]; } } } while (0)
    POST_LOAD(gw, 0, co, cxb, cxf, cs);
    f32x4 gt[4], sh[4], sc[4]; int pcnd = -1;
#pragma unroll
    for (int i = 0; i < NIT; ++i) {
        const int r = gw + 256 * i, cnd = cond_of(r);
        if (cnd != pcnd) {
            pcnd = cnd;
#pragma unroll
            for (int j = 0; j < 4; ++j) { gt[j] = ((const f32x4*)(modl + (size_t)cnd * 6144 + gidx * DM) + lane)[64 * j];
                if (NEXT) { sh[j] = ((const f32x4*)(modn + (size_t)cnd * 6144 + sidx_n * DM) + lane)[64 * j]; sc[j] = ((const f32x4*)(modn + (size_t)cnd * 6144 + (sidx_n + 1) * DM) + lane)[64 * j]; } }
        }
        if (i + 1 < NIT) POST_LOAD(r + 256, i + 1, no, nxb, nxf, ns);
        f32x4 o[4], x[4]; float ss = 0.f;
#pragma unroll
        for (int j = 0; j < 4; ++j) { o[j] = bf4(co[j]); x[j] = XIN16 ? bf4(cxb[j]) : cxf[j]; }
        if (SLAB && i >= 8) {
#pragma unroll
            for (int p = 0; p < 3; ++p)
#pragma unroll
                for (int j = 0; j < 4; ++j) o[j] = o[j] + bf4(cs[p][j]); }
#pragma unroll
        for (int j = 0; j < 4; ++j) ss += sq4(o[j]);
        const float ro = rsqrtf(wave_sum(ss) * (1.f / DM) + EPS);
        f32x4* y4 = (f32x4*)(Y + (size_t)r * DM) + lane; u32x2* yb2 = (u32x2*)(Y + (size_t)r * DM) + lane; float s2 = 0.f;
#pragma unroll
        for (int j = 0; j < 4; ++j) { x[j] = x[j] + gt[j] * (o[j] * ro * gp[j]);
            if (XOUT16) yb2[64 * j] = (u32x2){pk2(x[j].x, x[j].y), pk2(x[j].z, x[j].w)}; else y4[64 * j] = x[j];
            s2 += sq4(x[j]); }
        if (NEXT) {
            const float rx = rsqrtf(wave_sum(s2) * (1.f / DM) + EPS);
            u32x2* h2 = (u32x2*)(H + (size_t)r * DM) + lane;
#pragma unroll
            for (int j = 0; j < 4; ++j) { const f32x4 h = x[j] * rx * gn[j] * (1.f + sc[j]) + sh[j]; h2[64 * j] = (u32x2){pk2(h.x, h.y), pk2(h.z, h.w)}; }
        }
#pragma unroll
        for (int j = 0; j < 4; ++j) { co[j] = no[j]; cxb[j] = nxb[j]; cxf[j] = nxf[j];
#pragma unroll
            for (int p = 0; p < 3; ++p) cs[p][j] = ns[p][j]; }
    }
#undef POST_LOAD
}

template <bool SLAB, bool XF32 = false>
__device__ __forceinline__ void phase_post16(const bf16* O, const bf16* slab, const float* xp, const float* xs, float* Y, const float* gpost, const float* modl, int gidx,
                                             const float* gpre_n, const float* modn, int sidx_n, bf16* H, int gw, int slab_off, int lane) {
    int l8 = 8 * lane; asm volatile("" : "+v"(l8));
#define RC(q) (l8 + 512 * ((q) >> 1) + 4 * ((q) & 1))
#define BF8(vv_, lo_, hi_) do { const u32x4 t_ = (vv_); lo_ = bf4((u32x2){t_.x, t_.y}); hi_ = bf4((u32x2){t_.z, t_.w}); } while (0)
#define PK8(a_, b_) ((u32x4){pk2((a_).x, (a_).y), pk2((a_).z, (a_).w), pk2((b_).x, (b_).y), pk2((b_).z, (b_).w)})
    f32x4 gp[4], gn[4];
#pragma unroll
    for (int q = 0; q < 4; ++q) { gp[q] = *(const f32x4*)(gpost + RC(q)); gn[q] = *(const f32x4*)(gpre_n + RC(q)); }
    u32x4 co[2], no[2], cxb[2], nxb[2], cs[3][2], ns[3][2]; f32x4 cxf[4], nxf[4];
#define POST_LOAD16(rr, it, po, pxb, pxf, ps) do { \
        const u32x4* o4_ = (const u32x4*)(O + (size_t)(rr) * DM + l8); po[0] = o4_[0]; po[1] = o4_[64]; \
        if (!XF32) { const u32x4* b4_ = (const u32x4*)((const bf16*)Y + (size_t)(rr) * (2 * DM) + l8); pxb[0] = b4_[0]; pxb[1] = b4_[64]; } \
        else { const float* xr_ = xrow_in(xp, xs, (rr)); _Pragma("unroll") for (int q = 0; q < 4; ++q) pxf[q] = *(const f32x4*)(xr_ + RC(q)); } \
        if (SLAB && (it) >= 8) { _Pragma("unroll") for (int p = 0; p < 3; ++p) { const u32x4* s4_ = (const u32x4*)(slab + (size_t)p * SLAB_ELEMS + (size_t)((rr) - slab_off) * DM + l8); \
            ps[p][0] = s4_[0]; ps[p][1] = s4_[64]; } } } while (0)
    POST_LOAD16(gw, 0, co, cxb, cxf, cs);
    f32x4 gt[4], sh[4], sc[4]; int pcnd = -1;
#pragma unroll
    for (int i = 0; i < NIT; ++i) {
        const int r = gw + 256 * i, cnd = cond_of(r);
        if (cnd != pcnd) {
            pcnd = cnd;
#pragma unroll
            for (int q = 0; q < 4; ++q) { gt[q] = *(const f32x4*)(modl + (size_t)cnd * 6144 + gidx * DM + RC(q));
                sh[q] = *(const f32x4*)(modn + (size_t)cnd * 6144 + sidx_n * DM + RC(q)); sc[q] = *(const f32x4*)(modn + (size_t)cnd * 6144 + (sidx_n + 1) * DM + RC(q)); }
        }
        if (i + 1 < NIT) POST_LOAD16(r + 256, i + 1, no, nxb, nxf, ns);
        f32x4 o[4], x[4]; float ss = 0.f;
        BF8(co[0], o[0], o[1]); BF8(co[1], o[2], o[3]);
        if (!XF32) { BF8(cxb[0], x[0], x[1]); BF8(cxb[1], x[2], x[3]); }
        else {
#pragma unroll
            for (int q = 0; q < 4; ++q) x[q] = cxf[q]; }
        if (SLAB && i >= 8) {
#pragma unroll
            for (int p = 0; p < 3; ++p) { f32x4 a0, a1, a2, a3; BF8(cs[p][0], a0, a1); BF8(cs[p][1], a2, a3); o[0] = o[0] + a0; o[1] = o[1] + a1; o[2] = o[2] + a2; o[3] = o[3] + a3; } }
#pragma unroll
        for (int q = 0; q < 4; ++q) ss += sq4(o[q]);
        const float ro = rsqrtf(wave_sum(ss) * (1.f / DM) + EPS);
        float s2 = 0.f;
#pragma unroll
        for (int q = 0; q < 4; ++q) { x[q] = x[q] + gt[q] * (o[q] * ro * gp[q]); s2 += sq4(x[q]); }
        { u32x4* y4b = (u32x4*)((bf16*)Y + (size_t)r * (2 * DM) + l8); y4b[0] = PK8(x[0], x[1]); y4b[64] = PK8(x[2], x[3]); }
        const float rx = rsqrtf(wave_sum(s2) * (1.f / DM) + EPS);
        f32x4 hq[4];
#pragma unroll
        for (int q = 0; q < 4; ++q) hq[q] = x[q] * rx * gn[q] * (1.f + sc[q]) + sh[q];
        { u32x4* h4 = (u32x4*)(H + (size_t)r * DM + l8); h4[0] = PK8(hq[0], hq[1]); h4[64] = PK8(hq[2], hq[3]); }
#pragma unroll
        for (int jj = 0; jj < 2; ++jj) { co[jj] = no[jj]; cxb[jj] = nxb[jj];
#pragma unroll
            for (int p = 0; p < 3; ++p) cs[p][jj] = ns[p][jj]; }
#pragma unroll
        for (int q = 0; q < 4; ++q) cxf[q] = nxf[q];
    }
#undef POST_LOAD16
#undef RC
#undef BF8
#undef PK8
}

__device__ __forceinline__ void phase_conv(const bf16* U, bf16* MIX, const float* sc_w, const float* dw_w, const float* dw_b, const float* ln_g, const float* ln_b,
                                           LAS unsigned char* lds, int tid, int wave, int lane, int G) {
    LAS bf16* zsb = (LAS bf16*)lds;
    LAS bf16* pbuf = (LAS bf16*)(lds + 62 * 1024);
    LAS bf16* zbuf = (LAS bf16*)(lds + 96 * 1024);
    LAS float* part = (LAS float*)(lds + 129 * 1024);
    LAS float* stat = part + 512;
    const int c = tid, srow = tid >> 6, ch8 = tid & 63;
    float w[31];
#pragma unroll
    for (int j = 0; j < 31; ++j) w[j] = dw_w[j * 512 + c];
    const float bdw = dw_b[c], lg = ln_g[c], lb = ln_b[c];
    u32x4 bv[8], ac[5];
#define CONV_LOAD(chn) do { const int r0n_ = 32 * (chn); const bf16* ub_ = U + (size_t)(r0n_ - 15 + srow) * CU2 + 1024 + 8 * ch8; \
        _Pragma("unroll") for (int p = 0; p < 8; ++p) { const int row = srow + 8 * p; bv[p] = *(const u32x4*)(ub_ + (size_t)(row < 62 ? 8 * p : 0) * CU2); } } while (0)
#define CONV_LOAD_A(chn) do { const int r0n_ = 32 * (chn); const bf16* ua_ = U + (size_t)(r0n_ - 1 + srow) * CU2 + 512 + 8 * ch8; \
        _Pragma("unroll") for (int p = 0; p < 5; ++p) { const int row = srow + 8 * p; ac[p] = *(const u32x4*)(ua_ + (size_t)(row < 34 ? 8 * p : 0) * CU2); } } while (0)
    const int cx = 80 * ((int)blockIdx.x & 7), cs0 = (int)blockIdx.x >> 3;
    CONV_LOAD(cx + cs0); CONV_LOAD_A(cx + cs0);
    for (int cs = cs0; cs < 80; cs += 32) { const int ch = cx + cs;
        const int r0 = 32 * ch;
        const int sq0 = r0 < TP ? (r0 & ~255) : TP + ((r0 - TP) & ~2047), sq1 = sq0 + (r0 < TP ? 256 : 2048);
#pragma unroll
        for (int p = 0; p < 8; ++p) { const int row = srow + 8 * p, rr = r0 - 15 + row; const bool ok = rr >= sq0 && rr < sq1;
            if (row < 62) *(LAS u32x4*)(zsb + row * 512 + 8 * ch8) = ok ? bv[p] : (u32x4){0u, 0u, 0u, 0u}; }
#pragma unroll
        for (int p = 0; p < 5; ++p) { const int row = srow + 8 * p, rr = r0 - 1 + row; const bool ok = rr >= sq0 && rr < sq1;
            if (row < 34) *(LAS u32x4*)(pbuf + row * 512 + 8 * ch8) = ok ? ac[p] : (u32x4){0u, 0u, 0u, 0u}; }
        __syncthreads();
        float z1[32];
        {   float z0[62];
#pragma unroll
            for (int j = 0; j < 62; ++j) z0[j] = bf2f(zsb[j * 512 + c]);
#pragma unroll
            for (int t = 0; t < 32; ++t) z1[t] = bdw;
#pragma unroll
            for (int j = 0; j < 31; ++j)
#pragma unroll
                for (int t = 0; t < 32; ++t) z1[t] += w[j] * z0[t + j]; }
        __builtin_amdgcn_sched_barrier(0);
        u32x4 gb[4];
        {   const bf16* ug = U + (size_t)(r0 + srow) * CU2 + 8 * ch8;
#pragma unroll
            for (int p = 0; p < 4; ++p) gb[p] = *(const u32x4*)(ug + (size_t)(8 * p) * CU2); }
        if (cs + 32 < 80) CONV_LOAD(ch + 32);
        __builtin_amdgcn_sched_barrier(0);
#pragma unroll
        for (int pass = 0; pass < 2; ++pass) { float v1[32];
#pragma unroll
            for (int t = 0; t < 32; ++t) v1[t] = pass ? z1[t] * z1[t] : z1[t];
#pragma unroll
            for (int st = 0; st < 5; ++st) { const int B = 32 >> st, n = 16 >> st; const bool hi = (lane & B) != 0;
#pragma unroll
                for (int i = 0; i < 16; ++i) if (i < n) { const float s1 = hi ? v1[i] : v1[i + n], k1 = hi ? v1[i + n] : v1[i]; v1[i] = k1 + __shfl_xor(s1, B); } }
            v1[0] += __shfl_xor(v1[0], 1);
            if ((lane & 1) == 0) part[pass * 256 + wave * 32 + (lane >> 1)] = v1[0];
            __builtin_amdgcn_sched_barrier(0); }
        __syncthreads();
        if (tid < 32) { float a = 0.f, b = 0.f;
#pragma unroll
            for (int q = 0; q < 8; ++q) { a += part[q * 32 + tid]; b += part[256 + q * 32 + tid]; }
            const float mean = a * (1.f / 512.f), var = fmaxf(b * (1.f / 512.f) - mean * mean, 0.f);
            stat[2 * tid] = mean; stat[2 * tid + 1] = rsqrtf(var + EPS); }
        __syncthreads();
#pragma unroll
        for (int t = 0; t < 32; ++t) { const f32x2 ms = *(const LAS f32x2*)(stat + 2 * t); const float y = (z1[t] - ms.x) * ms.y * lg + lb; zbuf[t * 512 + c] = f2bf(fsilu(y)); }
        float scw[3][8];
#pragma unroll
        for (int j = 0; j < 3; ++j) { const f32x4 a = *(const f32x4*)(sc_w + j * 512 + 8 * ch8), b = *(const f32x4*)(sc_w + j * 512 + 8 * ch8 + 4);
            scw[j][0] = a.x; scw[j][1] = a.y; scw[j][2] = a.z; scw[j][3] = a.w; scw[j][4] = b.x; scw[j][5] = b.y; scw[j][6] = b.z; scw[j][7] = b.w; }
#pragma unroll
        for (int p = 0; p < 4; ++p) { const int t = srow + 8 * p;
            float g[8], p0[8], p1[8], p2[8]; unpack8(gb[p], g);
            unpack8(*(const LAS u32x4*)(pbuf + t * 512 + 8 * ch8), p0); unpack8(*(const LAS u32x4*)(pbuf + (t + 1) * 512 + 8 * ch8), p1); unpack8(*(const LAS u32x4*)(pbuf + (t + 2) * 512 + 8 * ch8), p2);
#pragma unroll
            for (int k = 0; k < 8; ++k) g[k] = g[k] * (scw[0][k] * p0[k] + scw[1][k] * p1[k] + scw[2][k] * p2[k]);
            *(u32x4*)(MIX + (size_t)(r0 + t) * DM + 8 * ch8) = pack8(g); }
        __builtin_amdgcn_sched_barrier(0);
        if (cs + 32 < 80) CONV_LOAD_A(ch + 32);
        __syncthreads();
#pragma unroll
        for (int p = 0; p < 4; ++p) { const int t = srow + 8 * p; *(u32x4*)(MIX + (size_t)(r0 + t) * DM + 512 + 8 * ch8) = *(const LAS u32x4*)(zbuf + t * 512 + 8 * ch8); }
    }
#undef CONV_LOAD
#undef CONV_LOAD_A
}

__device__ __forceinline__ void rope_head64(float (&v)[8], int lane, const f32x2 (&cs)[8]) {
    const bool second = (lane & 2) != 0;
#pragma unroll
    for (int j = 0; j < 8; ++j) { const float pv = __shfl_xor(v[j], 2);
        v[j] = second ? v[j] * cs[j].x + pv * cs[j].y : v[j] * cs[j].x - pv * cs[j].y; }
}
__device__ __forceinline__ void phase_attn_rows(const bf16* U1, const float* qn, const float* kn, const float* qan, const float* kvan, const f32x2* tabg, const f32x2* tabm,
                                                bf16* QC, bf16* KC, bf16* VtC, bf16* QA, bf16* CKV, bf16* KR, float* o_k, float* o_v, float* o_ckv, float* o_kr,
                                                const float* c_k, const float* c_v, const float* c_ckv, const float* c_kr, LAS unsigned char* lds, int bid, int tid, int wave, int lane) {
    LAS bf16* vbuf = (LAS bf16*)lds;
    LAS f32x2* ltg = (LAS f32x2*)(lds + 8192);
    LAS f32x2* ltm = ltg + 64 * 16;
    { const u32x4* src = (const u32x4*)tabg; LAS u32x4* dst = (LAS u32x4*)(lds + 8192); dst[tid] = src[tid]; if (tid < 256) dst[512 + tid] = src[512 + tid]; }
    const int pb = (bid & 7) * 32 + (bid >> 3);
    const int gw = pb * NWAVES + wave, rb0 = 2560 * (bid & 7) + 8 * (bid >> 3), r0 = rb0 + wave, l2 = lane & 31,
    l3 = lane < 48 ? lane : 0, l4 = lane & 3, d0 = 8 * (lane & 7);
    const bool hi32 = lane >= 32, krl = lane >= 48 && lane < 52;
    float knv[8], qav[8], kvv[8];
#pragma unroll
    for (int j = 0; j < 8; ++j) { knv[j] = kn[d0 + j]; qav[j] = qan[8 * l3 + j]; kvv[j] = kvan[8 * l2 + j]; }
    u32x4 ckv_, cqa, nkv, nqa;
    const int okv = hi32 ? 640 + 8 * l2 : 8 * l2, oqa = lane < 48 ? 256 + 8 * lane : 896 + 8 * l4;
#define AR_LOAD(rr, pkv, pqa) do { const bf16* u_ = U1 + (size_t)(rr) * U1W; pkv = *(const u32x4*)(u_ + okv); pqa = *(const u32x4*)(u_ + oqa); } while (0)
    AR_LOAD(r0, ckv_, cqa);
    const f32x4 ck4 = *(const f32x4*)(c_k + (size_t)gw * 128 + 4 * l2), cv4 = *(const f32x4*)(c_v + (size_t)gw * 128 + 4 * l2), cc4 = *(const f32x4*)(c_ckv + (size_t)gw * 256 + 4 * lane);
    const float ckr1 = c_kr[(size_t)gw * 32 + l2];
    __syncthreads();
#pragma unroll 1
    for (int i = 0; i < NIT; ++i) {
        const int r = r0 + 256 * i;
        if (i + 1 < NIT) AR_LOAD(r + 256, nkv, nqa);
        const bool smp = r >= TP; const int ts = (r - TP) & 2047, prow = ts >> 6, pcol = ts & 63;
        const int krow = smp ? TP + ((r - TP) >> 11) * KSEQ + PAST + ts : r;
        f32x2 csg[8];
        { const LAS f32x4* t4 = (const LAS f32x4*)(ltg + ((lane & 4) ? pcol : prow) * 16 + 8 * (lane & 1));
#pragma unroll
          for (int j = 0; j < 4; ++j) { const f32x4 t = t4[j]; csg[2 * j] = (f32x2){t.x, t.y}; csg[2 * j + 1] = (f32x2){t.z, t.w}; } }
        float ssc;
        {
            float v[8], raw[8]; unpack8(ckv_, v);
            float ss = 0.f;
#pragma unroll
            for (int j = 0; j < 8; ++j) { raw[j] = v[j]; ss += v[j] * v[j]; }
            ssc = ss;
            ss += __shfl_xor(ss, 1); ss += __shfl_xor(ss, 2); ss += __shfl_xor(ss, 4);
            const float rstd = rsqrtf(ss * (1.f / 64.f) + EPS);
#pragma unroll
            for (int j = 0; j < 8; ++j) v[j] = v[j] * rstd * knv[j];
            if (lane < 16 && !smp) { float* ok = o_k + (size_t)r * 128 + 8 * lane; *(f32x4*)ok = (f32x4){v[0], v[1], v[2], v[3]}; *(f32x4*)(ok + 4) = (f32x4){v[4], v[5], v[6], v[7]}; }
            float vr[8];
#pragma unroll
            for (int j = 0; j < 8; ++j) vr[j] = v[j];
            rope_head64(vr, lane, csg);
#pragma unroll
            for (int j = 0; j < 8; ++j) v[j] = smp ? vr[j] : v[j];
            if (lane < 16) *(u32x4*)(KC + (size_t)krow * 128 + 8 * lane) = pack8(v);
            else if (lane < 32) { const int cv = 8 * (lane - 16);
                *(LAS u32x4*)(vbuf + ((i & 1) * 8 + wave) * 128 + cv) = ckv_;
                if (!smp) { float* ov = o_v + (size_t)r * 128 + cv; *(f32x4*)ov = (f32x4){raw[0], raw[1], raw[2], raw[3]}; *(f32x4*)(ov + 4) = (f32x4){raw[4], raw[5], raw[6], raw[7]}; } }
            const float sc = wave_sum(hi32 ? ssc : 0.f);
            const float rc = rsqrtf(sc * (1.f / 256.f) + EPS);
            if (hi32) { float c[8];
#pragma unroll
                for (int j = 0; j < 8; ++j) c[j] = raw[j] * rc * kvv[j];
                *(u32x4*)(CKV + (size_t)krow * KVL + 8 * l2) = pack8(c);
                if (!smp) { float* oc = o_ckv + (size_t)r * 256 + 8 * l2; *(f32x4*)oc = (f32x4){c[0], c[1], c[2], c[3]}; *(f32x4*)(oc + 4) = (f32x4){c[4], c[5], c[6], c[7]}; } }
        }
        {
            float v[8]; unpack8(cqa, v);
            float ss = 0.f;
#pragma unroll
            for (int j = 0; j < 8; ++j) ss += v[j] * v[j];
            ss = wave_sum(lane < 48 ? ss : 0.f);
            const float rstd = rsqrtf(ss * (1.f / 384.f) + EPS);
            if (lane < 48) { float a[8];
#pragma unroll
                for (int j = 0; j < 8; ++j) a[j] = v[j] * rstd * qav[j];
                *(u32x4*)(QA + (size_t)r * QL + 8 * lane) = pack8(a); }
            const int blk = l4 >> 1, pos = blk ? pcol : prow; const bool second = (l4 & 1) != 0;
            if (krl && !smp) { float* okr = o_kr + (size_t)r * 32 + 8 * l4; *(f32x4*)okr = (f32x4){v[0], v[1], v[2], v[3]}; *(f32x4*)(okr + 4) = (f32x4){v[4], v[5], v[6], v[7]}; }
            const LAS f32x4* t4 = (const LAS f32x4*)(ltm + pos * 8);
            unsigned wd[8];
#pragma unroll
            for (int j = 0; j < 4; ++j) { const f32x4 t = t4[j];
#pragma unroll
                for (int q = 0; q < 2; ++q) { const int jj = 2 * j + q; const float cx = q ? t.z : t.x, sx = q ? t.w : t.y;
                    const float pv = __shfl_xor(v[jj], 1);
                    const float rv = second ? v[jj] * cx + pv * sx : v[jj] * cx - pv * sx; const float o = smp ? rv : v[jj];
                    const float po = __shfl_xor(o, 1);
                    wd[jj] = second ? pk2(po, o) : pk2(o, po); } }
            if (krl) *(u32x4*)(KR + (size_t)krow * 32 + 16 * blk + (second ? 8 : 0)) = second ? (u32x4){wd[4], wd[5], wd[6], wd[7]} : (u32x4){wd[0], wd[1], wd[2], wd[3]};
        }
        __syncthreads();
        if (tid < 128) {
            const int rb = rb0 + 256 * i, kb = rb >= TP ? TP + ((rb - TP) >> 11) * KSEQ + PAST + ((rb - TP) & 2047) : rb;
            const LAS bf16* vp = vbuf + (i & 1) * 1024 + tid; u32x4 w;
            w.x = (unsigned)vp[0] | ((unsigned)vp[128] << 16); w.y = (unsigned)vp[256] | ((unsigned)vp[384] << 16); w.z = (unsigned)vp[512] | ((unsigned)vp[640] << 16); w.w = (unsigned)vp[768] | ((unsigned)vp[896] << 16);
            *(u32x4*)(VtC + (size_t)tid * TK + kb) = w; }
        ckv_ = nkv; cqa = nqa;
    }
#undef AR_LOAD
    {   const int cr = gw, krow = TP + (cr >> 8) * KSEQ + (cr & 255);
        __syncthreads();
        if (lane < 32) { *(u32x2*)(KC + (size_t)krow * 128 + 4 * lane) = (u32x2){pk2(ck4.x, ck4.y), pk2(ck4.z, ck4.w)};
            *(LAS u32x2*)(vbuf + wave * 128 + 4 * lane) = (u32x2){pk2(cv4.x, cv4.y), pk2(cv4.z, cv4.w)};
            const int e = lane, blk = e >> 4, loc = e & 15; KR[(size_t)krow * 32 + 16 * blk + 2 * (loc & 7) + (loc >> 3)] = f2bf(ckr1); }
        *(u32x2*)(CKV + (size_t)krow * KVL + 4 * lane) = (u32x2){pk2(cc4.x, cc4.y), pk2(cc4.z, cc4.w)};
        __syncthreads();
        if (tid < 128) { const int cb = pb * NWAVES, kb = TP + (cb >> 8) * KSEQ + (cb & 255);
            const LAS bf16* vp = vbuf + tid; u32x4 w;
            w.x = (unsigned)vp[0] | ((unsigned)vp[128] << 16); w.y = (unsigned)vp[256] | ((unsigned)vp[384] << 16); w.z = (unsigned)vp[512] | ((unsigned)vp[640] << 16); w.w = (unsigned)vp[768] | ((unsigned)vp[896] << 16);
            *(u32x4*)(VtC + (size_t)tid * TK + kb) = w; }
        __syncthreads();
    }
}

#define MFMA32(a, b, c) __builtin_amdgcn_mfma_f32_32x32x16_bf16((a), (b), (c), 0, 0, 0)
template <bool MLA, int ABL>
__device__ __forceinline__ void attn_tile(const LAS unsigned char* kb, const LAS unsigned char* rb, const LAS unsigned char* vb, const bf16x8 (&qf)[MLA ? 6 : 4],
                                          f32x16& o0, f32x16& o1, float& m, float& l, float c, int r, int h) {
    constexpr int NQ = MLA ? 6 : 4;
    f32x16 p0, p1;
#pragma unroll
    for (int i = 0; i < 16; ++i) { p0[i] = 0.f; p1[i] = 0.f; }
#pragma unroll
    for (int ks = 0; ks < 4; ++ks) { const bf16x8 a0 = *(const LAS bf16x8*)(kb + r * 144 + ks * 32 + h * 16), a1 = *(const LAS bf16x8*)(kb + (32 + r) * 144 + ks * 32 + h * 16);
        p0 = MFMA32(a0, qf[ks], p0); p1 = MFMA32(a1, qf[ks], p1); }
    if (MLA) {
#pragma unroll
        for (int ks = 0; ks < 2; ++ks) { const bf16x8 a0 = *(const LAS bf16x8*)(rb + r * 80 + ks * 32 + h * 16), a1 = *(const LAS bf16x8*)(rb + (32 + r) * 80 + ks * 32 + h * 16);
            p0 = MFMA32(a0, qf[NQ - 2 + ks], p0); p1 = MFMA32(a1, qf[NQ - 2 + ks], p1); } }
    bf16x8 vf[2][2][2];
#pragma unroll
    for (int t = 0; t < 2; ++t)
#pragma unroll
        for (int s = 0; s < 2; ++s)
#pragma unroll
            for (int dh = 0; dh < 2; ++dh) vf[t][s][dh] = *(const LAS bf16x8*)(vb + (32 * dh + r) * 144 + 64 * t + 32 * s + 16 * h);
    __builtin_amdgcn_sched_barrier(0);
    if (ABL != 1 && ABL != 3) {
    float mx = p0[0];
#pragma unroll
    for (int i = 1; i < 16; ++i) mx = fmaxf(mx, p0[i]);
#pragma unroll
    for (int i = 0; i < 16; ++i) mx = fmaxf(mx, p1[i]);
    mx = fmaxf(mx, __shfl_xor(mx, 32));
    if (!__all((mx - m) * c <= 8.f)) {
        const float mn = fmaxf(m, mx), alpha = __builtin_amdgcn_exp2f((m - mn) * c); m = mn; l *= alpha;
#pragma unroll
        for (int i = 0; i < 16; ++i) { o0[i] *= alpha; o1[i] *= alpha; }
    }
    const float mc = -m * c;
    float ps = 0.f;
#pragma unroll
    for (int i = 0; i < 16; ++i) { p0[i] = __builtin_amdgcn_exp2f(fmaf(p0[i], c, mc)); ps += p0[i]; }
#pragma unroll
    for (int i = 0; i < 16; ++i) { p1[i] = __builtin_amdgcn_exp2f(fmaf(p1[i], c, mc)); ps += p1[i]; }
    l += ps;
    }
    bf16x8 pb[2][2];
#pragma unroll
    for (int s = 0; s < 2; ++s) {
        u32x4 w0; w0.x = pk2(p0[8 * s + 0], p0[8 * s + 1]); w0.y = pk2(p0[8 * s + 2], p0[8 * s + 3]); w0.z = pk2(p0[8 * s + 4], p0[8 * s + 5]); w0.w = pk2(p0[8 * s + 6], p0[8 * s + 7]);
        u32x4 w1; w1.x = pk2(p1[8 * s + 0], p1[8 * s + 1]); w1.y = pk2(p1[8 * s + 2], p1[8 * s + 3]); w1.z = pk2(p1[8 * s + 4], p1[8 * s + 5]); w1.w = pk2(p1[8 * s + 6], p1[8 * s + 7]);
        pb[0][s] = __builtin_bit_cast(bf16x8, w0); pb[1][s] = __builtin_bit_cast(bf16x8, w1); }
    __builtin_amdgcn_sched_barrier(0);
#pragma unroll
    for (int t = 0; t < 2; ++t)
#pragma unroll
        for (int s = 0; s < 2; ++s) {
            o0 = MFMA32(vf[t][s][0], pb[t][s], o0);
            o1 = MFMA32(vf[t][s][1], pb[t][s], o1); }
    __builtin_amdgcn_sched_barrier(0);
}
constexpr int ATT_TAB_OFF = 100 * 1024;
struct AttnNext { const bf16* Q; const bf16* K; const bf16* V; const bf16* KR; int ldq, ldk; };
template <bool MLA, int ABL = 0>
__device__ __forceinline__ void attn_unit(LAS unsigned char* lds, const bf16* Q, int ldq, const bf16* K, int ldk, const bf16* KRp, const bf16* Vt, int nkeys, bf16* O, float c,
                                          const f32x2* tabm, int qpos0, int tid, int wave, int lane, const AttnNext& nx) {
    constexpr int NQ = MLA ? 6 : 4;
    constexpr int KB_SZ = 64 * 144, KR_OFF = 4 * KB_SZ, KR_SZ = 64 * 80, VT_OFF = KR_OFF + 4 * KR_SZ, VT_SZ = 64 * 144;
    const int r = lane & 31, h = lane >> 5;
    const int skey = tid >> 3, sch = tid & 7;
    const bf16* kg = K + (size_t)skey * ldk + 8 * sch;
    const bf16* vg = Vt + (size_t)skey * TK + 8 * sch;
    const bf16* rg = KRp + (size_t)(tid >> 2) * 32 + 8 * (tid & 3);
    const int kw = skey * 144 + sch * 16, vw = skey * 144 + (sch >> 1) * 32 + (sch & 1) * 8, rw = (tid >> 2) * 80 + (tid & 3) * 16;
    const int np = nkeys >> 7;
    u32x4 kreg[2], vreg[2], rreg[2];
#define AT_LOAD(pp) do { _Pragma("unroll") for (int q_ = 0; q_ < 2; ++q_) { const int tt_ = 2 * (pp) + q_; kreg[q_] = *(const u32x4*)(kg + (size_t)tt_ * 64 * ldk); vreg[q_] = *(const u32x4*)(vg + tt_ * 64); \
        if (MLA && tid < 256) rreg[q_] = *(const u32x4*)(rg + (size_t)tt_ * 64 * 32); } } while (0)
#define AT_WRITE(pr) do { _Pragma("unroll") for (int q_ = 0; q_ < 2; ++q_) { const int sl_ = 2 * (pr) + q_; *(LAS u32x4*)(lds + sl_ * KB_SZ + kw) = kreg[q_]; \
        *(LAS u32x2*)(lds + VT_OFF + sl_ * VT_SZ + vw) = (u32x2){vreg[q_].x, vreg[q_].y}; *(LAS u32x2*)(lds + VT_OFF + sl_ * VT_SZ + vw + 16) = (u32x2){vreg[q_].z, vreg[q_].w}; \
        if (MLA && tid < 256) *(LAS u32x4*)(lds + KR_OFF + sl_ * KR_SZ + rw) = rreg[q_]; } } while (0)
    AT_LOAD(0);
    bf16x8 qf[NQ];
    { const bf16* qrow = Q + (size_t)(32 * wave + r) * ldq + 8 * h;
#pragma unroll
      for (int ks = 0; ks < NQ; ++ks) qf[ks] = *(const bf16x8*)(qrow + 16 * ks); }
    if (MLA && qpos0 >= 0) {
        const int ts = qpos0 + 32 * wave + r, prow = ts >> 6, pcol = ts & 63;
#pragma unroll
        for (int blk = 0; blk < 2; ++blk) { const u32x4 w = __builtin_bit_cast(u32x4, qf[NQ - 2 + blk]); float v[8]; unpack8(w, v); const int pos = blk ? pcol : prow;
#pragma unroll
            for (int jj = 0; jj < 4; ++jj) { const f32x2 cs = ((const LAS f32x2*)(lds + ATT_TAB_OFF + 8448))[pos * 8 + 4 * h + jj]; const float x1 = v[2 * jj], x2 = v[2 * jj + 1]; v[2 * jj] = x1 * cs.x - x2 * cs.y; v[2 * jj + 1] = x2 * cs.x + x1 * cs.y; }
            qf[NQ - 2 + blk] = __builtin_bit_cast(bf16x8, pack8(v)); }
    }
    const LAS f32x2* ltg = (const LAS f32x2*)(lds + ATT_TAB_OFF); const LAS float* lqn = (const LAS float*)(lds + ATT_TAB_OFF + 8192);
    if (!MLA) {
        float v[4][8];
#pragma unroll
        for (int ks = 0; ks < 4; ++ks) unpack8(__builtin_bit_cast(u32x4, qf[ks]), v[ks]);
        float ss = 0.f;
#pragma unroll
        for (int ks = 0; ks < 4; ++ks)
#pragma unroll
            for (int j = 0; j < 8; ++j) ss += v[ks][j] * v[ks][j];
        ss += __shfl_xor(ss, 32);
        const float rstd = rsqrtf(ss * (1.f / 64.f) + EPS);
#pragma unroll
        for (int ks = 0; ks < 4; ++ks) { const f32x4 g0 = *(const LAS f32x4*)(lqn + 16 * ks + 8 * h), g1 = *(const LAS f32x4*)(lqn + 16 * ks + 8 * h + 4);
            v[ks][0] *= rstd * g0.x; v[ks][1] *= rstd * g0.y; v[ks][2] *= rstd * g0.z; v[ks][3] *= rstd * g0.w; v[ks][4] *= rstd * g1.x; v[ks][5] *= rstd * g1.y; v[ks][6] *= rstd * g1.z; v[ks][7] *= rstd * g1.w; }
        if (qpos0 >= 0) {
            const int ts = qpos0 + 32 * wave + r, prow = ts >> 6, pcol = ts & 63;
#pragma unroll
            for (int hf = 0; hf < 2; ++hf) { const LAS f32x2* tg = ltg + (hf ? pcol : prow) * 16 + 8 * h;
#pragma unroll
                for (int j = 0; j < 8; ++j) { const f32x2 cs = tg[j]; const float x1 = v[2 * hf][j], x2 = v[2 * hf + 1][j]; v[2 * hf][j] = x1 * cs.x - x2 * cs.y; v[2 * hf + 1][j] = x2 * cs.x + x1 * cs.y; } }
        }
#pragma unroll
        for (int ks = 0; ks < 4; ++ks) qf[ks] = __builtin_bit_cast(bf16x8, pack8(v[ks]));
    }
    f32x16 o0, o1;
#pragma unroll
    for (int i = 0; i < 16; ++i) { o0[i] = 0.f; o1[i] = 0.f; }
    float m = -1e30f, l = 0.f; unsigned pf = 0u;
    AT_WRITE(0);
    __syncthreads();
    for (int j = 0; j < np; ++j) {
        const int cur = j & 1; const bool more = j + 1 < np;
        if (ABL != 3) { if (more) AT_LOAD(j + 1); }
        if (!more) {
            const unsigned* pa = (const unsigned*)(nx.Q + (size_t)(tid >> 1) * nx.ldq + (tid & 1) * 64);
            const unsigned* pb = tid < 128 ? (const unsigned*)(nx.K + (size_t)tid * nx.ldk)
                               : tid < 256 ? (const unsigned*)(nx.V + (size_t)((tid - 128) >> 1) * TK + (tid & 1) * 64)
                               : tid < 320 ? (const unsigned*)(nx.KR + (size_t)(2 * (tid - 256)) * 32) : pa;
            pf = *pa ^ *pb; }
#pragma unroll
        for (int q = 0; q < 2; ++q) { const int sl = 2 * cur + q;
            attn_tile<MLA, ABL>(lds + sl * KB_SZ, lds + KR_OFF + sl * KR_SZ, lds + VT_OFF + sl * VT_SZ, qf, o0, o1, m, l, c, r, h); }
        if (ABL != 3) { if (more) AT_WRITE(cur ^ 1);
        __syncthreads(); }
    }
#undef AT_LOAD
#undef AT_WRITE
    *(LAS unsigned*)(lds + 96 * 1024 + 4 * tid) = pf;
    l += __shfl_xor(l, 32);
    const float inv = 1.f / l;
    bf16* orow = O + (size_t)(32 * wave + r) * DM;
#pragma unroll
    for (int hf = 0; hf < 2; ++hf)
#pragma unroll
        for (int pp = 0; pp < 2; ++pp) {
            const int ga = 2 * pp, gb2 = 2 * pp + 1;
#define OV(g_, k_) ((hf ? o1[4 * (g_) + (k_)] : o0[4 * (g_) + (k_)]) * inv)
            const u32x2 wa = (u32x2){pk2(OV(ga, 0), OV(ga, 1)), pk2(OV(ga, 2), OV(ga, 3))}, wb = (u32x2){pk2(OV(gb2, 0), OV(gb2, 1)), pk2(OV(gb2, 2), OV(gb2, 3))};
#undef OV
            const u32x2 snd = h ? wa : wb;
            const u32x2 rcv = (u32x2){(unsigned)__shfl_xor((int)snd.x, 32), (unsigned)__shfl_xor((int)snd.y, 32)};
            const u32x4 w = h ? (u32x4){rcv.x, rcv.y, wb.x, wb.y} : (u32x4){wa.x, wa.y, rcv.x, rcv.y};
            *(u32x4*)(orow + 32 * hf + 16 * pp + 8 * h) = w; }
}
__device__ __forceinline__ void phase_attention(unsigned char* ws, LAS unsigned char* lds, const f32x2* tabg, const f32x2* tabm, const float* qn, int tid, int wave, int lane, int G) {
    const bf16* QC = (const bf16*)(ws + WS_C + C_QC); const bf16* MQ = (const bf16*)(ws + WS_C + C_MQ); const bf16* KN = (const bf16*)(ws + WS_C + C_KN);
    const bf16* VTM = (const bf16*)(ws + WS_C + C_VTM); const bf16* KC = (const bf16*)(ws + WS_A + A_KC); const bf16* VTC = (const bf16*)(ws + WS_A + A_VTC);
    const bf16* KR = (const bf16*)(ws + WS_A + A_KR); bf16* ATT = (bf16*)(ws + WS_B);
    constexpr float C_G = 0.125f * 1.4426950408889634f, C_M = 0.10206207261596577f * 1.4426950408889634f;
    {   ((LAS u32x4*)(lds + ATT_TAB_OFF))[tid] = ((const u32x4*)tabg)[tid];
        if (tid < 16) ((LAS f32x4*)(lds + ATT_TAB_OFF + 8192))[tid] = ((const f32x4*)qn)[tid];
        if (tid < 256) ((LAS u32x4*)(lds + ATT_TAB_OFF + 8448))[tid] = ((const u32x4*)tabm)[tid];
        __syncthreads(); }
    if (wave >= 4) __builtin_amdgcn_s_setprio(1);
    for (int i = blockIdx.x; i < 1280; i += G) {
        bool mla; int row0, key0, nkeys, hh, qpos0;
        if (i < 1024) { mla = i < 512; const int ii = i & 511, j = ii >> 3, b = j >> 3, qb = j & 7; hh = ii & 7;
            row0 = TP + b * SEQS + qb * 256; key0 = TP + b * KSEQ; nkeys = KSEQ; qpos0 = qb * 256; }
        else { mla = i < 1152; const int ii = (i - 1024) & 127, b = ii >> 3; hh = ii & 7; row0 = b * 256; key0 = row0; nkeys = 256; qpos0 = -1; }
        AttnNext nx;
        {   const int n = i + G < 1280 ? i + G : i; bool nm; int nr, nk, nh;
            if (n < 1024) { nm = n < 512; const int ii = n & 511, j = ii >> 3, b = j >> 3, qb = j & 7; nh = ii & 7; nr = TP + b * SEQS + qb * 256; nk = TP + b * KSEQ; }
            else { nm = n < 1152; const int ii = (n - 1024) & 127, b = ii >> 3; nh = ii & 7; nr = b * 256; nk = nr; }
            if (nm) { nx.Q = MQ + (size_t)nr * MQD + nh * 96; nx.ldq = MQD; nx.K = KN + (size_t)nk * 512 + nh * 64; nx.ldk = 512; nx.V = VTM + (size_t)(nh * 64) * TK + nk; nx.KR = KR + (size_t)nk * 32; }
            else { nx.Q = QC + (size_t)nr * 512 + nh * 64; nx.ldq = 512; nx.K = KC + (size_t)nk * 128 + (nh >> 2) * 64; nx.ldk = 128; nx.V = VTC + (size_t)((nh >> 2) * 64) * TK + nk; nx.KR = KR + (size_t)nk * 32; } }
        if (mla) attn_unit<true>(lds, MQ + (size_t)row0 * MQD + hh * 96, MQD, KN + (size_t)key0 * 512 + hh * 64, 512, KR + (size_t)key0 * 32, VTM + (size_t)(hh * 64) * TK + key0, nkeys,
                                 ATT + (size_t)row0 * DM + 512 + hh * 64, C_M, tabm, qpos0, tid, wave, lane, nx);
        else attn_unit<false>(lds, QC + (size_t)row0 * 512 + hh * 64, 512, KC + (size_t)key0 * 128 + (hh >> 2) * 64, 128, KR, VTC + (size_t)((hh >> 2) * 64) * TK + key0, nkeys,
                              ATT + (size_t)row0 * DM + hh * 64, C_G, tabm, qpos0, tid, wave, lane, nx);
    }
    if (wave >= 4) __builtin_amdgcn_s_setprio(0);
}

#define XB_TMO      128
#define XB_XCNT(j)  (256  + 64 * (j))
#define XB_XSUB(j)  (1280 + 64 * (j))
#define XB_XGEN(j)  (2304 + 64 * (j))
#define XB_TOP      3328
#define XB_TOPGEN   3392
#define XCD_BAR_WORDS 3456
#define XB_SPIN_CAP (1u << 18)

__device__ __forceinline__ unsigned xb_ld(unsigned* p)              { return __hip_atomic_load(p, __ATOMIC_RELAXED, __HIP_MEMORY_SCOPE_AGENT); }
__device__ __forceinline__ unsigned xb_add(unsigned* p, unsigned v) { return __hip_atomic_fetch_add(p, v, __ATOMIC_RELAXED, __HIP_MEMORY_SCOPE_AGENT); }
__device__ __forceinline__ unsigned xb_xcc_id() { return (unsigned)__builtin_amdgcn_s_getreg((3 << 11) | 20) & 0xFu; }
#define XB_SPIN(cond, bar) do { unsigned _sp = 0; while (cond) { __builtin_amdgcn_s_sleep(1); \
    if ((++_sp & 255u) == 0u) { if (xb_ld(&(bar)[XB_TMO])) break; if (_sp > XB_SPIN_CAP) { atomicAdd(&(bar)[XB_TMO], 1u); break; } } } } while (0)

struct XcdBarrier {
    unsigned* bar; unsigned x;
    volatile LAS unsigned* st;
};

__device__ __forceinline__ XcdBarrier xcd_barrier_post(unsigned* bar, volatile LAS unsigned* st) {
    XcdBarrier b; b.bar = bar; b.x = xb_xcc_id(); b.st = st;
    if (threadIdx.x == 0) (void)xb_add(&bar[XB_XCNT(b.x)], 1u);
    return b;
}
__device__ __forceinline__ void xcd_barrier_complete(unsigned* bar, unsigned x, unsigned& nloc, unsigned& nx) {
    const unsigned G = gridDim.x * gridDim.y * gridDim.z;
    unsigned sum, cnt, mine, sp = 0u;
    for (;;) {
        sum = 0u; cnt = 0u; mine = 0u;
#pragma unroll
        for (unsigned j = 0; j < 16; ++j) { const unsigned c = xb_ld(&bar[XB_XCNT(j)]); sum += c; cnt += (c > 0u) ? 1u : 0u; mine = (j == x) ? c : mine; }
        if (sum == G) break;
        __builtin_amdgcn_s_sleep(1);
        if ((++sp & 255u) == 0u) { if (xb_ld(&bar[XB_TMO])) break; if (sp > XB_SPIN_CAP) { atomicAdd(&bar[XB_TMO], 1u); break; } }
    }
    nloc = mine > 0u ? mine : 1u; nx = cnt > 0u ? cnt : 1u;
}

__device__ __forceinline__ void xcd_barrier(const XcdBarrier& b) {
    asm volatile("s_waitcnt vmcnt(0)" ::: "memory");
    __syncthreads();
    if (threadIdx.x == 64) {
        __builtin_amdgcn_fence(__ATOMIC_ACQUIRE, "agent");
        asm volatile("s_waitcnt vmcnt(0)" ::: "memory");
    }
    if (threadIdx.x == 0) {
        unsigned* bar = b.bar;
        __builtin_amdgcn_s_waitcnt(0);
        unsigned nloc = b.st[0], nx = b.st[1];
        const unsigned gen = b.st[2];
        if (nloc == 0u) { xcd_barrier_complete(bar, b.x, nloc, nx); b.st[0] = nloc; b.st[1] = nx; }
        b.st[2] = gen + 1u;
        const unsigned old = xb_add(&bar[XB_XSUB(b.x)], 1u);
        if (old + 1u == (gen + 1u) * nloc) {
            __builtin_amdgcn_fence(__ATOMIC_RELEASE, "agent");
            asm volatile("s_waitcnt vmcnt(0)" ::: "memory");
            (void)xb_add(&bar[XB_TOP], 1u);
        }
        const unsigned target = (gen + 1u) * nx;
        XB_SPIN(xb_ld(&bar[XB_TOP]) < target, bar);
        asm volatile("s_waitcnt vmcnt(0)" ::: "memory");
    }
    __syncthreads();
}

struct Args { const float* in[32]; float* out; unsigned char* ws; int ph_lo, ph_hi; };
constexpr int NPHASE = 18;

#ifndef PG8_SP2
#define PG8_SP2 true
#endif
#ifndef PG8_ALIGN
#define PG8_ALIGN true
#endif
struct FullOrder {
    pg8::StaticOrder S; int nt;
    __device__ __forceinline__ void init(int M, int N, int K, int G, int c) { S.init(M, N, G, c); nt = K / 64; }
    __device__ __forceinline__ bool next(int i, pg8::Unit& u) const { if (!S.next(i, u)) return false; u.koff = 0; u.nt = nt; u.part = 0; return true; }
    __device__ __forceinline__ void a_ready(const pg8::Unit&) const {}
    __device__ __forceinline__ void done(const pg8::Unit&) const {}
};
struct SplitTailOrder {
    int c, K;
    __device__ __forceinline__ bool next(int i, pg8::Unit& u) const {
        const int x = c & 7, slot = c >> 3;
        if (i == 0) { u.pm = 10 * x + (slot >> 2); u.pn = slot & 3; u.koff = 0; u.nt = K / 64; u.part = 0; return true; }
        if (i == 1) { u.pm = 10 * x + 8 + (slot >> 4); u.pn = (slot >> 2) & 3; u.part = slot & 3;
            if (K == 1024) { u.koff = 256 * u.part; u.nt = 4; } else { u.koff = 64 * (u.part < 2 ? 12 * u.part : 24 + 10 * (u.part - 2)); u.nt = u.part < 2 ? 12 : 10; }
            return true; }
        return false;
    }
    __device__ __forceinline__ void a_ready(const pg8::Unit&) const {}
    __device__ __forceinline__ void done(const pg8::Unit&) const {}
};
template <class Epi>
__device__ __forceinline__ void run_gemm(LAS unsigned char* lds, const bf16* A, const bf16* Bt, int M, int N, int K, int G, int cid, const Epi& E) {
    pg8::Gemm g{A, Bt, M, N, K}; FullOrder S; S.init(M, N, K, G, cid);
    pg8::gemm_phase<Epi, FullOrder, PG8_ALIGN, PG8_SP2>(lds, g, S, E);
}
template <class Epi>
__device__ __forceinline__ void run_gemm_split(LAS unsigned char* lds, const bf16* A, const bf16* Bt, int K, int cid, const Epi& E) {
    pg8::Gemm g{A, Bt, T, 1024, K}; SplitTailOrder S{cid, K};
    pg8::gemm_phase<Epi, SplitTailOrder, PG8_ALIGN, PG8_SP2>(lds, g, S, E);
}

__global__ void __launch_bounds__(NTHR, 2) fwd_kernel(Args args) {
    extern __shared__ __attribute__((aligned(16))) unsigned char lds_raw[];
    LAS unsigned char* lds = (LAS unsigned char*)lds_raw;
#if MK_CG_SYNC
    cg::grid_group grid = cg::this_grid();
#endif
    const int tid = threadIdx.x, lane = tid & 63, wave = __builtin_amdgcn_readfirstlane(tid >> 6);
    const int G = gridDim.x, bid = blockIdx.x, gw = bid * NWAVES + wave, ngw = G * NWAVES;
    unsigned char* ws = args.ws; const float* const* in = args.in; float* out = args.out;
    const int lo = args.ph_lo, hi = args.ph_hi;
#ifndef REP_PHASE
#define REP_PHASE (-1)
#define REP_N 1
#endif
#define PH(k) if (IN(k)) for (int rp_ = 0; rp_ < ((k) == REP_PHASE ? REP_N : 1); ++rp_)
#ifndef PH_MASK
#define PH_MASK 0x3ffff
#endif
#define IN(k) (((PH_MASK >> (k)) & 1) && lo <= (k) && (k) < hi)
#if MK_CG_SYNC
#define SEAM(k) do { if (IN(k) && IN((k) + 1)) grid.sync(); } while (0)
#else
    if (tid < 3) ((volatile LAS unsigned*)(lds + 131072))[tid] = 0u;
    __syncthreads();
    const XcdBarrier bar = xcd_barrier_post((unsigned*)(args.ws + WS_CTL), (volatile LAS unsigned*)(lds + 131072));
#ifdef PROBE_TS
    volatile LAS unsigned long long* tsl = (volatile LAS unsigned long long*)(lds + 131072 + 256);
    if (bid == 0 && tid == 0) tsl[0] = __builtin_amdgcn_s_memrealtime();
#ifndef PROBE_XBAR
#define PROBE_XBAR 0
#endif
#ifndef PROBE_SUB
#define PROBE_SUB 0.f
#endif
#define SEAM(k) do { if (IN(k) && IN((k) + 1)) { xcd_barrier(bar); for (int xb_ = 0; xb_ < PROBE_XBAR; ++xb_) xcd_barrier(bar); if (bid == 0 && tid == 0) tsl[(k) + 1] = __builtin_amdgcn_s_memrealtime(); } } while (0)
#else
#define SEAM(k) do { if (IN(k) && IN((k) + 1)) xcd_barrier(bar); } while (0)
#endif
#endif
    bf16* H = (bf16*)(ws + WS_A); bf16* OB = (bf16*)(ws + WS_A); bf16* MIX = (bf16*)(ws + WS_B); bf16* ATT = (bf16*)(ws + WS_B);
    bf16* U = (bf16*)(ws + WS_C); bf16* ACT = (bf16*)(ws + WS_C);
    bf16* SLABB = (bf16*)(ws + WS_B); bf16* SLABC = (bf16*)(ws + WS_C);
    const float* MOD0 = (const float*)(ws + WS_MOD); const float* MOD1 = MOD0 + 9 * 6144;
    const f32x2* tabg = (const f32x2*)(ws + WS_TABG); const f32x2* tabm = (const f32x2*)(ws + WS_TABM);
    float* Y = out + OUT_Y;

    PH(0) {
        if (G != 256 || bid < 128) p0_adaln(in, ws, lds, tid, wave, lane, bid, G == 256 ? 128 : G, 0, 128);
        if (bid == G - 1) p0_tables(in, ws, tid);
        if (G == 256) { if (bid >= 128) p0_weights(in, ws, (LAS float*)(lds + 57344 + wave * 8448), (bid - 128) * NWAVES + wave, 128 * NWAVES, lane, 0, P0_ITEMS_L0); }
        else p0_weights(in, ws, (LAS float*)(lds + 57344 + wave * 8448), gw, ngw, lane, 0, P0_ITEMS_L0);
    }
    SEAM(0);
    PH(1) phase_norm_in(in[0], in[1], in[10] + 0 * DM, MOD0, 0, H, row0_of(bid, wave), lane);
    SEAM(1);
    PH(2) run_gemm(lds, H, (const bf16*)(ws + WS_WCIN), T, CIN, 1024, G, bid, EpiConvIn{U, (const float*)(ws + WS_BCIN)});
    PH(2) { if (bid >= 32) p0_weights(in, ws, (LAS float*)(lds + wave * 8448), (bid - 32) * NWAVES + wave, (G - 32) * NWAVES, lane, P0_ITEMS_L0, P0_ITEMS_ALL);
            if (bid >= 128) { __syncthreads(); p0_adaln(in, ws, lds, tid, wave, lane, bid - 128, G - 128, 128, 256); } }
    SEAM(2);
    PH(3) phase_conv(U, MIX, in[13], in[15], in[16], in[17], in[18], lds, tid, wave, lane, G);
    SEAM(3);
    PH(4) run_gemm_split(lds, MIX, (const bf16*)(ws + WS_WCOUT), 1024, bid, EpiStore{OB, DM, in[20], SLABC});
    SEAM(4);
    PH(5) phase_post16<true, true>(OB, SLABC, in[0], in[1], Y, in[11] + 0 * DM, MOD0, 2, in[10] + 1 * DM, MOD0, 3, H, row0_of(bid, wave), slab_off_of(bid), lane);
    SEAM(5);
    PH(6) run_gemm(lds, H, (const bf16*)(ws + WS_WGU0), T, 2 * FFN, 1024, G, bid, EpiSwiGLU{ACT});
    SEAM(6);
    PH(7) run_gemm_split(lds, ACT, (const bf16*)(ws + WS_WD0), FFN, bid, EpiStore{OB, DM, nullptr, SLABB});
    SEAM(7);
    PH(8) phase_post16<true>(OB, SLABB, nullptr, nullptr, Y, in[11] + 1 * DM, MOD0, 5, in[10] + 2 * DM, MOD1, 0, H, row0_of(bid, wave), slab_off_of(bid), lane);
    SEAM(8);
    PH(9) run_gemm(lds, H, (const bf16*)(ws + WS_WAIN), T, AINP, 1024, G, bid, EpiAttnIn{(bf16*)(ws + WS_C + C_QC), (bf16*)(ws + WS_C + C_U1)});
    SEAM(9);
    PH(10) phase_attn_rows((const bf16*)(ws + WS_C + C_U1), in[22], in[23], in[24], in[26], tabg, tabm,
                                (bf16*)(ws + WS_C + C_QC), (bf16*)(ws + WS_A + A_KC), (bf16*)(ws + WS_A + A_VTC), (bf16*)(ws + WS_A + A_QA), (bf16*)(ws + WS_A + A_CKV), (bf16*)(ws + WS_A + A_KR),
                                out + OUT_K, out + OUT_V, out + OUT_CKV, out + OUT_KR, in[2], in[3], in[4], in[5], lds, bid, tid, wave, lane);
    SEAM(10);
    PH(11) {
        run_gemm(lds, (const bf16*)(ws + WS_A + A_QA), (const bf16*)(ws + WS_WQB), T, MQD, QL, G, bid, EpiStore{(bf16*)(ws + WS_C + C_MQ), MQD, nullptr, nullptr});
        run_gemm(lds, (const bf16*)(ws + WS_A + A_CKV), (const bf16*)(ws + WS_WKN), TK, 512, KVL, G, (bid + 240) % G, EpiStore{(bf16*)(ws + WS_C + C_KN), 512, nullptr, nullptr});
        run_gemm(lds, (const bf16*)(ws + WS_WVT), (const bf16*)(ws + WS_A + A_CKV), 512, TK, KVL, G, (bid + 160) % G, EpiStore{(bf16*)(ws + WS_C + C_VTM), TK, nullptr, nullptr});
    }
    SEAM(11);
    PH(12) phase_attention(ws, lds, tabg, tabm, in[22], tid, wave, lane, G);
    SEAM(12);
    PH(13) run_gemm(lds, ATT, (const bf16*)(ws + WS_WAOUT), T, 1024, 1024, G, bid, EpiStore{OB, DM, nullptr, nullptr});
    SEAM(13);
    PH(14) phase_post16<false>(OB, nullptr, nullptr, nullptr, Y, in[11] + 2 * DM, MOD1, 2, in[10] + 3 * DM, MOD1, 3, H, row0_of(bid, wave), slab_off_of(bid), lane);
    SEAM(14);
    PH(15) run_gemm(lds, H, (const bf16*)(ws + WS_WGU1), T, 2 * FFN, 1024, G, bid, EpiSwiGLU{ACT});
    SEAM(15);
    PH(16) run_gemm_split(lds, ACT, (const bf16*)(ws + WS_WD1), FFN, bid, EpiStore{OB, DM, nullptr, SLABB});
    SEAM(16);
    PH(17) phase_post<false, true, false, true>(OB, SLABB, Y, Y + (size_t)TP * DM, Y, in[11] + 3 * DM, MOD1, 5, nullptr, nullptr, 0, nullptr, row0_of(bid, wave), slab_off_of(bid), lane);
#ifdef PROBE_TS
    xcd_barrier(bar);
    if (bid == 0) {
        if (tid == 0) tsl[18] = __builtin_amdgcn_s_memrealtime();
        __syncthreads();
        const unsigned long long t1 = tsl[PROBE_TS >= 18 ? 18 : PROBE_TS + 1], t0 = tsl[PROBE_TS >= 18 ? 0 : PROBE_TS];
        const float us = (float)(t1 - t0) * 0.01f - PROBE_SUB, eps = sqrtf(us * 1e-4f);
        float* okr = out + OUT_KR;
        for (int i = tid; i < TP * 32; i += NTHR) okr[i] *= (1.f + eps);
    }
#endif
#undef IN
#undef SEAM
}

#ifndef MK_ONE_LAUNCH
#define MK_ONE_LAUNCH 1
#endif
extern "C" void kernel_launch(void* const* d_in, const int* in_sizes, int n_in, void* d_out, int out_size, void* d_ws, size_t ws_size, hipStream_t stream) {
    static int grid = 0;
    if (grid == 0) {
        if (n_in != 32 || ws_size < WS_END) { fprintf(stderr, "kernel_launch: unexpected inputs (n_in %d, ws %zu)\n", n_in, ws_size); grid = -1; return; }
        int dev = 0, cus = 0, per_cu = 0;
        (void)hipGetDevice(&dev); (void)hipDeviceGetAttribute(&cus, hipDeviceAttributeMultiprocessorCount, dev);
        if (hipFuncSetAttribute((const void*)fwd_kernel, hipFuncAttributeMaxDynamicSharedMemorySize, LDS_BYTES) != hipSuccess) { fprintf(stderr, "kernel_launch: hipFuncSetAttribute failed\n"); grid = -1; return; }
        if (hipOccupancyMaxActiveBlocksPerMultiprocessor(&per_cu, (const void*)fwd_kernel, NTHR, LDS_BYTES) != hipSuccess || per_cu < 1) { fprintf(stderr, "kernel_launch: occupancy query says %d\n", per_cu); per_cu = 1; }
        (void)hipGetLastError();
        if (cus != 256) { fprintf(stderr, "kernel_launch: built for a 256-CU device (one workgroup per CU), found %d CUs; nothing launched\n", cus); grid = -1; return; }
        grid = cus;
    }
    if (grid < 0) return;
    Args a{};
    for (int i = 0; i < 32; ++i) a.in[i] = (const float*)d_in[i];
    a.out = (float*)d_out; a.ws = (unsigned char*)d_ws;
#if MK_ONE_LAUNCH && MK_CG_SYNC
    a.ph_lo = 0; a.ph_hi = NPHASE;
    void* kargs[] = {&a};
    hipError_t e = hipLaunchCooperativeKernel((const void*)fwd_kernel, dim3(grid), dim3(NTHR), kargs, LDS_BYTES, stream);
    if (e != hipSuccess) fprintf(stderr, "kernel_launch: cooperative launch failed: %s (grid %d)\n", hipGetErrorString(e), grid);
#elif MK_ONE_LAUNCH
    if (hipMemsetAsync((char*)d_ws + WS_CTL, 0, 16384, stream) != hipSuccess) { fprintf(stderr, "kernel_launch: memset failed\n"); return; }
    a.ph_lo = 0; a.ph_hi = NPHASE;
    hipLaunchKernelGGL(fwd_kernel, dim3(grid), dim3(NTHR), LDS_BYTES, stream, a);
#else
    for (int p = 0; p < NPHASE; ++p) { a.ph_lo = p; a.ph_hi = p + 1; hipLaunchKernelGGL(fwd_kernel, dim3(grid), dim3(NTHR), LDS_BYTES, stream, a); }
#endif
}
```
